# Optimizing an MI355X kernel written in HIP

```python
import math
import jax
import jax.numpy as jnp
from jax import lax
import numpy as np

D_MODEL = 1024
BATCH = 4
SEQ = 8192
DEPTH = 2

N_BRANCH = 4
HEAD_DIM = 64
MIX_W = D_MODEL // N_BRANCH
N_HEADS_MIX = MIX_W // HEAD_DIM
N_META = 16
CHUNK = 64
PAD = CHUNK - N_META
NEG = -1e30
RWKV_LORA_W = 64
RWKV_LORA_A = 64
RWKV_LORA_G = 128
RWKV_GN_EPS = HEAD_DIM * 1e-5
GLA_DK = HEAD_DIM // 2
GLA_LORA = 16
GLA_TAU = 16.0
DSA_KV_RANK = 128
IDX_HEADS = 8
IDX_DIM = 32
TOPK_MAX = 256
Q_BLOCK = 128
N_BUCKETS = 32
MAX_DISTANCE = 128
CONV_W = 4
N_GROUPS = 4
EXPERTS_PER_GROUP = 4
N_EXPERTS = N_GROUPS * EXPERTS_PER_GROUP
TOP_K_INNER = 2
D_EXPERT = D_MODEL // 4
DN_ALPHA = (2 * DEPTH) ** 0.25
DN_BETA = (8 * DEPTH) ** -0.25
LN_EPS = 1e-5

RWKV_SPLITS = (MIX_W, MIX_W, MIX_W, RWKV_LORA_W, RWKV_LORA_A, RWKV_LORA_G)
GLA_SPLITS = (N_HEADS_MIX * GLA_DK, N_HEADS_MIX * GLA_DK, MIX_W, GLA_LORA, MIX_W)
DSA_SPLITS = (MIX_W, DSA_KV_RANK, IDX_HEADS * IDX_DIM, IDX_DIM, IDX_HEADS)
MLSTM_SPLITS = (MIX_W, MIX_W, MIX_W, N_HEADS_MIX, N_HEADS_MIX, MIX_W)
IN_SPLITS = (sum(RWKV_SPLITS), sum(GLA_SPLITS), sum(DSA_SPLITS), sum(MLSTM_SPLITS), N_BRANCH * D_MODEL)
IN_COLS = sum(IN_SPLITS)

kernel_name = 'hybrid_gated_rwkv7_gla_dsa_mlstm_hmoe'


def _split(a, sizes):
    return jnp.split(a, [int(s) for s in np.cumsum(sizes)[:-1]], axis=-1)


def _layer_norm(x, g, b):
    xf = x.astype(jnp.float32)
    mu = jnp.mean(xf, -1, keepdims=True)
    var = jnp.mean(jnp.square(xf - mu), -1, keepdims=True)
    return ((xf - mu) * lax.rsqrt(var + LN_EPS)).astype(x.dtype) * g + b


def _std_norm(y, eps):
    mu = jnp.mean(y, -1, keepdims=True)
    var = jnp.mean(jnp.square(y - mu), -1, keepdims=True)
    return (y - mu) * lax.rsqrt(var + eps)


def _rms(y, eps=1e-6):
    return y * lax.rsqrt(jnp.mean(jnp.square(y), -1, keepdims=True) + eps)


def _token_shift(a):
    return jnp.pad(a, ((0, 0), (1, 0), (0, 0)))[:, :-1]


def _causal_dwconv(a, w, b):
    out = lax.conv_general_dilated(a, w.astype(a.dtype)[:, None, :], (1,), [(CONV_W - 1, 0)],
                                   dimension_numbers=('NWC', 'WIO', 'NWC'),
                                   feature_group_count=a.shape[-1])
    return out + b


def _to_chunks(t, n_heads, fill=0.0):
    B, T, C = t.shape
    t = jnp.pad(t, ((0, 0), (PAD, 0), (0, 0)), constant_values=fill)
    return t.reshape(B, (T + PAD) // CHUNK, CHUNK, n_heads, C // n_heads).transpose(0, 3, 1, 2, 4)


def _from_chunks(t):
    B, H, NC, L, d = t.shape
    return t.transpose(0, 2, 3, 1, 4).reshape(B, NC * L, H, d)[:, PAD:]


def _t5_bucket(dist):
    max_exact = N_BUCKETS // 2
    n = jnp.maximum(dist, 0)
    large = max_exact + (jnp.log(jnp.maximum(n, 1).astype(jnp.float32) / max_exact)
                         / math.log(MAX_DISTANCE / max_exact) * (N_BUCKETS - max_exact)).astype(jnp.int32)
    return jnp.where(n < max_exact, n, jnp.minimum(large, N_BUCKETS - 1))


def _rwkv7_mixer(p, mu, w_up, w0, a_up, a0, g_up, k_k, k_a, r_k, gn_g, gn_b):
    B, T, _ = p.shape
    H, N = N_HEADS_MIX, HEAD_DIM
    p = p + (_token_shift(p) - p) * mu
    r, k, v, xw, xa, xg = _split(p, RWKV_SPLITS)
    w_log = -jax.nn.softplus(-(w0 + jnp.tanh(xw) @ w_up)) - 0.5
    decay = jnp.exp(-jnp.exp(w_log))
    a = jax.nn.sigmoid(a0 + xa @ a_up)
    g = jax.nn.sigmoid(xg) @ g_up
    kk = (k * k_k).reshape(B, T, H, N)
    kk = kk / jnp.maximum(jnp.sqrt(jnp.sum(kk * kk, -1, keepdims=True)), 1e-12)
    k = k * (1.0 + (a - 1.0) * k_a)
    r, decay, k, v, a = (t.reshape(B, T, H, N) for t in (r, decay, k, v, a))

    def step(s, inp):
        r_t, w_t, k_t, v_t, kk_t, a_t = inp
        s_kk = jnp.einsum('bhvk,bhk->bhv', s, kk_t)
        s = (s * w_t[:, :, None, :] - s_kk[..., None] * (kk_t * a_t)[:, :, None, :]
             + v_t[..., None] * k_t[:, :, None, :])
        return s, jnp.einsum('bhvk,bhk->bhv', s, r_t)

    s0 = jnp.zeros((B, H, N, N), jnp.float32)
    _, y = lax.scan(step, s0, tuple(jnp.moveaxis(t, 1, 0) for t in (r, decay, k, v, kk, a)))
    y = jnp.moveaxis(y, 0, 1)
    y = _std_norm(y, RWKV_GN_EPS).reshape(B, T, H * N) * gn_g + gn_b
    bonus = jnp.sum(r * k * r_k, -1, keepdims=True) * v
    return (y + bonus.reshape(B, T, H * N)) * g


def _gla_mixer(p, a_up, a_b, norm_g):
    B, T, _ = p.shape
    H = N_HEADS_MIX
    q, k, v, xa, og = _split(p, GLA_SPLITS)
    la = jax.nn.log_sigmoid(xa @ a_up + a_b) / GLA_TAU
    q = _to_chunks(q, H) * GLA_DK ** -0.5
    k = _to_chunks(k, H)
    v = _to_chunks(v, H)
    la = _to_chunks(la, H)
    b = jnp.cumsum(la, axis=3)
    b_last = b[:, :, :, -1:]
    q_g = q * jnp.exp(b)
    att = jnp.einsum('bhcld,bhcsd->bhcls', q_g, k * jnp.exp(-b))
    att = jnp.where(jnp.tril(jnp.ones((CHUNK, CHUNK), bool)), att, 0.0)
    o = jnp.einsum('bhcls,bhcsv->bhclv', att, v)
    u = jnp.einsum('bhcsd,bhcsv->bhcdv', k * jnp.exp(b_last - b), v)
    dec = jnp.exp(b_last[:, :, :, 0])

    def step(s, inp):
        dec_c, u_c = inp
        return dec_c[..., None] * s + u_c, s

    s0 = jnp.zeros((B, H, GLA_DK, HEAD_DIM), jnp.float32)
    _, s_in = lax.scan(step, s0, (jnp.moveaxis(dec, 2, 0), jnp.moveaxis(u, 2, 0)))
    o = o + jnp.einsum('bhcld,bhcdv->bhclv', q_g, jnp.moveaxis(s_in, 0, 2))
    o = _rms(_from_chunks(o)) * norm_g
    return o.reshape(B, T, H * HEAD_DIM) * jax.nn.silu(og)


def _dsa_mixer(p, kv_norm_g, w_uk, w_uv, rel_bias, topk):
    B, T, _ = p.shape
    H, N = N_HEADS_MIX, HEAD_DIM
    q, ckv, qi, ki, wi = _split(p, DSA_SPLITS)
    c = _rms(ckv) * kv_norm_g
    k = c @ w_uk
    v = c @ w_uv
    n_blk = -(-T // Q_BLOCK)
    tq_len = n_blk * Q_BLOCK

    def blocks(t):
        t = jnp.pad(t, ((0, 0), (0, tq_len - T)) + ((0, 0),) * (t.ndim - 2))
        return jnp.moveaxis(t.reshape((B, n_blk, Q_BLOCK) + t.shape[2:]), 1, 0)

    q_b = blocks(q.reshape(B, T, H, N) * N ** -0.5)
    qi_b = blocks(qi.reshape(B, T, IDX_HEADS, IDX_DIM))
    wi_b = blocks(wi * (IDX_HEADS * IDX_DIM) ** -0.5)
    pos_b = jnp.arange(tq_len, dtype=jnp.int32).reshape(n_blk, Q_BLOCK)
    key_pos = jnp.arange(T, dtype=jnp.int32)
    gather = jax.vmap(lambda src, idx: src[idx])

    def attend(args):
        qb, qib, wib, tq = args
        rel = jax.nn.relu(jnp.einsum('bqhd,bsd->bqhs', qib, ki))
        score = jnp.einsum('bqhs,bqh->bqs', rel, wib)
        score = jnp.where(key_pos < N_META, jnp.inf, score)
        score = jnp.where(key_pos[None, :] <= tq[:, None], score, -jnp.inf)
        _, idx = lax.top_k(score, topk)
        valid = idx <= tq[None, :, None]
        k_sel = gather(k, idx)
        v_sel = gather(v, idx)
        logits = jnp.einsum('bqhd,bqkd->bhqk', qb, k_sel)
        bias = rel_bias[_t5_bucket(tq[None, :, None] - idx)]
        logits = logits + jnp.moveaxis(bias, -1, 1)
        logits = jnp.where(valid[:, None], logits, -jnp.inf)
        prob = jax.nn.softmax(logits, axis=-1)
        return jnp.einsum('bhqk,bqkd->bqhd', prob, v_sel)

    out = lax.map(attend, (q_b, qi_b, wi_b, pos_b))
    return jnp.moveaxis(out, 0, 1).reshape(B, tq_len, H * N)[:, :T]


def _mlstm_mixer(p, conv_w, conv_b, i_b, f_b, norm_g):
    B, T, _ = p.shape
    H, N = N_HEADS_MIX, HEAD_DIM
    q, k, v, ig, fg, og = _split(p, MLSTM_SPLITS)
    qk = jax.nn.silu(_causal_dwconv(jnp.concatenate([q, k], -1), conv_w, conv_b))
    q = _to_chunks(qk[..., :MIX_W], H)
    k = _to_chunks(qk[..., MIX_W:], H) * N ** -0.5
    v = _to_chunks(v, H)
    li = _to_chunks(ig + i_b, H, NEG)[..., 0]
    lf = _to_chunks(jax.nn.log_sigmoid(fg + f_b), H)[..., 0]
    b = jnp.cumsum(lf, -1)
    b_last = b[..., -1]
    g_loc = b_last[..., None] - b + li
    m_loc = jnp.max(g_loc, -1)
    w_loc = jnp.exp(g_loc - m_loc[..., None])
    c_loc = jnp.einsum('bhcs,bhcsd,bhcsv->bhcdv', w_loc, k, v)
    n_loc = jnp.einsum('bhcs,bhcsd->bhcd', w_loc, k)

    def step(carry, inp):
        c_st, n_st, m_st = carry
        bl, ml, cl, nl = inp
        m_new = jnp.maximum(bl + m_st, ml)
        s_old = jnp.exp(bl + m_st - m_new)
        s_new = jnp.exp(ml - m_new)
        return ((s_old[..., None, None] * c_st + s_new[..., None, None] * cl,
                 s_old[..., None] * n_st + s_new[..., None] * nl, m_new), (c_st, n_st, m_st))

    init = (jnp.zeros((B, H, N, N), jnp.float32), jnp.zeros((B, H, N), jnp.float32),
            jnp.zeros((B, H), jnp.float32))
    _, (c_in, n_in, m_in) = lax.scan(step, init, tuple(jnp.moveaxis(t, 2, 0) for t in (b_last, m_loc, c_loc, n_loc)))
    c_in, n_in, m_in = (jnp.moveaxis(t, 0, 2) for t in (c_in, n_in, m_in))
    causal = jnp.tril(jnp.ones((CHUNK, CHUNK), bool))
    d_log = jnp.where(causal, b[..., :, None] - b[..., None, :] + li[..., None, :], -jnp.inf)
    inter = b + m_in[..., None]
    m_t = jnp.maximum(inter, jnp.max(d_log, -1))
    s_w = jnp.exp(d_log - m_t[..., None]) * jnp.einsum('bhcld,bhcsd->bhcls', q, k)
    w_inter = jnp.exp(inter - m_t)
    num = (jnp.einsum('bhcls,bhcsv->bhclv', s_w, v)
           + w_inter[..., None] * jnp.einsum('bhcld,bhcdv->bhclv', q, c_in))
    den = jnp.sum(s_w, -1) + w_inter * jnp.einsum('bhcld,bhcd->bhcl', q, n_in)
    h = num / jnp.maximum(jnp.abs(den), jnp.exp(-m_t))[..., None]
    h = _from_chunks(h) * jax.nn.sigmoid(og).reshape(B, T, H, N)
    return _std_norm(h, 1e-5).reshape(B, T, H * N) * norm_g


def _hier_moe(x, w_grp, b_grp, w_rt, b_rt, w_gate, w_up, w_down):
    B, T, D = x.shape
    xf = x.reshape(B * T, D)
    g_logit = (xf @ w_grp).astype(jnp.float32) + b_grp
    g_sel = jnp.argmax(g_logit, -1)
    p_grp = jnp.take_along_axis(jax.nn.softmax(g_logit, -1), g_sel[:, None], 1)
    e_logit = ((xf @ w_rt).astype(jnp.float32) + b_rt).reshape(-1, N_GROUPS, EXPERTS_PER_GROUP)
    e_logit = jnp.take_along_axis(e_logit, g_sel[:, None, None], 1)[:, 0]
    top_val, top_idx = lax.top_k(e_logit, TOP_K_INNER)
    w = jax.nn.softmax(top_val, -1) * p_grp
    e_idx = g_sel[:, None] * EXPERTS_PER_GROUP + top_idx
    gate = jnp.einsum('nke,nk->ne', jax.nn.one_hot(e_idx, N_EXPERTS, dtype=jnp.float32), w).astype(x.dtype)
    y = jnp.zeros_like(xf)
    for e in range(N_EXPERTS):
        hid = jax.nn.silu(xf @ w_gate[e]) * (xf @ w_up[e])
        y = y + gate[:, e:e + 1] * (hid @ w_down[e])
    return y.reshape(B, T, D)


def setup_inputs(seed: int = 0) -> dict:
    key = jax.random.key(seed)
    keys = iter([jax.random.fold_in(key, i) for i in range(64)])

    def nrm(shape, scale):
        return jax.random.normal(next(keys), shape, jnp.float32) * scale

    def unif(shape, lo, hi):
        return jax.random.uniform(next(keys), shape, jnp.float32, minval=lo, maxval=hi)

    def gain(shape):
        return 1.0 + nrm(shape, 0.02)

    L, D, H, N, W = DEPTH, D_MODEL, N_HEADS_MIX, HEAD_DIM, MIX_W
    return {
        'x': nrm((BATCH, SEQ, D), 1.0),
        'meta': nrm((N_META, D), 1.0),
        'ln_in_g': gain((D,)),
        'ln_in_b': nrm((D,), 0.02),
        'rel_bias': nrm((N_BUCKETS, H), 0.5),
        'w_in': nrm((L, D, IN_COLS), D ** -0.5),
        'rwkv_mu': unif((L, sum(RWKV_SPLITS)), 0.0, 1.0),
        'rwkv_w_up': nrm((L, RWKV_LORA_W, W), RWKV_LORA_W ** -0.5),
        'rwkv_w0': unif((L, W), -6.0, 1.0),
        'rwkv_a_up': nrm((L, RWKV_LORA_A, W), RWKV_LORA_A ** -0.5),
        'rwkv_a0': nrm((L, W), 0.1),
        'rwkv_g_up': nrm((L, RWKV_LORA_G, W), RWKV_LORA_G ** -0.5),
        'rwkv_k_k': 0.85 + nrm((L, W), 0.02),
        'rwkv_k_a': gain((L, W)),
        'rwkv_r_k': nrm((L, H, N), 0.1),
        'rwkv_gn_g': gain((L, W)),
        'rwkv_gn_b': nrm((L, W), 0.02),
        'gla_a_up': nrm((L, GLA_LORA, H * GLA_DK), GLA_LORA ** -0.5),
        'gla_a_b': nrm((L, H * GLA_DK), 0.1),
        'gla_norm_g': gain((L, N)),
        'dsa_kv_norm_g': gain((L, DSA_KV_RANK)),
        'dsa_w_uk': nrm((L, DSA_KV_RANK, N), DSA_KV_RANK ** -0.5),
        'dsa_w_uv': nrm((L, DSA_KV_RANK, N), DSA_KV_RANK ** -0.5),
        'mlstm_conv_w': nrm((L, CONV_W, 2 * W), CONV_W ** -0.5),
        'mlstm_conv_b': nrm((L, 2 * W), 0.02),
        'mlstm_i_b': nrm((L, H), 0.5),
        'mlstm_f_b': unif((L, H), 3.0, 6.0),
        'mlstm_norm_g': gain((L, W)),
        'w_branch': nrm((L, N_BRANCH, W, D), DN_BETA * W ** -0.5),
        'w_out': nrm((L, D, D), DN_BETA * D ** -0.5),
        'ln1_g': gain((L, D)),
        'ln1_b': nrm((L, D), 0.02),
        'moe_w_grp': nrm((L, D, N_GROUPS), D ** -0.5),
        'moe_b_grp': nrm((L, N_GROUPS), 0.01),
        'moe_w_rt': nrm((L, D, N_EXPERTS), D ** -0.5),
        'moe_b_rt': nrm((L, N_EXPERTS), 0.01),
        'moe_w_gate': nrm((L, N_EXPERTS, D, D_EXPERT), D ** -0.5),
        'moe_w_up': nrm((L, N_EXPERTS, D, D_EXPERT), D ** -0.5),
        'moe_w_down': nrm((L, N_EXPERTS, D_EXPERT, D), DN_BETA * D_EXPERT ** -0.5),
        'ln2_g': gain((L, D)),
        'ln2_b': nrm((L, D), 0.02),
    }


def reference(x, meta, ln_in_g, ln_in_b, rel_bias, w_in,
              rwkv_mu, rwkv_w_up, rwkv_w0, rwkv_a_up, rwkv_a0, rwkv_g_up, rwkv_k_k, rwkv_k_a, rwkv_r_k,
              rwkv_gn_g, rwkv_gn_b,
              gla_a_up, gla_a_b, gla_norm_g,
              dsa_kv_norm_g, dsa_w_uk, dsa_w_uv,
              mlstm_conv_w, mlstm_conv_b, mlstm_i_b, mlstm_f_b, mlstm_norm_g,
              w_branch, w_out, ln1_g, ln1_b,
              moe_w_grp, moe_b_grp, moe_w_rt, moe_b_rt, moe_w_gate, moe_w_up, moe_w_down, ln2_g, ln2_b):
    B, S, D = x.shape
    topk = min(TOPK_MAX, S // 4)
    h = jnp.concatenate([jnp.broadcast_to(meta.astype(x.dtype), (B, N_META, D)), x], axis=1)
    h = _layer_norm(h, ln_in_g, ln_in_b)
    for l in range(DEPTH):
        p = (h @ w_in[l]).astype(jnp.float32)
        p_a, p_b, p_c, p_d, p_g = _split(p, IN_SPLITS)
        y_a = _rwkv7_mixer(p_a, rwkv_mu[l], rwkv_w_up[l], rwkv_w0[l], rwkv_a_up[l], rwkv_a0[l], rwkv_g_up[l],
                           rwkv_k_k[l], rwkv_k_a[l], rwkv_r_k[l], rwkv_gn_g[l], rwkv_gn_b[l])
        y_b = _gla_mixer(p_b, gla_a_up[l], gla_a_b[l], gla_norm_g[l])
        y_c = _dsa_mixer(p_c, dsa_kv_norm_g[l], dsa_w_uk[l], dsa_w_uv[l], rel_bias, topk)
        y_d = _mlstm_mixer(p_d, mlstm_conv_w[l], mlstm_conv_b[l], mlstm_i_b[l], mlstm_f_b[l], mlstm_norm_g[l])
        gates = jnp.split(jax.nn.sigmoid(p_g), N_BRANCH, axis=-1)
        merged = jnp.zeros_like(h)
        for i, y in enumerate((y_a, y_b, y_c, y_d)):
            merged = merged + gates[i].astype(h.dtype) * (y.astype(h.dtype) @ w_branch[l, i])
        h = _layer_norm(DN_ALPHA * h + merged @ w_out[l], ln1_g[l], ln1_b[l])
        moe_out = _hier_moe(h, moe_w_grp[l], moe_b_grp[l], moe_w_rt[l], moe_b_rt[l],
                            moe_w_gate[l], moe_w_up[l], moe_w_down[l])
        h = _layer_norm(DN_ALPHA * h + moe_out, ln2_g[l], ln2_b[l])
    return h[:, N_META:]
```

```cpp
#include <hip/hip_runtime.h>
#include <cstdio>
#include <cstdint>
namespace pg8 {
#define PG8_LAS __attribute__((address_space(3)))
typedef unsigned short bf16_t;
typedef short bf16x8 __attribute__((ext_vector_type(8)));
typedef float f32x4 __attribute__((ext_vector_type(4)));
typedef unsigned u32x4 __attribute__((ext_vector_type(4)));
constexpr int BM = 256, BK = 64, HALF = 128, HTB = HALF * BK * 2  , STAGE_BYTES = 8 * HTB, NXCD = 8, WGM = 8;

__host__ __device__ __forceinline__ int lds_byte(int r, int c) { const int st = (r >> 4) * 2 + (c >> 5), rr = r & 15, cc = c & 31, ob = rr * 64 + cc * 2; return st * 1024 + (ob ^ (((ob >> 9) & 1) << 5)); }
__host__ __device__ __forceinline__ void stage_rc(int b, int& R, int& C) { const int st = b / 1024, sb = b % 1024, swz = sb ^ (((sb >> 9) & 1) << 5); R = (st >> 1) * 16 + swz / 64; C = (st & 1) * 32 + (swz % 64) / 2; }
__host__ __device__ __forceinline__ int perm32(int rho) { const int n = rho >> 4, i = rho & 15; return 8 * (i >> 2) + 4 * n + (i & 3); }

struct Unit { int pm, pn, x0, x1; };
struct Gemm { const bf16_t* A; const bf16_t* Bt; int M, N, K; };

struct StaticOrder {
    int nM, nN, nwg, G, c;
    __host__ __device__ void init(int M, int N, int G_, int c_) { nM = M / BM; nN = N / BM; nwg = nM * nN; G = G_; c = c_; }
    __host__ __device__ bool next(int i, Unit& u) const {
        const long L = (long)i * G + c; if (L >= nwg) return false;
        int wgid = (int)L; { const int q = nwg / NXCD, r = nwg % NXCD, xcd = wgid % NXCD, off = wgid / NXCD; wgid = (xcd < r ? xcd * (q + 1) : r * (q + 1) + (xcd - r) * q) + off; }
        const int nig = WGM * nN, gid = wgid / nig, fm = gid * WGM, gsz = (nM - fm) < WGM ? (nM - fm) : WGM;
        u.pm = fm + ((wgid % nig) % gsz); u.pn = (wgid % nig) / gsz; return true;
    }
    __device__ __forceinline__ void a_ready(const Unit&) const {}
    __device__ __forceinline__ void done(const Unit&) const {}
};

typedef float f32x2c_t __attribute__((ext_vector_type(2))); typedef __bf16 bf16x2c_t __attribute__((ext_vector_type(2)));
__device__ __forceinline__ unsigned cvt_pk_bf16(float lo, float hi) { const f32x2c_t v = {lo, hi}; const bf16x2c_t b = __builtin_convertvector(v, bf16x2c_t); return __builtin_bit_cast(unsigned, b); }
typedef float f32x2 __attribute__((ext_vector_type(2)));
template <class Epi, class Sched, bool ALIGN_EPI = false, bool SP2 = false>
__device__ __forceinline__ void gemm_phase(PG8_LAS unsigned char* lds, const Gemm g, const Sched& S, const Epi& E) {
    int tid_o = threadIdx.x; asm volatile("" : "+v"(tid_o));
    const int tid = tid_o, wid = __builtin_amdgcn_readfirstlane(tid >> 6), lane = tid & 63, wr = wid >> 2, wc = wid & 3, fr = lane & 15, fq = lane >> 4;
    const int K = g.K, nt = K / BK;
    unsigned voffA[2], voffB[2];
#pragma unroll
    for (int i = 0; i < 2; ++i) { int R, C; stage_rc(tid * 16 + i * 8192, R, C); const int Rb = Epi::PERM ? ((R & ~31) + perm32(R & 31)) : R;
        voffA[i] = (unsigned)(R * K + C) * 2u; voffB[i] = (unsigned)(Rb * K + C) * 2u; }
    const size_t kstep = (size_t)(BK * 2);
    const size_t hstep = (size_t)HALF * K * 2;
    const size_t tstep = 2 * hstep;
    const unsigned ldsw = (unsigned)wid * 1024u;
    const int aoff = lds_byte(wr * 64 + fr, fq * 8), boff = lds_byte(wc * 32 + fr, fq * 8);
#define PG8_SA(b, h) (((b) * 2 + (h)) * HTB)
#define PG8_SB(b, h) ((4 + (b) * 2 + (h)) * HTB)
#define PG8_STAGE(bufoff, gbase, voff) do { _Pragma("unroll") for (int _i = 0; _i < 2; ++_i) \
        __builtin_amdgcn_global_load_lds((const unsigned*)((const char*)(gbase) + (voff)[_i]), (PG8_LAS unsigned*)(lds + (bufoff) + ldsw + _i * 8192), 16, 0, 0); } while (0)
#define PG8_LDA(dst, b, h) do { _Pragma("unroll") for (int m = 0; m < 4; ++m) _Pragma("unroll") for (int k = 0; k < 2; ++k) dst[m][k] = *(const PG8_LAS bf16x8*)(lds + PG8_SA(b, h) + aoff + m * 2048 + k * 1024); } while (0)
#define PG8_LDB(dst, b, h) do { _Pragma("unroll") for (int n = 0; n < 2; ++n) _Pragma("unroll") for (int k = 0; k < 2; ++k) dst[n][k] = *(const PG8_LAS bf16x8*)(lds + PG8_SB(b, h) + boff + n * 2048 + k * 1024); } while (0)
#define PG8_MMA(ai, bj, At, Bt) do { __builtin_amdgcn_s_setprio(1); _Pragma("unroll") for (int m = 0; m < 4; ++m) _Pragma("unroll") for (int n = 0; n < 2; ++n) _Pragma("unroll") for (int k = 0; k < 2; ++k) \
        acc[ai][bj][m][n] = __builtin_amdgcn_mfma_f32_16x16x32_bf16(Bt[n][k], At[m][k], acc[ai][bj][m][n], 0, 0, 0); __builtin_amdgcn_s_setprio(0); } while (0)
#define PG8_WAIT_V(n) asm volatile("s_waitcnt vmcnt(" #n ")" ::: "memory")
#define PG8_WAIT_L(n) asm volatile("s_waitcnt lgkmcnt(" #n ")" ::: "memory")
#define PG8_BAR __builtin_amdgcn_s_barrier()
#define PG8_SCHED __builtin_amdgcn_sched_barrier(0)
    Unit cur, nxt; int ui = 0;
    if (!S.next(0, cur)) return;
    f32x4 acc[2][2][4][2];
#pragma unroll
    for (int a = 0; a < 2; ++a)
#pragma unroll
        for (int b = 0; b < 2; ++b)
#pragma unroll
            for (int m = 0; m < 4; ++m)
#pragma unroll
                for (int n = 0; n < 2; ++n) acc[a][b][m][n] = (f32x4){0.f, 0.f, 0.f, 0.f};
    bf16x8 At[4][2], B0[2][2], B1[2][2];
    const char* cA = (const char*)g.A + (size_t)cur.pm * tstep; const char* cB = (const char*)g.Bt + (size_t)cur.pn * tstep;
    S.a_ready(cur);
    if constexpr (SP2) {
        PG8_STAGE(PG8_SB(0, 0), cB, voffB); PG8_STAGE(PG8_SB(0, 1), cB + hstep, voffB); PG8_STAGE(PG8_SA(0, 0), cA, voffA); PG8_STAGE(PG8_SA(0, 1), cA + hstep, voffA);
        if (wr == 1) PG8_BAR;
        PG8_WAIT_V(2); PG8_BAR;
        PG8_STAGE(PG8_SB(1, 0), cB + kstep, voffB); PG8_STAGE(PG8_SA(1, 0), cA + kstep, voffA); PG8_STAGE(PG8_SB(1, 1), cB + hstep + kstep, voffB);
        PG8_WAIT_V(6); PG8_BAR;
    } else {
        PG8_STAGE(PG8_SB(0, 0), cB, voffB); PG8_STAGE(PG8_SA(0, 0), cA, voffA); PG8_STAGE(PG8_SB(0, 1), cB + hstep, voffB); PG8_STAGE(PG8_SA(0, 1), cA + hstep, voffA);
        if (wr == 1) PG8_BAR;
        PG8_WAIT_V(4); PG8_BAR;
        PG8_STAGE(PG8_SB(1, 0), cB + kstep, voffB); PG8_STAGE(PG8_SA(1, 0), cA + kstep, voffA); PG8_STAGE(PG8_SB(1, 1), cB + hstep + kstep, voffB);
        PG8_WAIT_V(6); PG8_BAR;
    }
    for (;;) {
        const bool has_next = S.next(ui + 1, nxt);
        const char* nA = has_next ? (const char*)g.A + (size_t)nxt.pm * tstep : cA; const char* nB = has_next ? (const char*)g.Bt + (size_t)nxt.pn * tstep : cB;
#pragma unroll 1
        for (int t = 0; t < nt; t += 2) {
            const bool last = (t == nt - 2);
            const char* a1 = cA + (size_t)(t + 1) * kstep;
            const char* a2 = last ? nA : cA + (size_t)(t + 2) * kstep; const char* b2 = last ? nB : cB + (size_t)(t + 2) * kstep;
            const char* a3 = a2 + kstep; const char* b3 = b2 + kstep;
            if (last && has_next) S.a_ready(nxt);
            if constexpr (SP2) {
            PG8_LDB(B0, 0, 0); PG8_LDB(B1, 0, 1); PG8_SCHED; PG8_LDA(At, 0, 0); PG8_STAGE(PG8_SA(1, 1), a1 + hstep, voffA);
            PG8_WAIT_V(8); PG8_WAIT_L(0); PG8_BAR; PG8_MMA(0, 0, At, B0); PG8_MMA(0, 1, At, B1); PG8_BAR; PG8_SCHED;
            PG8_LDA(At, 0, 1); PG8_STAGE(PG8_SB(0, 0), b2, voffB); PG8_STAGE(PG8_SB(0, 1), b2 + hstep, voffB); PG8_STAGE(PG8_SA(0, 0), a2, voffA);
            PG8_WAIT_V(8); PG8_WAIT_L(0); PG8_BAR; PG8_MMA(1, 0, At, B0); PG8_MMA(1, 1, At, B1); PG8_BAR; PG8_SCHED;
            PG8_LDB(B0, 1, 0); PG8_LDB(B1, 1, 1); PG8_SCHED; PG8_LDA(At, 1, 0); PG8_STAGE(PG8_SA(0, 1), a2 + hstep, voffA);
            PG8_WAIT_V(8); PG8_WAIT_L(0); PG8_BAR; PG8_MMA(0, 0, At, B0); PG8_MMA(0, 1, At, B1); PG8_BAR; PG8_SCHED;
            PG8_LDA(At, 1, 1); PG8_STAGE(PG8_SB(1, 0), b3, voffB); PG8_STAGE(PG8_SB(1, 1), b3 + hstep, voffB); PG8_STAGE(PG8_SA(1, 0), a3, voffA);
            PG8_WAIT_V(8); PG8_WAIT_L(0); PG8_BAR; PG8_MMA(1, 0, At, B0); PG8_MMA(1, 1, At, B1); PG8_BAR; PG8_SCHED;
            } else {
            PG8_LDB(B0, 0, 0); PG8_SCHED; PG8_LDA(At, 0, 0); PG8_STAGE(PG8_SA(1, 1), a1 + hstep, voffA);
            PG8_WAIT_L(8); PG8_BAR; PG8_WAIT_L(0); PG8_MMA(0, 0, At, B0); PG8_BAR; PG8_SCHED;
            PG8_LDB(B1, 0, 1); PG8_STAGE(PG8_SB(0, 0), b2, voffB);
            PG8_BAR; PG8_WAIT_L(0); PG8_MMA(0, 1, At, B1); PG8_BAR;
            PG8_LDA(At, 0, 1); PG8_STAGE(PG8_SA(0, 0), a2, voffA);
            PG8_BAR; PG8_WAIT_L(0); PG8_MMA(1, 0, At, B0); PG8_BAR; PG8_SCHED;
            PG8_STAGE(PG8_SB(0, 1), b2 + hstep, voffB);
            PG8_WAIT_V(6); PG8_BAR; PG8_MMA(1, 1, At, B1); PG8_BAR;
            PG8_LDB(B0, 1, 0); PG8_SCHED; PG8_LDA(At, 1, 0); PG8_STAGE(PG8_SA(0, 1), a2 + hstep, voffA);
            PG8_WAIT_L(8); PG8_BAR; PG8_WAIT_L(0); PG8_MMA(0, 0, At, B0); PG8_BAR; PG8_SCHED;
            PG8_LDB(B1, 1, 1); PG8_STAGE(PG8_SB(1, 0), b3, voffB);
            PG8_BAR; PG8_WAIT_L(0); PG8_MMA(0, 1, At, B1); PG8_BAR;
            PG8_LDA(At, 1, 1); PG8_STAGE(PG8_SA(1, 0), a3, voffA);
            PG8_BAR; PG8_WAIT_L(0); PG8_MMA(1, 0, At, B0); PG8_BAR; PG8_SCHED;
            PG8_STAGE(PG8_SB(1, 1), b3 + hstep, voffB);
            PG8_WAIT_V(6); PG8_BAR; PG8_MMA(1, 1, At, B1); PG8_BAR;
            }
        }
        if constexpr (ALIGN_EPI) { if (wr == 0) PG8_BAR; }
        if constexpr (!Epi::AFTER_DRAIN) { E(acc, cur, wr, wc, fr, fq); S.done(cur); }
        if (!has_next) break;
#pragma unroll
        for (int a = 0; a < 2; ++a)
#pragma unroll
            for (int b = 0; b < 2; ++b)
#pragma unroll
                for (int m = 0; m < 4; ++m)
#pragma unroll
                    for (int n = 0; n < 2; ++n) acc[a][b][m][n] = (f32x4){0.f, 0.f, 0.f, 0.f};
        cur = nxt; cA = nA; cB = nB; ++ui;
        if constexpr (ALIGN_EPI) { if (wr == 1) PG8_BAR; }
    }
    PG8_WAIT_V(0);
    if constexpr (!ALIGN_EPI) { if (wr == 0) PG8_BAR; }
    PG8_BAR;
    if constexpr (Epi::AFTER_DRAIN) { E.fused(acc, cur, wr, wc, fr, fq, lds, wid, lane); S.done(cur); }
#undef PG8_SA
#undef PG8_SB
#undef PG8_STAGE
#undef PG8_LDA
#undef PG8_LDB
#undef PG8_MMA
#undef PG8_WAIT_V
#undef PG8_WAIT_L
#undef PG8_BAR
#undef PG8_SCHED
}
}

#ifndef RWKV_CACHE
#define RWKV_CACHE 1
#endif
#ifndef DSA_DUP
#define DSA_DUP 0
#endif
#ifndef DSA_HALVES
#define DSA_HALVES 0
#endif
constexpr int BATCH = 4, SEQ = 8192, NMETA = 16, T = SEQ + NMETA, M = BATCH * T, MP = 33024, D = 1024, DEPTH = 2;
constexpr int NCH = 129, PADT = 48;
constexpr int PW = 3584, IN_COLS = 7616;
constexpr int C_RW = 0, C_GLA = 1024, C_DSA = 1808, C_ML = 2488, C_MIXEND = 3520;
constexpr int NBH = 16;
constexpr int XROWS = 69888;
constexpr float DN_ALPHA = 1.41421356237f;
static_assert(MP % 256 == 0 && MP >= M && XROWS % 256 == 0 && XROWS >= 2 * M + 16 * 255, "shapes");

constexpr size_t MiB = 1u << 20;
constexpr size_t WS_CTL = 0, CTL_ZERO_BYTES = 1 * MiB;
constexpr size_t WS_W = 1 * MiB;
constexpr size_t W_IN = 0, W_G = W_IN + (size_t)PW * D * 2, W_B = W_G + (size_t)4096 * D * 2, W_O = W_B + (size_t)4 * D * 256 * 2,
                 W_GU = W_O + (size_t)D * D * 2, W_D = W_GU + (size_t)16 * 512 * D * 2, W_END = W_D + (size_t)16 * D * 256 * 2;
static_assert(W_END <= 44 * MiB, "weights");
constexpr size_t WS_HB = 45 * MiB;
constexpr size_t WS_R = 110 * MiB;
constexpr size_t R_P = 0;
constexpr size_t R_G = 0;
constexpr size_t R_X1 = 0;
constexpr size_t R_XG = 0;
constexpr size_t R_HID = 137 * MiB;
constexpr size_t R_BYTES = 258 * MiB;
static_assert((size_t)MP * 4096 * 2 <= R_BYTES && (size_t)XROWS * D * 2 <= R_HID && R_HID + (size_t)XROWS * 256 * 2 <= R_BYTES, "R");
constexpr size_t WS_Y = 368 * MiB;
constexpr size_t WS_MG = WS_Y + (size_t)4 * MP * 256 * 2;
constexpr size_t WS_O2 = WS_Y;
constexpr size_t WS_MISC = WS_MG + (size_t)MP * D * 2;
constexpr size_t WS_END = WS_MISC + 4 * MiB;
static_assert(WS_R + R_BYTES <= WS_Y && WS_END <= 512 * MiB, "d_ws map");
constexpr size_t MI_GU = 0;
constexpr size_t MI_GDEC = MI_GU + (size_t)NBH * NCH * 2048 * 4;
constexpr size_t MI_MC = MI_GDEC + (size_t)NBH * NCH * 32 * 4;
constexpr size_t MI_MN = MI_MC + (size_t)NBH * NCH * 4096 * 4;
constexpr size_t MI_ML = MI_MN + (size_t)NBH * NCH * 64 * 4;
constexpr size_t MI_BL = MI_ML + (size_t)NBH * NCH * 4;
constexpr size_t MI_MIN = MI_BL + (size_t)NBH * NCH * 4;
constexpr size_t MI_K = (MI_MIN + (size_t)NBH * NCH * 4 + 255) / 256 * 256;
constexpr size_t MI_V = MI_K + (size_t)MP * 64 * 2;
constexpr size_t MI_KI = MI_V + (size_t)MP * 64 * 2;
constexpr size_t MI_END = MI_KI + (size_t)MP * 32 * 2;
static_assert(MI_END <= (size_t)MP * D * 2, "mixer intermediates fit the MG region");
constexpr size_t MS_ROUTE = 0;
constexpr size_t MS_RW = MS_ROUTE + (size_t)M * 16;
constexpr size_t MS_ROWTOK = MS_RW + (size_t)M * 8;
constexpr size_t MS_ROWW = MS_ROWTOK + (size_t)XROWS * 4;
static_assert(MS_ROWW + (size_t)XROWS * 4 <= 4 * MiB, "misc");
constexpr int CW_BAR = 4096;
constexpr int CW_DSAQ = 20480;
constexpr int CW_MIXQ = 24576;
constexpr int CW_ECNT = 16384;

constexpr int LDS_BYTES = 163840, MISC_OFF = LDS_BYTES - 512;
constexpr int NWAVES = 8, NT = 512;
constexpr int NPHASE = 1 + 12 * DEPTH;

#define GAS __attribute__((address_space(1)))
#define LAS __attribute__((address_space(3)))
typedef unsigned short bf16;
typedef unsigned v4u __attribute__((ext_vector_type(4)));
typedef unsigned v2u __attribute__((ext_vector_type(2)));
typedef float f32x4 __attribute__((ext_vector_type(4)));
typedef float f32x16 __attribute__((ext_vector_type(16)));
typedef short bf16x8 __attribute__((ext_vector_type(8)));
#define LDS_WAIT() asm volatile("s_waitcnt lgkmcnt(0)" ::: "memory")
#define VM_WAIT() asm volatile("s_waitcnt vmcnt(0)" ::: "memory")
__device__ __forceinline__ unsigned f2bf(float f) { unsigned u = __builtin_bit_cast(unsigned, f); return (u + 0x7fffu + ((u >> 16) & 1u)) >> 16; }
__device__ __forceinline__ unsigned pk2(float lo, float hi) { return f2bf(lo) | (f2bf(hi) << 16); }
__device__ __forceinline__ float bf2f(bf16 v) { return __builtin_bit_cast(float, (unsigned)v << 16); }
__device__ __forceinline__ float bflo(unsigned w) { return __builtin_bit_cast(float, w << 16); }
__device__ __forceinline__ float bfhi(unsigned w) { return __builtin_bit_cast(float, w & 0xffff0000u); }
__device__ __forceinline__ float sigmoidf_(float x) { return __builtin_amdgcn_rcpf(1.0f + __expf(-x)); }
__device__ __forceinline__ float logsigf_(float x) { return fminf(x, 0.f) - __logf(1.0f + __expf(-fabsf(x))); }
__device__ __forceinline__ float siluf_(float x) { return x * __builtin_amdgcn_rcpf(1.0f + __expf(-x)); }
__device__ __forceinline__ float wave_sum(float v) {
#pragma unroll
    for (int o = 1; o < 64; o <<= 1) v += __shfl_xor(v, o);
    return v;
}
__device__ __forceinline__ float wave_max(float v) {
#pragma unroll
    for (int o = 1; o < 64; o <<= 1) v = fmaxf(v, __shfl_xor(v, o));
    return v;
}
template <int CTRL> __device__ __forceinline__ float dppf(float x) {
    return __builtin_bit_cast(float, __builtin_amdgcn_update_dpp(0, __builtin_bit_cast(int, x), CTRL, 0xF, 0xF, true));
}
__device__ __forceinline__ float sum8(float v) { v += dppf<0xB1>(v); v += dppf<0x4E>(v); v += dppf<0x141>(v); return v; }
__device__ __forceinline__ float wave_sum_fast(float v) {
    v += dppf<0xB1>(v); v += dppf<0x4E>(v); v += dppf<0x141>(v); v += dppf<0x140>(v);
    const int iv = __builtin_bit_cast(int, v);
    float r = (__builtin_bit_cast(float, __builtin_amdgcn_readlane(iv, 0)) + __builtin_bit_cast(float, __builtin_amdgcn_readlane(iv, 16))) +
              (__builtin_bit_cast(float, __builtin_amdgcn_readlane(iv, 32)) + __builtin_bit_cast(float, __builtin_amdgcn_readlane(iv, 48)));
    asm volatile("" : "+v"(r));
    return r;
}
__device__ __forceinline__ float max8(float v) { v = fmaxf(v, dppf<0xB1>(v)); v = fmaxf(v, dppf<0x4E>(v)); v = fmaxf(v, dppf<0x141>(v)); return v; }

struct Args { const float* in[41]; float* out; unsigned char* ws; int ph_lo, ph_hi; };
typedef const __attribute__((address_space(4))) Args CArgs;
__device__ __forceinline__ CArgs* opaque_args() { CArgs* p = (CArgs*)__builtin_amdgcn_kernarg_segment_ptr(); asm volatile("" : "+s"(p)); return p; }
enum { I_X = 0, I_META, I_LNIN_G, I_LNIN_B, I_RELB, I_WIN, I_RW_MU, I_RW_WUP, I_RW_W0, I_RW_AUP, I_RW_A0, I_RW_GUP, I_RW_KK, I_RW_KA, I_RW_RK, I_RW_GNG, I_RW_GNB,
       I_GLA_AUP, I_GLA_AB, I_GLA_NG, I_DSA_NG, I_DSA_WUK, I_DSA_WUV, I_ML_CW, I_ML_CB, I_ML_IB, I_ML_FB, I_ML_NG, I_WBR, I_WOUT, I_LN1G, I_LN1B,
       I_MOE_WGRP, I_MOE_BGRP, I_MOE_WRT, I_MOE_BRT, I_MOE_WG, I_MOE_WU, I_MOE_WD, I_LN2G, I_LN2B };

__device__ __forceinline__ void transpose_item(const float* W, int ld, bf16* WT, int K, int k0, int n0, int drow0, LAS float* scr, int lane) {
    { f32x4 t[8];
#pragma unroll
      for (int i = 0; i < 8; ++i) t[i] = *(const GAS f32x4*)(W + (size_t)(k0 + 8 * i + (lane >> 3)) * ld + n0 + 4 * (lane & 7));
#pragma unroll
      for (int i = 0; i < 8; ++i) { LAS float* d = scr + (8 * i + (lane >> 3)) * 33 + 4 * (lane & 7); d[0] = t[i].x; d[1] = t[i].y; d[2] = t[i].z; d[3] = t[i].w; } }
    LDS_WAIT(); asm volatile("" ::: "memory");
    const int c = lane & 7;
#pragma unroll
    for (int j = 0; j < 4; ++j) { const int n = (lane >> 3) + 8 * j; const LAS float* s = scr + (8 * c) * 33 + n;
        v4u o; o.x = pk2(s[0 * 33], s[1 * 33]); o.y = pk2(s[2 * 33], s[3 * 33]); o.z = pk2(s[4 * 33], s[5 * 33]); o.w = pk2(s[6 * 33], s[7 * 33]);
        *(v4u*)(WT + (size_t)(drow0 + n) * K + k0 + 8 * c) = o; }
    LDS_WAIT(); asm volatile("" ::: "memory");
}
constexpr int WI_1 = 16 * 110, WI_2 = 16 * 128, WI_3 = 4 * 128, WI_4 = 16 * 32, WI_5 = 16 * 256, WI_6 = 16 * 128, WI_ALL = WI_1 + WI_2 + WI_3 + WI_4 + WI_5 + WI_6;
__device__ __noinline__ void convert_weights(CArgs& a, int l, LAS unsigned char* lds, int gw, int ngw, int wave, int lane) {
    LAS float* scr = (LAS float*)(lds + wave * 16384);
    unsigned char* wb = a.ws + WS_W;
    const float* w_in = a.in[I_WIN] + (size_t)l * D * IN_COLS;
    const float* w_br = a.in[I_WBR] + (size_t)l * 4 * 256 * D;
    const float* w_out = a.in[I_WOUT] + (size_t)l * D * D;
    const float* w_g = a.in[I_MOE_WG] + (size_t)l * 16 * D * 256;
    const float* w_u = a.in[I_MOE_WU] + (size_t)l * 16 * D * 256;
    const float* w_d = a.in[I_MOE_WD] + (size_t)l * 16 * 256 * D;
    for (int it0 = gw; it0 < WI_ALL; it0 += ngw) {
        int it = it0;
        if (it < WI_1) { const int kb = it / 110, nb = it % 110; transpose_item(w_in, IN_COLS, (bf16*)(wb + W_IN), D, 64 * kb, 32 * nb, 32 * nb, scr, lane); continue; } it -= WI_1;
        if (it < WI_2) { const int kb = it / 128, nb = it % 128; transpose_item(w_in, IN_COLS, (bf16*)(wb + W_G), D, 64 * kb, C_MIXEND + 32 * nb, 32 * nb, scr, lane); continue; } it -= WI_2;
        if (it < WI_3) { const int i = it / 128, r = it % 128, kb = r / 32, nb = r % 32; transpose_item(w_br + (size_t)i * 256 * D, D, (bf16*)(wb + W_B) + (size_t)i * D * 256, 256, 64 * kb, 32 * nb, 32 * nb, scr, lane); continue; } it -= WI_3;
        if (it < WI_4) { const int kb = it / 32, nb = it % 32; transpose_item(w_out, D, (bf16*)(wb + W_O), D, 64 * kb, 32 * nb, 32 * nb, scr, lane); continue; } it -= WI_4;
        if (it < WI_5) { const int e = it / 256, r = it % 256, w = r / 128, r2 = r % 128, kb = r2 / 8, nb = r2 % 8;
            transpose_item((w ? w_u : w_g) + (size_t)e * D * 256, 256, (bf16*)(wb + W_GU), D, 64 * kb, 32 * nb, e * 512 + (nb / 4) * 256 + w * 128 + (nb % 4) * 32, scr, lane); continue; } it -= WI_5;
        { const int e = it / 128, r = it % 128, kb = r / 32, nb = r % 32; transpose_item(w_d + (size_t)e * 256 * D, D, (bf16*)(wb + W_D) + (size_t)e * D * 256, 256, 64 * kb, 32 * nb, 32 * nb, scr, lane); }
    }
    { v4u* z = (v4u*)((bf16*)(wb + W_IN) + (size_t)C_MIXEND * D); const int n16 = (PW - C_MIXEND) * D * 2 / 16;
      for (int i = gw * 64 + lane; i < n16; i += ngw * 64) z[i] = (v4u){0u, 0u, 0u, 0u}; }
}
__device__ __forceinline__ void ln_row_stats(f32x4 (&v)[4], float& mean, float& rstd) {
    float s = 0.f;
#pragma unroll
    for (int j = 0; j < 4; ++j) s += (v[j].x + v[j].y) + (v[j].z + v[j].w);
    mean = wave_sum_fast(s) * (1.f / D); float s2 = 0.f;
#pragma unroll
    for (int j = 0; j < 4; ++j) { const f32x4 d = v[j] - mean; s2 += (d.x * d.x + d.y * d.y) + (d.z * d.z + d.w * d.w); }
    rstd = __builtin_amdgcn_rsqf(wave_sum_fast(s2) * (1.f / D) + 1e-5f);
}
#define XB_TMO      128
#define XB_XCNT(j)  (256  + 64 * (j))
#define XB_XSUB(j)  (1280 + 64 * (j))
#define XB_XGEN(j)  (2304 + 64 * (j))
#define XB_TOP      3328
#define XB_TOPGEN   3392
#define XCD_BAR_WORDS 3456
#define XB_SPIN_CAP (1u << 22)

__device__ __forceinline__ unsigned xb_ld(unsigned* p)              { return __hip_atomic_load(p, __ATOMIC_RELAXED, __HIP_MEMORY_SCOPE_AGENT); }
__device__ __forceinline__ unsigned xb_add(unsigned* p, unsigned v) { return __hip_atomic_fetch_add(p, v, __ATOMIC_RELAXED, __HIP_MEMORY_SCOPE_AGENT); }
__device__ __forceinline__ unsigned xb_xcc_id() { return (unsigned)__builtin_amdgcn_s_getreg((3 << 11) | 20) & 0xFu; }
#define XB_SPIN(cond, bar) do { unsigned _sp = 0; while (cond) { __builtin_amdgcn_s_sleep(1); \
    if ((++_sp & 255u) == 0u) { if (xb_ld(&(bar)[XB_TMO])) break; if (_sp > XB_SPIN_CAP) { atomicAdd(&(bar)[XB_TMO], 1u); break; } } } } while (0)

struct XcdBarrier {
    unsigned* bar; unsigned x;
    volatile LAS unsigned* st;
};

__device__ __forceinline__ XcdBarrier xcd_barrier_post(unsigned* bar, volatile LAS unsigned* st) {
    XcdBarrier b; b.bar = bar; b.x = xb_xcc_id(); b.st = st;
    if (threadIdx.x == 0) (void)xb_add(&bar[XB_XCNT(b.x)], 1u);
    return b;
}
__device__ __forceinline__ void xcd_barrier_complete(unsigned* bar, unsigned x, unsigned& nloc, unsigned& nx) {
    const unsigned G = gridDim.x * gridDim.y * gridDim.z;
    unsigned sum, cnt, mine, sp = 0u;
    for (;;) {
        sum = 0u; cnt = 0u; mine = 0u;
#pragma unroll
        for (unsigned j = 0; j < 16; ++j) { const unsigned c = xb_ld(&bar[XB_XCNT(j)]); sum += c; cnt += (c > 0u) ? 1u : 0u; mine = (j == x) ? c : mine; }
        if (sum == G) break;
        __builtin_amdgcn_s_sleep(1);
        if ((++sp & 255u) == 0u) { if (xb_ld(&bar[XB_TMO])) break; if (sp > XB_SPIN_CAP) { atomicAdd(&bar[XB_TMO], 1u); break; } }
    }
    nloc = mine > 0u ? mine : 1u; nx = cnt > 0u ? cnt : 1u;
}

__device__ __forceinline__ void xcd_barrier(const XcdBarrier& b) {
    asm volatile("s_waitcnt vmcnt(0)" ::: "memory");
    __syncthreads();
    if (threadIdx.x == 0) {
        unsigned* bar = b.bar;
        __builtin_amdgcn_s_waitcnt(0);
        unsigned nloc = b.st[0], nx = b.st[1];
        if (nloc == 0u) { xcd_barrier_complete(bar, b.x, nloc, nx); b.st[0] = nloc; b.st[1] = nx; }
        const unsigned old = xb_add(&bar[XB_XSUB(b.x)], 1u);
        const unsigned gen = old / nloc;
        if (old + 1u == (gen + 1u) * nloc) {
            __builtin_amdgcn_fence(__ATOMIC_RELEASE, "agent");
            asm volatile("s_waitcnt vmcnt(0)" ::: "memory");
            const unsigned og = xb_add(&bar[XB_TOP], 1u);
            const unsigned tg = og / nx;
            if (og + 1u == (tg + 1u) * nx) xb_add(&bar[XB_TOPGEN], 1u);
            else XB_SPIN(xb_ld(&bar[XB_TOPGEN]) == tg, bar);
            __builtin_amdgcn_fence(__ATOMIC_ACQUIRE, "agent");
            xb_add(&bar[XB_XGEN(b.x)], 1u);
            asm volatile("s_waitcnt vmcnt(0)" ::: "memory");
        } else {
            XB_SPIN(xb_ld(&bar[XB_XGEN(b.x)]) == gen, bar);
            __builtin_amdgcn_fence(__ATOMIC_ACQUIRE, "agent");
            asm volatile("s_waitcnt vmcnt(0)" ::: "memory");
        }
    }
    __syncthreads();
}
constexpr int RL = 68;
__device__ __forceinline__ bf16x8 rw_frag(const LAS float* p) {
    const f32x4 x = *(const LAS f32x4*)p, y = *(const LAS f32x4*)(p + 4);
    const v4u w = (v4u){pg8::cvt_pk_bf16(x.x, x.y), pg8::cvt_pk_bf16(x.z, x.w), pg8::cvt_pk_bf16(y.x, y.y), pg8::cvt_pk_bf16(y.z, y.w)};
    return __builtin_bit_cast(bf16x8, w);
}
__device__ __forceinline__ void rw_mma(f32x4 (&acc)[2], const LAS float* A, const LAS float* Bk, int lane, int wave) {
    const int tm = wave >> 1, tn0 = (wave & 1) * 2, l15 = lane & 15, kq = lane >> 4;
#pragma unroll
    for (int ks = 0; ks < 2; ++ks) { const bf16x8 af = rw_frag(A + (16 * tm + l15) * RL + 32 * ks + 8 * kq);
#pragma unroll
        for (int t = 0; t < 2; ++t) { const bf16x8 bf = rw_frag(Bk + (16 * (tn0 + t) + l15) * RL + 32 * ks + 8 * kq);
            acc[t] = __builtin_amdgcn_mfma_f32_16x16x32_bf16(af, bf, acc[t], 0, 0, 0); } }
}
#define RW_ZERO(acc) do { acc[0] = (f32x4){0.f, 0.f, 0.f, 0.f}; acc[1] = (f32x4){0.f, 0.f, 0.f, 0.f}; } while (0)
#define RW_FOREACH(acc, ROW, COL, VAL, BODY) do { _Pragma("unroll") for (int t_ = 0; t_ < 2; ++t_) _Pragma("unroll") for (int r_ = 0; r_ < 4; ++r_) { \
    const int ROW = 16 * (wave >> 1) + 4 * (lane >> 4) + r_, COL = 16 * ((wave & 1) * 2 + t_) + (lane & 15); const float VAL = acc[t_][r_]; BODY } } while (0)

__device__ __forceinline__ void rw_mma32(f32x4 (&acc)[2], const LAS float* A, const LAS float* Bk, int lane, int wave) {
    const int tm = wave >> 1, tn0 = (wave & 1) * 2, l15 = lane & 15, kq = lane >> 4;
    const bf16x8 af = rw_frag(A + (16 * tm + l15) * RL + 8 * kq);
#pragma unroll
    for (int t = 0; t < 2; ++t) { const bf16x8 bf = rw_frag(Bk + (16 * (tn0 + t) + l15) * RL + 8 * kq);
        acc[t] = __builtin_amdgcn_mfma_f32_16x16x32_bf16(af, bf, acc[t], 0, 0, 0); }
}

template <int NK> __device__ __forceinline__ void mm8(float (&acc)[8], const LAS float* A, const LAS float* B, int ldb) {
#pragma unroll 8
    for (int k = 0; k < NK; ++k) {
        const float av = A[k]; const f32x4 b0 = *(const LAS f32x4*)(B + k * ldb), b1 = *(const LAS f32x4*)(B + k * ldb + 4);
        acc[0] += av * b0.x; acc[1] += av * b0.y; acc[2] += av * b0.z; acc[3] += av * b0.w;
        acc[4] += av * b1.x; acc[5] += av * b1.y; acc[6] += av * b1.z; acc[7] += av * b1.w;
    }
}
template <int NK> __device__ __forceinline__ void mm4(float (&acc)[4], const LAS float* A, const LAS float* B, int ldb) {
#pragma unroll 8
    for (int k = 0; k < NK; ++k) {
        const float av = A[k]; const f32x4 b0 = *(const LAS f32x4*)(B + k * ldb);
        acc[0] += av * b0.x; acc[1] += av * b0.y; acc[2] += av * b0.z; acc[3] += av * b0.w;
    }
}

__device__ __forceinline__ void ld8(const bf16* P, int b, int t, int col, float (&v)[8]) {
    v4u x = (v4u){0u, 0u, 0u, 0u};
    if (t >= 0) x = *(const GAS v4u*)(P + (size_t)(b * T + t) * PW + col);
    v[0] = bflo(x.x); v[1] = bfhi(x.x); v[2] = bflo(x.y); v[3] = bfhi(x.y); v[4] = bflo(x.z); v[5] = bfhi(x.z); v[6] = bflo(x.w); v[7] = bfhi(x.w);
}
__device__ __forceinline__ v4u ld8raw(const bf16* P, int b, int t, int col) { v4u x = (v4u){0u, 0u, 0u, 0u}; if (t >= 0) x = *(const GAS v4u*)(P + (size_t)(b * T + t) * PW + col); return x; }
__device__ __forceinline__ void unpack8(const v4u x, float (&v)[8]) { v[0] = bflo(x.x); v[1] = bfhi(x.x); v[2] = bflo(x.y); v[3] = bfhi(x.y); v[4] = bflo(x.z); v[5] = bfhi(x.z); v[6] = bflo(x.w); v[7] = bfhi(x.w); }
__device__ __forceinline__ void st8f(LAS float* dst, const v4u x) { *(LAS f32x4*)dst = (f32x4){bflo(x.x), bfhi(x.x), bflo(x.y), bfhi(x.y)}; *(LAS f32x4*)(dst + 4) = (f32x4){bflo(x.z), bfhi(x.z), bflo(x.w), bfhi(x.w)}; }
__device__ __forceinline__ float wave_scan(float v, int lane) {
    v += dppf<0x111>(v); v += dppf<0x112>(v); v += dppf<0x114>(v); v += dppf<0x118>(v);
    const int iv = __builtin_bit_cast(int, v);
    const float t0 = __builtin_bit_cast(float, __builtin_amdgcn_readlane(iv, 15)), t1 = __builtin_bit_cast(float, __builtin_amdgcn_readlane(iv, 31)), t2 = __builtin_bit_cast(float, __builtin_amdgcn_readlane(iv, 47));
    const int row = lane >> 4;
    return v + (row == 0 ? 0.f : row == 1 ? t0 : row == 2 ? t0 + t1 : (t0 + t1) + t2);
}
__device__ __forceinline__ void gla_front(CArgs& a, int l, int b, int h, int c, LAS float* XA, LAS float* LA, LAS float* AU, int tid) {
    const bf16* P = (const bf16*)(a.ws + WS_R + R_P);
    const float* a_up = a.in[I_GLA_AUP] + (size_t)l * 16 * 128; const float* a_b = a.in[I_GLA_AB] + (size_t)l * 128;
    if (tid < 128) { const int j = tid >> 1, p8 = tid & 1; float v[8]; ld8(P, b, 64 * c - PADT + j, C_GLA + 512 + 8 * p8, v);
#pragma unroll
        for (int e = 0; e < 8; ++e) XA[j * 16 + 8 * p8 + e] = v[e]; }
    AU[tid] = a_up[(tid >> 5) * 128 + h * 32 + (tid & 31)];
    if (tid < 32) AU[512 + tid] = a_b[h * 32 + tid];
    __syncthreads();
    { const int j = tid >> 3, d4 = (tid & 7) * 4, t = 64 * c - PADT + j;
      f32x4 z = *(const LAS f32x4*)(AU + 512 + d4);
#pragma unroll
      for (int q4 = 0; q4 < 4; ++q4) { const f32x4 xa = *(const LAS f32x4*)(XA + j * 16 + 4 * q4);
          z += xa.x * *(const LAS f32x4*)(AU + (4 * q4 + 0) * 32 + d4); z += xa.y * *(const LAS f32x4*)(AU + (4 * q4 + 1) * 32 + d4);
          z += xa.z * *(const LAS f32x4*)(AU + (4 * q4 + 2) * 32 + d4); z += xa.w * *(const LAS f32x4*)(AU + (4 * q4 + 3) * 32 + d4); }
      LA[j * 33 + d4 + 0] = t >= 0 ? logsigf_(z.x) * (1.0f / 16.0f) : 0.f; LA[j * 33 + d4 + 1] = t >= 0 ? logsigf_(z.y) * (1.0f / 16.0f) : 0.f;
      LA[j * 33 + d4 + 2] = t >= 0 ? logsigf_(z.z) * (1.0f / 16.0f) : 0.f; LA[j * 33 + d4 + 3] = t >= 0 ? logsigf_(z.w) * (1.0f / 16.0f) : 0.f; }
    __syncthreads();
    { const int lane = tid & 63, wave = tid >> 6;
#pragma unroll
      for (int i = 0; i < 4; ++i) { const int d = wave + 8 * i; LA[lane * 33 + d] = wave_scan(LA[lane * 33 + d], lane); } }
    __syncthreads();
}
__device__ __noinline__ void gla_stage1(CArgs& a, int l, int item, LAS unsigned char* lds, int tid) {
    const int c = item % NCH, bh = item / NCH, b = bh >> 2, h = bh & 3;
    LAS float* XA = (LAS float*)lds; LAS float* LA = XA + 1024; LAS float* KL = LA + 64 * 33; LAS float* V = KL + 32 * 65; LAS float* AU = V + 64 * 64;
    const bf16* P = (const bf16*)(a.ws + WS_R + R_P);
    const v4u kraw = ld8raw(P, b, 64 * c - PADT + ((tid & 255) >> 2), C_GLA + 128 + h * 32 + 8 * (tid & 3));
    const v4u vraw = ld8raw(P, b, 64 * c - PADT + (tid >> 3), C_GLA + 256 + h * 64 + 8 * (tid & 7));
    gla_front(a, l, b, h, c, XA, LA, AU, tid);
    if (tid < 256) { const int j = tid >> 2, p8 = tid & 3; float v[8]; unpack8(kraw, v);
#pragma unroll
        for (int e = 0; e < 8; ++e) { const int d = 8 * p8 + e; KL[d * 65 + j] = v[e] * __expf(LA[63 * 33 + d] - LA[j * 33 + d]); } }
    st8f(V + (tid >> 3) * 64 + 8 * (tid & 7), vraw);
    __syncthreads();
    { const int d = tid >> 4, e0 = (tid & 15) * 4; float acc[4] = {0.f, 0.f, 0.f, 0.f};
      mm4<64>(acc, KL + d * 65, V + e0, 64);
      float* U = (float*)(a.ws + WS_MG + MI_GU) + (size_t)item * 2048;
      *(f32x4*)(U + d * 64 + e0) = (f32x4){acc[0], acc[1], acc[2], acc[3]}; }
    if (tid < 32) ((float*)(a.ws + WS_MG + MI_GDEC))[(size_t)item * 32 + tid] = __expf(LA[63 * 33 + tid]);
    __syncthreads();
}
__device__ __noinline__ void gla_scan(CArgs& a, int item, int tid) {
    const int bh = item >> 2, idx = (item & 3) * 512 + tid, d = idx >> 6;
    GAS float* U = (GAS float*)(a.ws + WS_MG + MI_GU) + (size_t)bh * NCH * 2048 + idx;
    const GAS float* DEC = (const GAS float*)(a.ws + WS_MG + MI_GDEC) + (size_t)bh * NCH * 32 + d;
    float s = 0.f;
    for (int cb = 0; cb < NCH; cb += 16) {
        float u[16], dc[16];
#pragma unroll
        for (int i = 0; i < 16; ++i) { u[i] = 0.f; dc[i] = 0.f; if (cb + i < NCH) { u[i] = U[(size_t)(cb + i) * 2048]; dc[i] = DEC[(cb + i) * 32]; } }
#pragma unroll
        for (int i = 0; i < 16; ++i) if (cb + i < NCH) { U[(size_t)(cb + i) * 2048] = s; s = dc[i] * s + u[i]; }
    }
}
__device__ __noinline__ void gla_stage2(CArgs& a, int l, int item, LAS unsigned char* lds, int tid) {
    const int c = item % NCH, bh = item / NCH, b = bh >> 2, h = bh & 3, lane = tid & 63, wave = tid >> 6;
    LAS float* QG = (LAS float*)lds; LAS float* KG = QG + 64 * RL; LAS float* VT = KG + 64 * RL; LAS float* ST = VT + 64 * RL; LAS float* ATT = ST + 64 * RL; LAS float* O = ATT + 64 * RL;
    LAS float* XA = O + 64 * RL; LAS float* LA = XA + 1024; LAS float* AU = LA + 64 * 33;
    const bf16* P = (const bf16*)(a.ws + WS_R + R_P);
    const int j = tid >> 3, e0 = (tid & 7) * 8;
    const v4u qkraw = ld8raw(P, b, 64 * c - PADT + ((tid & 255) >> 2), C_GLA + (tid >> 8) * 128 + h * 32 + 8 * (tid & 3));
    const v4u vraw = ld8raw(P, b, 64 * c - PADT + j, C_GLA + 256 + h * 64 + e0);
    const f32x4 uraw = ((const GAS f32x4*)((const float*)(a.ws + WS_MG + MI_GU) + (size_t)item * 2048))[tid];
    const v4u ogv = ld8raw(P, b, 64 * c - PADT + j, C_GLA + 528 + h * 64 + e0);
    gla_front(a, l, b, h, c, XA, LA, AU, tid);
    { const int which = tid >> 8, jq = (tid & 255) >> 2, p8 = tid & 3; float v[8]; unpack8(qkraw, v);
#pragma unroll
      for (int e = 0; e < 8; ++e) { const int d = 8 * p8 + e; const float bb = LA[jq * 33 + d];
          if (which == 0) QG[jq * RL + d] = v[e] * 0.17677669529663687f * __expf(bb); else KG[jq * RL + d] = v[e] * __expf(-bb); } }
    { float v[8]; unpack8(vraw, v);
#pragma unroll
      for (int e = 0; e < 8; ++e) VT[(e0 + e) * RL + j] = v[e]; }
    { const int d0 = tid >> 4, e4 = (tid & 15) * 4;
      ST[(e4 + 0) * RL + d0] = uraw.x; ST[(e4 + 1) * RL + d0] = uraw.y; ST[(e4 + 2) * RL + d0] = uraw.z; ST[(e4 + 3) * RL + d0] = uraw.w; }
    __syncthreads();
    { f32x4 at[2]; RW_ZERO(at);
      rw_mma32(at, QG, KG, lane, wave);
      RW_FOREACH(at, rr, cc, vv, ATT[rr * RL + cc] = (cc <= rr) ? vv : 0.f;); }
    __syncthreads();
    { f32x4 o2[2]; RW_ZERO(o2);
      rw_mma(o2, ATT, VT, lane, wave);
      rw_mma32(o2, QG, ST, lane, wave);
      RW_FOREACH(o2, rr, cc, vv, O[rr * RL + cc] = vv;); }
    __syncthreads();
    float o[8];
#pragma unroll
    for (int i = 0; i < 8; ++i) o[i] = O[j * RL + e0 + i];
    float ss = 0.f;
#pragma unroll
    for (int i = 0; i < 8; ++i) ss += o[i] * o[i];
    ss = sum8(ss);
    const float rinv = __builtin_amdgcn_rsqf(ss * (1.0f / 64.0f) + 1e-6f);
    const int t = 64 * c - PADT + j;
    if (t >= 0) {
        const float* ng = a.in[I_GLA_NG] + (size_t)l * 64 + e0;
        const float g0 = siluf_(bflo(ogv.x)), g1 = siluf_(bfhi(ogv.x)), g2 = siluf_(bflo(ogv.y)), g3 = siluf_(bfhi(ogv.y)), g4 = siluf_(bflo(ogv.z)), g5 = siluf_(bfhi(ogv.z)), g6 = siluf_(bflo(ogv.w)), g7 = siluf_(bfhi(ogv.w));
        v4u w; w.x = pk2(o[0] * rinv * ng[0] * g0, o[1] * rinv * ng[1] * g1); w.y = pk2(o[2] * rinv * ng[2] * g2, o[3] * rinv * ng[3] * g3);
        w.z = pk2(o[4] * rinv * ng[4] * g4, o[5] * rinv * ng[5] * g5); w.w = pk2(o[6] * rinv * ng[6] * g6, o[7] * rinv * ng[7] * g7);
        bf16* Y = (bf16*)(a.ws + WS_Y) + (size_t)1 * MP * 256;
        *(GAS v4u*)(Y + (size_t)(b * T + t) * 256 + h * 64 + e0) = w;
    }
    __syncthreads();
}

struct MlRaw { v4u p0, p1; float cwv; };
__device__ __forceinline__ void ml_req_raw(CArgs& a, int l, const bf16* P, int b, int h, int c, int which, int tid, MlRaw& r) {
    const float* cw = a.in[I_ML_CW] + (size_t)l * 4 * 512 + which * 256 + h * 64; const float* cb = a.in[I_ML_CB] + (size_t)l * 512 + which * 256 + h * 64;
    r.p0 = ld8raw(P, b, 64 * c - PADT - 3 + (tid >> 3), C_ML + which * 256 + h * 64 + 8 * (tid & 7));
    r.p1 = (v4u){0u, 0u, 0u, 0u}; if (tid < 67 * 8 - NT) r.p1 = ld8raw(P, b, 64 * c - PADT - 3 + 64 + (tid >> 3), C_ML + which * 256 + h * 64 + 8 * (tid & 7));
    r.cwv = 0.f; if (tid < 256) r.cwv = cw[(tid >> 6) * 512 + (tid & 63)]; else if (tid < 320) r.cwv = cb[tid - 256];
}
__device__ __forceinline__ void ml_put_raw(const MlRaw& r, LAS float* RAW, LAS float* CW, int tid) {
    st8f(RAW + (tid >> 3) * 64 + 8 * (tid & 7), r.p0);
    if (tid < 67 * 8 - NT) st8f(RAW + (64 + (tid >> 3)) * 64 + 8 * (tid & 7), r.p1);
    if (tid < 320) CW[tid] = r.cwv;
}
__device__ __forceinline__ float ml_conv_at(const LAS float* RAW, const LAS float* CW, int j, int d) {
    float s = CW[256 + d];
#pragma unroll
    for (int i = 0; i < 4; ++i) s += CW[i * 64 + d] * RAW[(j + i) * 64 + d];
    return siluf_(s);
}
__device__ __forceinline__ void ml_conv8(const LAS float* RAW, const LAS float* CW, int j, int d8, float (&o)[8]) {
    { const f32x4 b0 = *(const LAS f32x4*)(CW + 256 + d8), b1 = *(const LAS f32x4*)(CW + 256 + d8 + 4); o[0] = b0.x; o[1] = b0.y; o[2] = b0.z; o[3] = b0.w; o[4] = b1.x; o[5] = b1.y; o[6] = b1.z; o[7] = b1.w; }
#pragma unroll
    for (int i = 0; i < 4; ++i) { const f32x4 w0 = *(const LAS f32x4*)(CW + i * 64 + d8), w1 = *(const LAS f32x4*)(CW + i * 64 + d8 + 4), x0 = *(const LAS f32x4*)(RAW + (j + i) * 64 + d8), x1 = *(const LAS f32x4*)(RAW + (j + i) * 64 + d8 + 4);
        o[0] += w0.x * x0.x; o[1] += w0.y * x0.y; o[2] += w0.z * x0.z; o[3] += w0.w * x0.w; o[4] += w1.x * x1.x; o[5] += w1.y * x1.y; o[6] += w1.z * x1.z; o[7] += w1.w * x1.w; }
#pragma unroll
    for (int i = 0; i < 8; ++i) o[i] = siluf_(o[i]);
}
__device__ __forceinline__ void ml_req_gates(const bf16* P, int b, int h, int c, int tid, unsigned& gi, unsigned& gf) {
    gi = 0u; gf = 0u; const int t = 64 * c - PADT + tid;
    if (tid < 64 && t >= 0) { const bf16* pr = P + (size_t)(b * T + t) * PW + C_ML; gi = pr[768 + h]; gf = pr[772 + h]; }
}
__device__ __forceinline__ void ml_gates(CArgs& a, int l, int h, int c, unsigned gi, unsigned gf, LAS float* LI, LAS float* BC, int tid) {
    if (tid < 64) { const int t = 64 * c - PADT + tid; float li = -1e30f, lf = 0.f;
        if (t >= 0) { li = bf2f((bf16)gi) + a.in[I_ML_IB][l * 4 + h]; lf = logsigf_(bf2f((bf16)gf) + a.in[I_ML_FB][l * 4 + h]); }
        LI[tid] = li; BC[tid] = wave_scan(lf, tid); }
    __syncthreads();
}
__device__ __noinline__ void ml_stage1(CArgs& a, int l, int item, LAS unsigned char* lds, int tid) {
    const int c = item % NCH, bh = item / NCH, b = bh >> 2, h = bh & 3;
    const int lane = tid & 63, wave = tid >> 6;
    LAS float* KW = (LAS float*)lds; LAS float* VT = KW + 64 * RL; LAS float* RAW = VT + 64 * RL; LAS float* CW = RAW + 67 * 64;
    LAS float* LI = CW + 320; LAS float* BC = LI + 64; LAS float* WL = BC + 64;
    const bf16* P = (const bf16*)(a.ws + WS_R + R_P);
    MlRaw rk; unsigned gi, gf;
    ml_req_raw(a, l, P, b, h, c, 1, tid, rk);
    const v4u vraw = ld8raw(P, b, 64 * c - PADT + (tid >> 3), C_ML + 512 + h * 64 + 8 * (tid & 7));
    ml_req_gates(P, b, h, c, tid, gi, gf);
    ml_put_raw(rk, RAW, CW, tid);
    { const int jv = tid >> 3, e8 = (tid & 7) * 8; float v[8]; unpack8(vraw, v);
#pragma unroll
      for (int e = 0; e < 8; ++e) VT[(e8 + e) * RL + jv] = v[e]; }
    ml_gates(a, l, h, c, gi, gf, LI, BC, tid);
    if (tid < 64) {
        const float g = BC[63] - BC[tid] + LI[tid]; const float mloc = wave_max(g); WL[tid] = __expf(g - mloc);
        if (tid == 0) { ((float*)(a.ws + WS_MG + MI_ML))[item] = mloc; ((float*)(a.ws + WS_MG + MI_BL))[item] = BC[63]; }
    }
    __syncthreads();
    { const int j = tid >> 3, d8 = (tid & 7) * 8; float kc[8];
      if (64 * c - PADT + j >= 0) ml_conv8(RAW, CW, j, d8, kc); else {
#pragma unroll
          for (int i = 0; i < 8; ++i) kc[i] = 0.f; }
      const float wl = WL[j] * 0.125f;
#pragma unroll
      for (int i = 0; i < 8; ++i) KW[(d8 + i) * RL + j] = kc[i] * wl; }
    __syncthreads();
    { f32x4 cl[2]; RW_ZERO(cl);
      rw_mma(cl, KW, VT, lane, wave);
      GAS float* CL = (GAS float*)(a.ws + WS_MG + MI_MC) + (size_t)item * 4096;
      RW_FOREACH(cl, rr, cc, vv, CL[rr * 64 + cc] = vv;); }
    { const int d = tid >> 3, p8 = (tid & 7) * 8; const f32x4 x = *(const LAS f32x4*)(KW + d * RL + p8), y = *(const LAS f32x4*)(KW + d * RL + p8 + 4);
      const float s = sum8((x.x + x.y) + (x.z + x.w) + (y.x + y.y) + (y.z + y.w));
      if ((tid & 7) == 0) ((float*)(a.ws + WS_MG + MI_MN))[(size_t)item * 64 + d] = s; }
    __syncthreads();
}
__device__ __noinline__ void ml_scan(CArgs& a, int item, int tid) {
    const int bh = item >> 3, sub = item & 7, idx = sub * 512 + tid;
    GAS float* CL = (GAS float*)(a.ws + WS_MG + MI_MC) + (size_t)bh * NCH * 4096 + idx;
    GAS float* NL = (GAS float*)(a.ws + WS_MG + MI_MN) + (size_t)bh * NCH * 64 + tid;
    const GAS float* ML = (const GAS float*)(a.ws + WS_MG + MI_ML) + bh * NCH; const GAS float* BL = (const GAS float*)(a.ws + WS_MG + MI_BL) + bh * NCH;
    GAS float* MIN = (GAS float*)(a.ws + WS_MG + MI_MIN) + bh * NCH;
    const bool do_n = (sub == 0 && tid < 64);
    float cs = 0.f, ns = 0.f, ms = 0.f;
    for (int cb = 0; cb < NCH; cb += 16) {
        float blv[16], mlv[16], clv[16], nlv[16];
#pragma unroll
        for (int i = 0; i < 16; ++i) { blv[i] = 0.f; mlv[i] = 0.f; clv[i] = 0.f; nlv[i] = 0.f;
            if (cb + i < NCH) { blv[i] = BL[cb + i]; mlv[i] = ML[cb + i]; clv[i] = CL[(size_t)(cb + i) * 4096]; if (do_n) nlv[i] = NL[(cb + i) * 64]; } }
#pragma unroll
        for (int i = 0; i < 16; ++i) if (cb + i < NCH) { const int c = cb + i; const float bl = blv[i], ml = mlv[i], cl = clv[i], nl = nlv[i];
            CL[(size_t)c * 4096] = cs; if (do_n) NL[c * 64] = ns; if (sub == 0 && tid == 0) MIN[c] = ms;
            const float mn = fmaxf(bl + ms, ml), so = __expf(bl + ms - mn), sn = __expf(ml - mn);
            cs = so * cs + sn * cl; ns = so * ns + sn * nl; ms = mn; }
    }
}
__device__ __noinline__ void ml_stage2(CArgs& a, int l, int item, LAS unsigned char* lds, int tid) {
    const int c = item % NCH, bh = item / NCH, b = bh >> 2, h = bh & 3, lane = tid & 63, wave = tid >> 6;
    LAS float* Q = (LAS float*)lds; LAS float* K = Q + 64 * RL; LAS float* VT = K + 64 * RL; LAS float* CT = VT + 64 * RL; LAS float* SW = CT + 64 * RL; LAS float* H = SW + 64 * RL;
    LAS float* RAWQ = H + 64 * RL; LAS float* RAWK = RAWQ + 67 * 64; LAS float* CWQ = RAWK + 67 * 64; LAS float* CWK = CWQ + 320;
    LAS float* LI = CWK + 320; LAS float* BC = LI + 64; LAS float* NIN = BC + 64; LAS float* MT = NIN + 64; LAS float* WI = MT + 64; LAS float* DINV = WI + 64;
    const bf16* P = (const bf16*)(a.ws + WS_R + R_P);
    MlRaw rq, rk; unsigned gi, gf;
    ml_req_raw(a, l, P, b, h, c, 0, tid, rq);
    ml_req_raw(a, l, P, b, h, c, 1, tid, rk);
    const v4u vraw = ld8raw(P, b, 64 * c - PADT + (tid >> 3), C_ML + 512 + h * 64 + 8 * (tid & 7));
    const GAS f32x4* CL = (const GAS f32x4*)((const float*)(a.ws + WS_MG + MI_MC) + (size_t)item * 4096);
    const f32x4 cin0 = CL[tid], cin1 = CL[512 + tid];
    float ninv = 0.f; if (tid < 64) ninv = ((const float*)(a.ws + WS_MG + MI_MN))[(size_t)item * 64 + tid];
    const float m_in = ((const float*)(a.ws + WS_MG + MI_MIN))[item];
    ml_req_gates(P, b, h, c, tid, gi, gf);
    const v4u ogv = ld8raw(P, b, 64 * c - PADT + (tid >> 3), C_ML + 776 + h * 64 + 8 * (tid & 7));
    ml_put_raw(rq, RAWQ, CWQ, tid);
    ml_put_raw(rk, RAWK, CWK, tid);
    { const int jv = tid >> 3, e8 = (tid & 7) * 8; float v[8]; unpack8(vraw, v);
#pragma unroll
      for (int e = 0; e < 8; ++e) VT[(e8 + e) * RL + jv] = v[e]; }
    { const int d0 = tid >> 4, e4 = (tid & 15) * 4;
      CT[(e4 + 0) * RL + d0] = cin0.x; CT[(e4 + 1) * RL + d0] = cin0.y; CT[(e4 + 2) * RL + d0] = cin0.z; CT[(e4 + 3) * RL + d0] = cin0.w;
      CT[(e4 + 0) * RL + 32 + d0] = cin1.x; CT[(e4 + 1) * RL + 32 + d0] = cin1.y; CT[(e4 + 2) * RL + 32 + d0] = cin1.z; CT[(e4 + 3) * RL + 32 + d0] = cin1.w; }
    if (tid < 64) NIN[tid] = ninv;
    ml_gates(a, l, h, c, gi, gf, LI, BC, tid);
    const int j = tid >> 3, e0 = (tid & 7) * 8;
    { float qc[8], kc[8];
      if (64 * c - PADT + j >= 0) { ml_conv8(RAWQ, CWQ, j, e0, qc); ml_conv8(RAWK, CWK, j, e0, kc); } else {
#pragma unroll
          for (int i = 0; i < 8; ++i) { qc[i] = 0.f; kc[i] = 0.f; } }
      *(LAS f32x4*)(Q + j * RL + e0) = (f32x4){qc[0], qc[1], qc[2], qc[3]}; *(LAS f32x4*)(Q + j * RL + e0 + 4) = (f32x4){qc[4], qc[5], qc[6], qc[7]};
      *(LAS f32x4*)(K + j * RL + e0) = (f32x4){kc[0] * 0.125f, kc[1] * 0.125f, kc[2] * 0.125f, kc[3] * 0.125f}; *(LAS f32x4*)(K + j * RL + e0 + 4) = (f32x4){kc[4] * 0.125f, kc[5] * 0.125f, kc[6] * 0.125f, kc[7] * 0.125f}; }
    {
      const float bj = BC[j]; float mx = -INFINITY;
#pragma unroll
      for (int i = 0; i < 8; ++i) { const int s = e0 + i; mx = fmaxf(mx, (s <= j) ? (bj - BC[s] + LI[s]) : -INFINITY); }
      mx = max8(mx);
      const float inter = bj + m_in, mt = fmaxf(inter, mx);
      if ((tid & 7) == 0) { MT[j] = mt; WI[j] = __expf(inter - mt); } }
    __syncthreads();
    { f32x4 qk[2]; RW_ZERO(qk);
      rw_mma(qk, Q, K, lane, wave);
      RW_FOREACH(qk, rr, cc, vv, SW[rr * RL + cc] = (cc <= rr) ? __expf(BC[rr] - BC[cc] + LI[cc] - MT[rr]) * vv : 0.f;); }
    __syncthreads();
    { float dsum = 0.f, qn = 0.f;
#pragma unroll
      for (int i = 0; i < 8; ++i) { dsum += SW[j * RL + e0 + i]; qn += Q[j * RL + e0 + i] * NIN[e0 + i]; }
      dsum = sum8(dsum); qn = sum8(qn);
      const float den = dsum + WI[j] * qn;
      if ((tid & 7) == 0) DINV[j] = __builtin_amdgcn_rcpf(fmaxf(fabsf(den), __expf(-MT[j]))); }
    { f32x4 num[2], qc[2]; RW_ZERO(num); RW_ZERO(qc);
      rw_mma(num, SW, VT, lane, wave);
      rw_mma(qc, Q, CT, lane, wave);
#pragma unroll
      for (int t_ = 0; t_ < 2; ++t_)
#pragma unroll
          for (int r_ = 0; r_ < 4; ++r_) { const int rr = 16 * (wave >> 1) + 4 * (lane >> 4) + r_, cc = 16 * ((wave & 1) * 2 + t_) + (lane & 15); H[rr * RL + cc] = num[t_][r_] + WI[rr] * qc[t_][r_]; } }
    __syncthreads();
    const float dinv = DINV[j];
    const int t = 64 * c - PADT + j;
    float hv[8]; float s1 = 0.f;
    if (t >= 0) {
        const float og[8] = {bflo(ogv.x), bfhi(ogv.x), bflo(ogv.y), bfhi(ogv.y), bflo(ogv.z), bfhi(ogv.z), bflo(ogv.w), bfhi(ogv.w)};
#pragma unroll
        for (int i = 0; i < 8; ++i) { hv[i] = H[j * RL + e0 + i] * dinv * sigmoidf_(og[i]); s1 += hv[i]; }
    } else {
#pragma unroll
        for (int i = 0; i < 8; ++i) hv[i] = 0.f;
    }
    const float mean = sum8(s1) * (1.0f / 64.0f); float s2 = 0.f;
#pragma unroll
    for (int i = 0; i < 8; ++i) { hv[i] -= mean; s2 += hv[i] * hv[i]; }
    const float rstd = __builtin_amdgcn_rsqf(sum8(s2) * (1.0f / 64.0f) + 1e-5f);
    if (t >= 0) {
        const float* ng = a.in[I_ML_NG] + (size_t)l * 256 + h * 64 + e0;
        v4u w; w.x = pk2(hv[0] * rstd * ng[0], hv[1] * rstd * ng[1]); w.y = pk2(hv[2] * rstd * ng[2], hv[3] * rstd * ng[3]);
        w.z = pk2(hv[4] * rstd * ng[4], hv[5] * rstd * ng[5]); w.w = pk2(hv[6] * rstd * ng[6], hv[7] * rstd * ng[7]);
        bf16* Y = (bf16*)(a.ws + WS_Y) + (size_t)3 * MP * 256;
        *(GAS v4u*)(Y + (size_t)(b * T + t) * 256 + h * 64 + e0) = w;
    }
    __syncthreads();
}

constexpr int RTT = 16;
__device__ __noinline__ void rwkv_chain(CArgs& a, int l, int bh, LAS unsigned char* lds, int tid) {
    const int b = bh >> 2, h = bh & 3, lane = tid & 63, wave = tid >> 6;
    LAS float* WUP = (LAS float*)lds;
    LAS float* AUP = WUP + 4096;
    LAS float* GUP = AUP + 4096;
    LAS float* PS = GUP + 8192;
    LAS float* KK = PS + RTT * 448;
    LAS float* WR = KK + RTT * 64; LAS float* WD = WR + RTT * 64; LAS float* KA = WD + RTT * 64; LAS float* KP = KA + RTT * 64;
    LAS float* AA = KP + RTT * 64; LAS float* GG = AA + RTT * 64; LAS float* YY = GG + RTT * 64;
    LAS float* C1 = YY + RTT * 64; LAS float* C2 = C1 + RTT; LAS float* BON = C2 + RTT;
    const bf16* P = (const bf16*)(a.ws + WS_R + R_P);
    const float* mu = a.in[I_RW_MU] + (size_t)l * 1024;
    { const float* w_up = a.in[I_RW_WUP] + (size_t)l * 64 * 256; const float* a_up = a.in[I_RW_AUP] + (size_t)l * 64 * 256; const float* g_up = a.in[I_RW_GUP] + (size_t)l * 128 * 256;
      for (int i = tid; i < 4096; i += NT) { WUP[i] = w_up[(i >> 6) * 256 + h * 64 + (i & 63)]; AUP[i] = a_up[(i >> 6) * 256 + h * 64 + (i & 63)]; }
      for (int i = tid; i < 8192; i += NT) GUP[i] = g_up[(i >> 6) * 256 + h * 64 + (i & 63)]; }
    const float* w0 = a.in[I_RW_W0] + (size_t)l * 256 + h * 64; const float* a0 = a.in[I_RW_A0] + (size_t)l * 256 + h * 64;
    const float* k_k = a.in[I_RW_KK] + (size_t)l * 256 + h * 64; const float* k_a = a.in[I_RW_KA] + (size_t)l * 256 + h * 64;
    const float* r_k = a.in[I_RW_RK] + (size_t)l * 256 + h * 64; const float* gn_g = a.in[I_RW_GNG] + (size_t)l * 256 + h * 64; const float* gn_b = a.in[I_RW_GNB] + (size_t)l * 256 + h * 64;
    bf16* Y = (bf16*)(a.ws + WS_Y);
    const int row = tid >> 3, cg = tid & 7;
    float s0 = 0.f, s1 = 0.f, s2 = 0.f, s3 = 0.f, s4 = 0.f, s5 = 0.f, s6 = 0.f, s7 = 0.f;
    __syncthreads();
    for (int t0 = 0; t0 < T; t0 += RTT) {
        for (int i = tid; i < RTT * 448; i += NT) { const int tk = i / 448, cc = i % 448, t = t0 + tk;
            int col; if (cc < 192) col = (cc >> 6) * 256 + h * 64 + (cc & 63); else col = 768 + (cc - 192);
            const size_t m = (size_t)(b * T + t) * PW + C_RW + col;
            const float pc = bf2f(P[m]), pp = t > 0 ? bf2f(P[m - PW]) : 0.f;
            float v = pc + (pp - pc) * mu[col];
            if (cc >= 192 && cc < 256) v = tanhf(v); else if (cc >= 320) v = sigmoidf_(v);
            PS[i] = v; }
        __syncthreads();
#pragma unroll
        for (int rep = 0; rep < 2; ++rep) { const int o = tid + rep * NT, tk = o >> 6, cch = o & 63;
            const LAS float* ps = PS + tk * 448;
            float wl = w0[cch], al = a0[cch], gl = 0.f;
#pragma unroll 8
            for (int i = 0; i < 64; ++i) { wl += ps[192 + i] * WUP[i * 64 + cch]; al += ps[256 + i] * AUP[i * 64 + cch]; }
#pragma unroll 8
            for (int i = 0; i < 128; ++i) gl += ps[320 + i] * GUP[i * 64 + cch];
            const float decay = expf(-0.6065306597126334f * sigmoidf_(wl));
            const float av = sigmoidf_(al);
            WD[o] = decay; AA[o] = av; GG[o] = gl;
            KP[o] = ps[64 + cch] * (1.0f + (av - 1.0f) * k_a[cch]); }
        __syncthreads();
#pragma unroll
        for (int rep = 0; rep < 2; ++rep) { const int tk = wave * 2 + rep; const LAS float* ps = PS + tk * 448;
            const float kr = ps[64 + lane] * k_k[lane]; const float nrm = sqrtf(wave_sum(kr * kr)); const float kk = kr / fmaxf(nrm, 1e-12f);
            const float av = AA[tk * 64 + lane], r = ps[lane], kp = KP[tk * 64 + lane];
            KK[tk * 64 + lane] = kk; KA[tk * 64 + lane] = kk * av; WR[tk * 64 + lane] = WD[tk * 64 + lane] * r;
            const float c1 = wave_sum(kk * av * r), c2 = wave_sum(kp * r), bo = wave_sum(r * kp * r_k[lane]);
            if (lane == 0) { C1[tk] = c1; C2[tk] = c2; BON[tk] = bo; } }
        __syncthreads();
#pragma unroll 2
        for (int tk = 0; tk < RTT; ++tk) {
            const f32x4 kk0 = *(const LAS f32x4*)(KK + tk * 64 + cg * 8), kk1 = *(const LAS f32x4*)(KK + tk * 64 + cg * 8 + 4);
            const f32x4 wr0 = *(const LAS f32x4*)(WR + tk * 64 + cg * 8), wr1 = *(const LAS f32x4*)(WR + tk * 64 + cg * 8 + 4);
            const f32x4 wd0 = *(const LAS f32x4*)(WD + tk * 64 + cg * 8), wd1 = *(const LAS f32x4*)(WD + tk * 64 + cg * 8 + 4);
            const f32x4 ka0 = *(const LAS f32x4*)(KA + tk * 64 + cg * 8), ka1 = *(const LAS f32x4*)(KA + tk * 64 + cg * 8 + 4);
            const f32x4 kp0 = *(const LAS f32x4*)(KP + tk * 64 + cg * 8), kp1 = *(const LAS f32x4*)(KP + tk * 64 + cg * 8 + 4);
            const float vt = PS[tk * 448 + 128 + row], c1 = C1[tk], c2 = C2[tk];
            float d1 = ((s0 * kk0.x + s1 * kk0.y) + (s2 * kk0.z + s3 * kk0.w)) + ((s4 * kk1.x + s5 * kk1.y) + (s6 * kk1.z + s7 * kk1.w));
            float d2 = ((s0 * wr0.x + s1 * wr0.y) + (s2 * wr0.z + s3 * wr0.w)) + ((s4 * wr1.x + s5 * wr1.y) + (s6 * wr1.z + s7 * wr1.w));
            d1 = sum8(d1); d2 = sum8(d2);
            const float y = d2 - d1 * c1 + vt * c2;
            if (cg == 0) YY[tk * 64 + row] = y;
            s0 = s0 * wd0.x - d1 * ka0.x + vt * kp0.x; s1 = s1 * wd0.y - d1 * ka0.y + vt * kp0.y; s2 = s2 * wd0.z - d1 * ka0.z + vt * kp0.z; s3 = s3 * wd0.w - d1 * ka0.w + vt * kp0.w;
            s4 = s4 * wd1.x - d1 * ka1.x + vt * kp1.x; s5 = s5 * wd1.y - d1 * ka1.y + vt * kp1.y; s6 = s6 * wd1.z - d1 * ka1.z + vt * kp1.z; s7 = s7 * wd1.w - d1 * ka1.w + vt * kp1.w;
        }
        __syncthreads();
#pragma unroll
        for (int rep = 0; rep < 2; ++rep) { const int tk = wave * 2 + rep, t = t0 + tk;
            const float y = YY[tk * 64 + lane]; const float mean = wave_sum(y) * (1.0f / 64.0f); const float dlt = y - mean;
            const float var = wave_sum(dlt * dlt) * (1.0f / 64.0f);
            const float yn = dlt / sqrtf(var + 64e-5f) * gn_g[lane] + gn_b[lane];
            const float o = (yn + BON[tk] * PS[tk * 448 + 128 + lane]) * GG[tk * 64 + lane];
            Y[(size_t)(b * T + t) * 256 + h * 64 + lane] = (bf16)f2bf(o); }
        __syncthreads();
    }
}

__device__ __noinline__ void dsa_stage1(CArgs& a, int l, int tile, LAS unsigned char* lds, int tid) {
    constexpr int CP = 132;
    LAS float* CN = (LAS float*)lds;
    LAS float* WT = CN + 64 * CP;
    const int lane = tid & 63, wave = tid >> 6;
    const bf16* P = (const bf16*)(a.ws + WS_R + R_P);
    const float* w_uk = a.in[I_DSA_WUK] + (size_t)l * 128 * 64; const float* w_uv = a.in[I_DSA_WUV] + (size_t)l * 128 * 64; const float* ng = a.in[I_DSA_NG] + (size_t)l * 128;
    const int m0 = tile * 64;
    const int tk0 = tid >> 4, q8 = (tid & 15) * 8;
    const v4u c0r = *(const GAS v4u*)(P + (size_t)(m0 + tk0) * PW + C_DSA + 256 + q8), c1r = *(const GAS v4u*)(P + (size_t)(m0 + tk0 + 32) * PW + C_DSA + 256 + q8);
    const int wq = tid & 127, wg = tid >> 7;
    const GAS f32x4* wsrc = (const GAS f32x4*)((wg < 2 ? w_uk : w_uv) + (size_t)wq * 64 + 32 * (wg & 1));
    f32x4 wr[8];
#pragma unroll
    for (int i = 0; i < 8; ++i) wr[i] = wsrc[i];
    const f32x4 g0 = *(const GAS f32x4*)(ng + q8), g1 = *(const GAS f32x4*)(ng + q8 + 4);
    v4u kir = (v4u){0u, 0u, 0u, 0u}; if (tid < 256) kir = *(const GAS v4u*)(P + (size_t)(m0 + (tid >> 2)) * PW + C_DSA + 640 + 8 * (tid & 3));
    { float x0[8], x1[8]; unpack8(c0r, x0); unpack8(c1r, x1);
      float s0 = 0.f, s1 = 0.f;
#pragma unroll
      for (int e = 0; e < 8; ++e) { s0 += x0[e] * x0[e]; s1 += x1[e] * x1[e]; }
      s0 = sum8(s0); s0 += dppf<0x128>(s0); s1 = sum8(s1); s1 += dppf<0x128>(s1);
      const float r0 = __builtin_amdgcn_rsqf(s0 * (1.0f / 128.0f) + 1e-6f), r1 = __builtin_amdgcn_rsqf(s1 * (1.0f / 128.0f) + 1e-6f);
      const float gg[8] = {g0.x, g0.y, g0.z, g0.w, g1.x, g1.y, g1.z, g1.w};
      LAS float* d0 = CN + tk0 * CP + q8; LAS float* d1 = CN + (tk0 + 32) * CP + q8;
      *(LAS f32x4*)d0 = (f32x4){x0[0] * r0 * gg[0], x0[1] * r0 * gg[1], x0[2] * r0 * gg[2], x0[3] * r0 * gg[3]}; *(LAS f32x4*)(d0 + 4) = (f32x4){x0[4] * r0 * gg[4], x0[5] * r0 * gg[5], x0[6] * r0 * gg[6], x0[7] * r0 * gg[7]};
      *(LAS f32x4*)d1 = (f32x4){x1[0] * r1 * gg[0], x1[1] * r1 * gg[1], x1[2] * r1 * gg[2], x1[3] * r1 * gg[3]}; *(LAS f32x4*)(d1 + 4) = (f32x4){x1[4] * r1 * gg[4], x1[5] * r1 * gg[5], x1[6] * r1 * gg[6], x1[7] * r1 * gg[7]}; }
#pragma unroll
    for (int i = 0; i < 8; ++i) { LAS float* d = WT + (64 * (wg >> 1) + 32 * (wg & 1) + 4 * i) * CP + wq; d[0] = wr[i].x; d[CP] = wr[i].y; d[2 * CP] = wr[i].z; d[3 * CP] = wr[i].w; }
    if (tid < 256) { bf16* KI = (bf16*)(a.ws + WS_MG + MI_KI); *(GAS v4u*)(KI + (size_t)(m0 + (tid >> 2)) * 32 + 8 * (tid & 3)) = kir; }
    __syncthreads();
    { const int tm = wave >> 1, tn0 = (wave & 1) * 4, l15 = lane & 15, kq = lane >> 4;
      f32x4 acc[4];
#pragma unroll
      for (int t = 0; t < 4; ++t) acc[t] = (f32x4){0.f, 0.f, 0.f, 0.f};
#pragma unroll
      for (int ks = 0; ks < 4; ++ks) { const bf16x8 af = rw_frag(CN + (16 * tm + l15) * CP + 32 * ks + 8 * kq);
#pragma unroll
          for (int t = 0; t < 4; ++t) { const bf16x8 bf = rw_frag(WT + (16 * (tn0 + t) + l15) * CP + 32 * ks + 8 * kq);
              acc[t] = __builtin_amdgcn_mfma_f32_16x16x32_bf16(af, bf, acc[t], 0, 0, 0); } }
      bf16* dst = (bf16*)(a.ws + WS_MG + ((wave & 1) ? MI_V : MI_K));
#pragma unroll
      for (int t = 0; t < 4; ++t)
#pragma unroll
          for (int r = 0; r < 4; ++r) dst[(size_t)(m0 + 16 * tm + 4 * kq + r) * 64 + 16 * t + l15] = (bf16)f2bf(acc[t][r]); }
    __syncthreads();
}

__device__ __forceinline__ unsigned f2key(float f) { const unsigned u = __builtin_bit_cast(unsigned, f); return u ^ ((unsigned)((int)u >> 31) | 0x80000000u); }
constexpr int DS_HIST = 131072, DS_IDX = DS_HIST + 4096, DS_QV = DS_IDX + 4096, DS_PR = DS_QV + 4096, DS_BT = DS_PR + 16384, DS_SEL = DS_BT + 2112, DS_ENDB = DS_SEL + 64;
static_assert(DS_ENDB <= MISC_OFF, "DSA LDS map");
__device__ __noinline__ void dsa_bias_table(CArgs& a, LAS unsigned char* lds, int tid) {
    LAS float* BT = (LAS float*)(lds + DS_BT); const float* rb = a.in[I_RELB];
    for (int i = tid; i < 129 * 4; i += NT) { const int n = i >> 2, hh = i & 3; int bk;
        if (n < 16) bk = n; else if (n >= 128) bk = 31; else { bk = 16 + (n >= 19) + (n >= 21) + (n >= 24) + (n >= 27) + (n >= 31) + (n >= 35) + (n >= 40) + (n >= 46) + (n >= 52) + (n >= 59) + (n >= 67) + (n >= 77) + (n >= 87) + (n >= 99) + (n >= 113); }
        BT[i] = rb[bk * 4 + hh]; }
    for (int i = tid; i < 1024; i += NT) ((LAS unsigned*)(lds + DS_HIST))[i] = 0u;
    if (tid < 16) ((LAS unsigned*)(lds + DS_SEL))[tid] = 0u;
    __syncthreads();
}
__device__ __forceinline__ unsigned dsa_find_bin(const LAS unsigned* H, unsigned& rem, unsigned prefix, int shift, int lane) {
    const unsigned c0 = H[4 * lane], c1 = H[4 * lane + 1], c2 = H[4 * lane + 2], c3 = H[4 * lane + 3];
    const unsigned mine = c0 + c1 + c2 + c3; unsigned suf = mine;
    { int sv = (int)suf;
      sv += __builtin_amdgcn_update_dpp(0, sv, 0x101, 0xF, 0xF, true); sv += __builtin_amdgcn_update_dpp(0, sv, 0x102, 0xF, 0xF, true);
      sv += __builtin_amdgcn_update_dpp(0, sv, 0x104, 0xF, 0xF, true); sv += __builtin_amdgcn_update_dpp(0, sv, 0x108, 0xF, 0xF, true);
      const int t1 = __builtin_amdgcn_readlane(sv, 16), t2 = __builtin_amdgcn_readlane(sv, 32), t3 = __builtin_amdgcn_readlane(sv, 48); const int row = lane >> 4;
      suf = (unsigned)(sv + (row == 3 ? 0 : row == 2 ? t3 : row == 1 ? t2 + t3 : t1 + t2 + t3)); }
    unsigned cum = suf - mine;
    int found = -1; unsigned nrem = 0u;
    if (cum < rem && cum + c3 >= rem) { found = 3; nrem = rem - cum; } cum += c3;
    if (found < 0 && cum < rem && cum + c2 >= rem) { found = 2; nrem = rem - cum; } cum += c2;
    if (found < 0 && cum < rem && cum + c1 >= rem) { found = 1; nrem = rem - cum; } cum += c1;
    if (found < 0 && cum < rem && cum + c0 >= rem) { found = 0; nrem = rem - cum; }
    const unsigned long long fm = __ballot(found >= 0);
    const int src = fm ? (int)__ffsll((long long)fm) - 1 : 0;
    const unsigned np = (unsigned)__builtin_amdgcn_readlane((int)(prefix | ((unsigned)(4 * lane + found) << shift)), src);
    rem = (unsigned)__builtin_amdgcn_readlane((int)nrem, src);
    return np;
}
__device__ __forceinline__ float wave_max_fast(float v) {
    v = fmaxf(v, dppf<0xB1>(v)); v = fmaxf(v, dppf<0x4E>(v)); v = fmaxf(v, dppf<0x141>(v)); v = fmaxf(v, dppf<0x140>(v));
    const int iv = __builtin_bit_cast(int, v);
    float r = fmaxf(fmaxf(__builtin_bit_cast(float, __builtin_amdgcn_readlane(iv, 0)), __builtin_bit_cast(float, __builtin_amdgcn_readlane(iv, 16))),
                    fmaxf(__builtin_bit_cast(float, __builtin_amdgcn_readlane(iv, 32)), __builtin_bit_cast(float, __builtin_amdgcn_readlane(iv, 48))));
    asm volatile("" : "+v"(r));
    return r;
}
__device__ __forceinline__ int mbcnt64(unsigned long long m, int acc) { return (int)__builtin_amdgcn_mbcnt_hi((unsigned)(m >> 32), __builtin_amdgcn_mbcnt_lo((unsigned)m, (unsigned)acc)); }
struct DsaPre { bf16x8 a0, a1, qf0, qf1; v2u wqr[4]; };
__device__ __forceinline__ void dsa_prefetch(CArgs& a, int tile, int tid, DsaPre& pre) {
    const int lane = tid & 63, wave = tid >> 6, q = wave >> 1;
    const int b = tile / (T / 4), t0 = (tile % (T / 4)) * 4, m0 = b * T + t0;
    const bf16* P = (const bf16*)(a.ws + WS_R + R_P);
    { const int r32 = lane & 31, half = lane >> 5, qa = r32 >> 3, ha = r32 & 7;
      const bf16* qrow = P + (size_t)(m0 + qa) * PW + C_DSA + 384 + ha * 32 + 8 * half;
      pre.a0 = *(const GAS bf16x8*)qrow; pre.a1 = *(const GAS bf16x8*)(qrow + 16);
#pragma unroll
      for (int qq = 0; qq < 4; ++qq) pre.wqr[qq] = *(const GAS v2u*)(P + (size_t)(m0 + qq) * PW + C_DSA + 672 + 4 * half); }
    { const int mrow = lane & 15, kg = lane >> 4;
      const bf16* qp = P + (size_t)(m0 + q) * PW + C_DSA + (mrow & 3) * 64 + 8 * kg;
      bf16x8 f0 = *(const GAS bf16x8*)qp, f1 = *(const GAS bf16x8*)(qp + 32);
      if (mrow >= 4) {
#pragma unroll
          for (int i = 0; i < 8; ++i) { f0[i] = 0; f1[i] = 0; } }
      pre.qf0 = f0; pre.qf1 = f1; }
}
__device__ __forceinline__ void dsa_stage2(CArgs& a, int tile, int tile_next, LAS unsigned char* lds, int tid, GAS unsigned* qctr, int& nxt, DsaPre& pre, volatile LAS int* SLOT, int knext) {
    const int lane = tid & 63, wave = tid >> 6;
    const int b = tile / (T / 4), t0 = (tile % (T / 4)) * 4, m0 = b * T + t0;
    LAS unsigned* SC = (LAS unsigned*)lds; LAS unsigned* HIST = (LAS unsigned*)(lds + DS_HIST); LAS int* IDX = (LAS int*)(lds + DS_IDX);
    LAS float* PR = (LAS float*)(lds + DS_PR); LAS float* BT = (LAS float*)(lds + DS_BT); LAS unsigned* SEL = (LAS unsigned*)(lds + DS_SEL);
    LAS unsigned* CAND = (LAS unsigned*)PR; LAS unsigned* CANDI = CAND + 1024; LAS unsigned* HISTB = CAND + 2048;
    const bf16* P = (const bf16*)(a.ws + WS_R + R_P);
    const bf16* KB = (const bf16*)(a.ws + WS_MG + MI_K); const bf16* VB = (const bf16*)(a.ws + WS_MG + MI_V); const bf16* KI = (const bf16*)(a.ws + WS_MG + MI_KI);
    const int q = wave >> 1, part = wave & 1;
    const bf16x8 qf0 = pre.qf0, qf1 = pre.qf1;
    if (t0 < 256) {
        for (int i = tid; i < 1024; i += NT) IDX[i] = i & 255;
    } else {
        for (int i = tid; i < 1024; i += NT) HISTB[i] = 0u;
        { const int r32 = lane & 31, half = lane >> 5, qa = r32 >> 3, ha = r32 & 7;
          const bf16x8 a0 = pre.a0, a1 = pre.a1;
          float wq[4][4];
#pragma unroll
          for (int qq = 0; qq < 4; ++qq) { wq[qq][0] = bflo(pre.wqr[qq].x) * 0.03125f; wq[qq][1] = bfhi(pre.wqr[qq].x) * 0.03125f; wq[qq][2] = bflo(pre.wqr[qq].y) * 0.03125f; wq[qq][3] = bfhi(pre.wqr[qq].y) * 0.03125f; }
          const int ntile = (t0 + 4 - 16 + 31) >> 5;
          const GAS bf16* kbase = (const GAS bf16*)KI + (size_t)(b * T + 16 + r32) * 32 + 8 * half;
#define DSA_KLD(d0, d1, kk) do { const int k_ = (kk) < ntile ? (kk) : ntile - 1; d0 = *(const GAS bf16x8*)(kbase + (size_t)k_ * 1024); d1 = *(const GAS bf16x8*)(kbase + (size_t)k_ * 1024 + 16); } while (0)
          const int q0 = half * 2;
          for (int drep = 0; drep < ((DSA_DUP & 1) ? 2 : 1); ++drep) { LAS unsigned* HISTW = drep ? CAND + 3072 : HIST; asm volatile("" ::: "memory");
          bf16x8 nb0, nb1, nc0, nc1;
          DSA_KLD(nb0, nb1, wave); DSA_KLD(nc0, nc1, wave + NWAVES);
          for (int kt = wave; kt < ntile; kt += 2 * NWAVES) {
              const bool two = kt + NWAVES < ntile;
              const bf16x8 b0 = nb0, b1 = nb1, c0 = nc0, c1 = nc1;
              DSA_KLD(nb0, nb1, kt + 2 * NWAVES); DSA_KLD(nc0, nc1, kt + 3 * NWAVES);
#pragma unroll
              for (int u = 0; u < 2; ++u) { if (u == 1 && !two) break;
                  const int s = 16 + 32 * (kt + u * NWAVES) + r32;
                  f32x16 acc;
#pragma unroll
                  for (int i = 0; i < 16; ++i) acc[i] = 0.f;
                  acc = __builtin_amdgcn_mfma_f32_32x32x16_bf16(a0, u ? c0 : b0, acc, 0, 0, 0);
                  acc = __builtin_amdgcn_mfma_f32_32x32x16_bf16(a1, u ? c1 : b1, acc, 0, 0, 0);
                  float pq[4];
#pragma unroll
                  for (int qq = 0; qq < 4; ++qq) { float p = 0.f, pa = 0.f;
#pragma unroll
                      for (int i = 0; i < 4; ++i) { p = fmaf(wq[qq][i], acc[4 * qq + i], p); pa = fmaf(wq[qq][i], __builtin_fabsf(acc[4 * qq + i]), pa); }
                      pq[qq] = p + pa; }
                  asm volatile("s_nop 1\n\tv_permlane32_swap_b32 %0, %1" : "+v"(pq[0]), "+v"(pq[2]));
                  asm volatile("s_nop 1\n\tv_permlane32_swap_b32 %0, %1" : "+v"(pq[1]), "+v"(pq[3]));
                  const float v0 = pq[0] + pq[2], v1 = pq[1] + pq[3];
                  const bool ok0 = s <= t0 + q0, ok1 = s <= t0 + q0 + 1;
                  const unsigned key0 = ok0 ? f2key(v0) : 0u, key1 = ok1 ? f2key(v1) : 0u;
                  SC[q0 * 8192 + (s - 16)] = key0;
                  SC[(q0 + 1) * 8192 + (s - 16)] = key1;
                  if (ok0) __hip_atomic_fetch_add(&HISTW[q0 * 256 + (key0 >> 24)], 1u, __ATOMIC_RELAXED, __HIP_MEMORY_SCOPE_WORKGROUP);
                  if (ok1) __hip_atomic_fetch_add(&HISTW[(q0 + 1) * 256 + (key1 >> 24)], 1u, __ATOMIC_RELAXED, __HIP_MEMORY_SCOPE_WORKGROUP); }
          }
          }
#undef DSA_KLD
          }
    }
    __syncthreads();
    if (t0 >= 256) {
        const int n = t0 + q - 15, n4 = (n + 3) >> 2;
        unsigned rem = 240u;
        unsigned prefix = dsa_find_bin(HIST + q * 256, rem, 0u, 24, lane);
        { const unsigned p1 = prefix >> 24;
          v4u kn = (v4u){0u, 0u, 0u, 0u}; if (part * 64 + lane < n4) kn = *(const LAS v4u*)(SC + q * 8192 + 4 * (part * 64 + lane));
          for (int g = part * 64 + lane; g < n4; g += 128) { const v4u kk = kn; if (g + 128 < n4) kn = *(const LAS v4u*)(SC + q * 8192 + 4 * (g + 128));
              if ((kk.x >> 24) == p1) __hip_atomic_fetch_add(&HISTB[q * 256 + ((kk.x >> 16) & 255u)], 1u, __ATOMIC_RELAXED, __HIP_MEMORY_SCOPE_WORKGROUP);
              if ((kk.y >> 24) == p1) __hip_atomic_fetch_add(&HISTB[q * 256 + ((kk.y >> 16) & 255u)], 1u, __ATOMIC_RELAXED, __HIP_MEMORY_SCOPE_WORKGROUP);
              if ((kk.z >> 24) == p1) __hip_atomic_fetch_add(&HISTB[q * 256 + ((kk.z >> 16) & 255u)], 1u, __ATOMIC_RELAXED, __HIP_MEMORY_SCOPE_WORKGROUP);
              if ((kk.w >> 24) == p1) __hip_atomic_fetch_add(&HISTB[q * 256 + ((kk.w >> 16) & 255u)], 1u, __ATOMIC_RELAXED, __HIP_MEMORY_SCOPE_WORKGROUP); } }
        __syncthreads();
        prefix = dsa_find_bin(HISTB + q * 256, rem, prefix, 16, lane);
        const int D = 240 - (int)rem;
        { const int gh = (n4 + 1) >> 1, gbeg = part * gh, gend = (gbeg + gh < n4) ? gbeg + gh : n4;
          const unsigned klo = prefix, khi = prefix + 0x10000u; const bool hiany = khi != 0u;
          if (part == 0 && lane < 16) IDX[q * 256 + lane] = lane;
          for (int drep = 0; drep < ((DSA_DUP & 64) ? 2 : 1); ++drep) { asm volatile("" ::: "memory"); int cnt = 0;
          LAS unsigned* SELW = drep ? &SEL[q * 4 + 2] : &SEL[q * 4 + 3]; LAS unsigned* CW = drep ? CAND + 3072 : CAND; LAS unsigned* CIW = drep ? CAND + 3072 : CANDI;
          v4u kn = (v4u){0u, 0u, 0u, 0u}; if (gbeg + lane < gend) kn = *(const LAS v4u*)(SC + q * 8192 + 4 * (gbeg + lane));
          for (int g0 = gbeg; g0 < gend; g0 += 64) { const int g = g0 + lane;
              const v4u kk = kn; kn = (v4u){0u, 0u, 0u, 0u}; if (g + 64 < gend) kn = *(const LAS v4u*)(SC + q * 8192 + 4 * (g + 64));
              const unsigned long long mg0 = __ballot(hiany && kk.x >= khi), mg1 = __ballot(hiany && kk.y >= khi), mg2 = __ballot(hiany && kk.z >= khi), mg3 = __ballot(hiany && kk.w >= khi);
              const unsigned long long me0 = __ballot(kk.x >= klo) & ~mg0, me1 = __ballot(kk.y >= klo) & ~mg1, me2 = __ballot(kk.z >= klo) & ~mg2, me3 = __ballot(kk.w >= klo) & ~mg3;
              if ((mg0 | mg1 | mg2 | mg3) != 0ull) {
                  int run = mbcnt64(mg3, mbcnt64(mg2, mbcnt64(mg1, mbcnt64(mg0, cnt))));
                  const unsigned kv[4] = {kk.x, kk.y, kk.z, kk.w};
#pragma unroll
                  for (int e = 0; e < 4; ++e) if (hiany && kv[e] >= khi) { int pos = part == 0 ? 16 + run : 16 + D - 1 - run; pos = pos < 16 ? 16 : (pos > 255 ? 255 : pos); IDX[q * 256 + pos] = 16 + 4 * g + e; ++run; }
                  cnt += __popcll(mg0) + __popcll(mg1) + __popcll(mg2) + __popcll(mg3); }
              if ((me0 | me1 | me2 | me3) != 0ull) {
                  const unsigned kv[4] = {kk.x, kk.y, kk.z, kk.w};
#pragma unroll
                  for (int e = 0; e < 4; ++e) if (kv[e] >= klo && !(hiany && kv[e] >= khi)) { const unsigned pp = __hip_atomic_fetch_add(SELW, 1u, __ATOMIC_RELAXED, __HIP_MEMORY_SCOPE_WORKGROUP); if (pp < 256u) { CW[q * 256 + pp] = kv[e]; CIW[q * 256 + pp] = 16u + 4u * g + e; } } }
          } } }
        __syncthreads();
        const bool ovf = SEL[3] > 256u || SEL[7] > 256u || SEL[11] > 256u || SEL[15] > 256u;
        if (!ovf) {
            const unsigned nc = SEL[q * 4 + 3];
            for (unsigned ci = lane; ci < nc; ci += 64) { const unsigned kv = CAND[q * 256 + ci], iv = CANDI[q * 256 + ci]; unsigned rank = 0u;
                for (unsigned cj = 0; cj < nc; ++cj) { const unsigned ko = CAND[q * 256 + cj], io = CANDI[q * 256 + cj]; rank += (ko > kv || (ko == kv && io < iv)) ? 1u : 0u; }
                if (rank < rem) IDX[q * 256 + 16 + D + (int)rank] = (int)iv; }
        } else {
            LAS unsigned* H2 = HISTB; unsigned mask = 0xffff0000u;
            for (int pass = 2; pass < 4; ++pass) { const int shift = 24 - 8 * pass;
                __syncthreads();
                for (int i = tid; i < 1024; i += NT) H2[i] = 0u;
                __syncthreads();
                for (int i = part * 64 + lane; i < n; i += 128) { const unsigned key = SC[q * 8192 + i]; if ((key & mask) == prefix) __hip_atomic_fetch_add(&H2[q * 256 + ((key >> shift) & 255u)], 1u, __ATOMIC_RELAXED, __HIP_MEMORY_SCOPE_WORKGROUP); }
                __syncthreads();
                prefix = dsa_find_bin(H2 + q * 256, rem, prefix, shift, lane); mask |= 255u << shift; }
            __syncthreads();
            if (part == 0) { const unsigned thr = prefix;
                if (lane < 16) IDX[q * 256 + lane] = lane;
                int base = 16; unsigned eqtaken = 0u; const unsigned long long below = (1ull << lane) - 1ull;
                for (int i0 = 0; i0 < n; i0 += 64) { const int i = i0 + lane; const bool valid = i < n;
                    const unsigned key = valid ? SC[q * 8192 + i] : 0u; const bool gt = valid && key > thr, eq = valid && key == thr;
                    const unsigned long long eqm = __ballot(eq);
                    const bool sel = gt || (eq && (eqtaken + (unsigned)__popcll(eqm & below)) < rem);
                    const unsigned long long sm = __ballot(sel);
                    if (sel) { const int pos = base + __popcll(sm & below); if (pos < 256) IDX[q * 256 + pos] = 16 + i; }
                    base += __popcll(sm); eqtaken += (unsigned)__popcll(eqm); } }
            __syncthreads();
        }
        for (int i = tid; i < 1024; i += NT) HIST[i] = 0u;
    }
    { const int hp = part, t = t0 + q; const int L = t0 < 256 ? t + 1 : 256;
      LAS unsigned char* KS = lds + q * 32768;
      const GAS v4u* KG = (const GAS v4u*)KB; const GAS v4u* VG = (const GAS v4u*)VB;
      if (t0 < 256) __syncthreads();
      v4u gv[16], gw[16];
#define DSA_LOAD(DST, SRC) do { _Pragma("unroll") for (int i = 0; i < 16; ++i) { const int p = lane + 64 * i, row = hp * 128 + (p >> 3), part_ = p & 7; \
          DST[i] = (v4u){0u, 0u, 0u, 0u}; if (row < L) DST[i] = (SRC)[(size_t)(b * T + IDX[q * 256 + row]) * 8 + part_]; } } while (0)
#define DSA_PUT(SRCV) do { _Pragma("unroll") for (int i = 0; i < 16; ++i) { const int p = lane + 64 * i, row = hp * 128 + (p >> 3), part_ = p & 7; \
          *(LAS v4u*)(KS + row * 128 + ((part_ ^ ((row >> 1) & 7)) << 4)) = SRCV[i]; } } while (0)
      DSA_LOAD(gv, KG);
      if (tid == 0) nxt = (int)__hip_atomic_fetch_add(qctr, 1u, __ATOMIC_RELAXED, __HIP_MEMORY_SCOPE_AGENT);
      DSA_PUT(gv);
      DSA_LOAD(gw, VG);
      __syncthreads();
      if (tid < 4) SEL[tid * 4 + 3] = 0u;
      for (int drep = 0; drep < ((DSA_DUP & 4) ? 2 : 1); ++drep) { asm volatile("" ::: "memory"); const int n16 = lane & 15, kg = lane >> 4;
#pragma unroll 2
        for (int j = 0; j < 8; ++j) { const int row = hp * 128 + 16 * j + n16; const int sw = (row >> 1) & 7;
            const bf16x8 k0 = *(const LAS bf16x8*)(KS + row * 128 + ((kg ^ sw) << 4)), k1 = *(const LAS bf16x8*)(KS + row * 128 + (((kg + 4) ^ sw) << 4));
            f32x4 acc = (f32x4){0.f, 0.f, 0.f, 0.f};
            acc = __builtin_amdgcn_mfma_f32_16x16x32_bf16(qf0, k0, acc, 0, 0, 0);
            acc = __builtin_amdgcn_mfma_f32_16x16x32_bf16(qf1, k1, acc, 0, 0, 0);
            if (kg == 0) { PR[(q * 4 + 0) * 256 + row] = acc[0]; PR[(q * 4 + 1) * 256 + row] = acc[1]; PR[(q * 4 + 2) * 256 + row] = acc[2]; PR[(q * 4 + 3) * 256 + row] = acc[3]; } } }
      dsa_prefetch(a, tile_next, tid, pre);
      __syncthreads();
      { LAS float* p0 = PR + (q * 4 + 2 * hp) * 256; LAS float* p1 = p0 + 256;
        float lg0[4], lg1[4];
#pragma unroll
        for (int r = 0; r < 4; ++r) { const int jj = lane + 64 * r; lg0[r] = -INFINITY; lg1[r] = -INFINITY;
            if (jj < L) { int dist = t - IDX[q * 256 + jj]; dist = dist > 128 ? 128 : dist;
                lg0[r] = p0[jj] * 0.125f + BT[dist * 4 + 2 * hp]; lg1[r] = p1[jj] * 0.125f + BT[dist * 4 + 2 * hp + 1]; } }
        const float m0x = wave_max_fast(fmaxf(fmaxf(lg0[0], lg0[1]), fmaxf(lg0[2], lg0[3]))), m1x = wave_max_fast(fmaxf(fmaxf(lg1[0], lg1[1]), fmaxf(lg1[2], lg1[3])));
        float e0[4], e1[4], s0 = 0.f, s1 = 0.f;
#pragma unroll
        for (int r = 0; r < 4; ++r) { e0[r] = __expf(lg0[r] - m0x); e1[r] = __expf(lg1[r] - m1x); s0 += e0[r]; s1 += e1[r]; }
        const float i0 = 1.0f / wave_sum_fast(s0), i1 = 1.0f / wave_sum_fast(s1);
        LAS bf16* pb = (LAS bf16*)p0;
#pragma unroll
        for (int r = 0; r < 4; ++r) { const int jj = lane + 64 * r; pb[jj] = (bf16)f2bf(e0[r] * i0); pb[256 + jj] = (bf16)f2bf(e1[r] * i1); } }
      DSA_PUT(gw);
      __syncthreads();
#undef DSA_LOAD
#undef DSA_PUT
      for (int drep = 0; drep < ((DSA_DUP & 8) ? 2 : 1); ++drep) { asm volatile("" ::: "memory"); const int g = lane >> 4, i16 = lane & 15, qq = i16 >> 2, pp = lane & 3, hd = i16 & 3;
        const LAS unsigned char* pbh = (const LAS unsigned char*)PR + (q * 4 + 2 * (hd >> 1)) * 1024 + (hd & 1) * 512 + 16 * g;
        const int r1 = 8 * g + qq, sw1 = (r1 >> 1) & 7, sw2 = ((r1 + 4) >> 1) & 7, pc0 = 4 * hp + (pp >> 1), pc1 = pc0 + 2;
        const unsigned kb0 = (unsigned)(unsigned long long)KS + 8 * (pp & 1);
        const unsigned a00 = kb0 + r1 * 128 + ((pc0 ^ sw1) << 4), a01 = kb0 + (r1 + 4) * 128 + ((pc0 ^ sw2) << 4), a10 = kb0 + r1 * 128 + ((pc1 ^ sw1) << 4), a11 = kb0 + (r1 + 4) * 128 + ((pc1 ^ sw2) << 4);
        f32x4 acc0 = (f32x4){0.f, 0.f, 0.f, 0.f}, acc1 = (f32x4){0.f, 0.f, 0.f, 0.f};
#define DSA_PV(KBI) do { const bf16x8 pf = *(const LAS bf16x8*)(pbh + 64 * (KBI)); v2u t00, t01, t10, t11; \
            asm volatile("ds_read_b64_tr_b16 %0, %4 offset:%8\n\tds_read_b64_tr_b16 %1, %5 offset:%8\n\tds_read_b64_tr_b16 %2, %6 offset:%8\n\tds_read_b64_tr_b16 %3, %7 offset:%8\n\ts_waitcnt lgkmcnt(0)" \
                         : "=&v"(t00), "=&v"(t01), "=&v"(t10), "=&v"(t11) : "v"(a00), "v"(a01), "v"(a10), "v"(a11), "i"((KBI) * 4096) : "memory"); \
            const v4u w0 = (v4u){t00.x, t00.y, t01.x, t01.y}, w1 = (v4u){t10.x, t10.y, t11.x, t11.y}; \
            acc0 = __builtin_amdgcn_mfma_f32_16x16x32_bf16(__builtin_bit_cast(bf16x8, w0), pf, acc0, 0, 0, 0); \
            acc1 = __builtin_amdgcn_mfma_f32_16x16x32_bf16(__builtin_bit_cast(bf16x8, w1), pf, acc1, 0, 0, 0); } while (0)
        DSA_PV(0); DSA_PV(1); DSA_PV(2); DSA_PV(3); DSA_PV(4); DSA_PV(5); DSA_PV(6); DSA_PV(7);
#undef DSA_PV
        if (i16 < 4) { bf16* Y = (bf16*)(a.ws + WS_Y) + (size_t)2 * MP * 256 + (size_t)(m0 + q) * 256 + i16 * 64 + 32 * hp + 4 * g;
            *(GAS v2u*)Y = (v2u){pk2(acc0[0], acc0[1]), pk2(acc0[2], acc0[3])};
            *(GAS v2u*)(Y + 16) = (v2u){pk2(acc1[0], acc1[1]), pk2(acc1[2], acc1[3])}; } }
    }
    if (tid == 0) { SLOT[0] = knext; SLOT[1] = nxt; }
    __syncthreads();
}

constexpr int RWA_BYTES = 64 * RL * 4;
constexpr int RW_GB = 8 * RWA_BYTES, RW_GL = RW_GB + 8192, RW_END = RW_GL + 512;
static_assert(RW_END <= MISC_OFF, "rwkv LDS map");
constexpr size_t R_RWM = (size_t)MP * PW * 2;
constexpr size_t R_RWN = R_RWM + (size_t)NBH * NCH * 4096 * 2;
static_assert(R_RWN + (size_t)NBH * NCH * 4096 * 2 <= R_BYTES, "rwkv intermediates fit behind P");

__device__ __forceinline__ void rwkv_front(CArgs& a, int l, int item, LAS unsigned char* lds, int tid) {
    const int c = item % NCH, bh = item / NCH, b = bh >> 2, h = bh & 3, lane = tid & 63, wave = tid >> 6;
    LAS float* A0 = (LAS float*)lds; LAS float* A1 = A0 + 64 * RL; LAS float* A2 = A1 + 64 * RL; LAS float* A3 = A2 + 64 * RL;
    LAS float* A4 = A3 + 64 * RL; LAS float* A5 = A4 + 64 * RL; LAS float* A6 = A5 + 64 * RL; LAS float* A7 = A6 + 64 * RL;
    LAS unsigned short* GB = (LAS unsigned short*)(lds + RW_GB); LAS float* GL = (LAS float*)(lds + RW_GL); LAS float* BON = GL + 64;
    const bf16* P = (const bf16*)(a.ws + WS_R + R_P);
    const float* mu = a.in[I_RW_MU] + (size_t)l * 1024;
    { const int j = tid >> 3, p8 = tid & 7, t = 64 * c - PADT + j;
      const GAS bf16* prow = (const GAS bf16*)P + (size_t)(b * T + (t >= 0 ? t : 0)) * PW + C_RW;
      v4u cu[7], pv[7]; f32x4 m0[7], m1[7];
#pragma unroll
      for (int it = 0; it < 7; ++it) { const int col = (it < 3 ? it * 256 + h * 64 : 768 + (it - 3) * 64) + 8 * p8;
          cu[it] = (v4u){0u, 0u, 0u, 0u}; pv[it] = (v4u){0u, 0u, 0u, 0u};
          if (t >= 0) cu[it] = *(const GAS v4u*)(prow + col);
          if (t > 0) pv[it] = *(const GAS v4u*)(prow + col - PW);
          m0[it] = *(const GAS f32x4*)(mu + col); m1[it] = *(const GAS f32x4*)(mu + col + 4); }
#pragma unroll
      for (int it = 0; it < 7; ++it) { LAS float* dst = it == 0 ? A5 : it == 1 ? A6 : it == 2 ? A4 : it == 3 ? A0 : it == 4 ? A1 : it == 5 ? A2 : A3;
          const float cf[8] = {bflo(cu[it].x), bfhi(cu[it].x), bflo(cu[it].y), bfhi(cu[it].y), bflo(cu[it].z), bfhi(cu[it].z), bflo(cu[it].w), bfhi(cu[it].w)};
          const float pf[8] = {bflo(pv[it].x), bfhi(pv[it].x), bflo(pv[it].y), bfhi(pv[it].y), bflo(pv[it].z), bfhi(pv[it].z), bflo(pv[it].w), bfhi(pv[it].w)};
          const float mf[8] = {m0[it].x, m0[it].y, m0[it].z, m0[it].w, m1[it].x, m1[it].y, m1[it].z, m1[it].w};
          float v[8];
#pragma unroll
          for (int e = 0; e < 8; ++e) { float x = cf[e] + (pf[e] - cf[e]) * mf[e];
              if (it == 3) { const float ex = __expf(2.0f * x); x = 1.0f - 2.0f * __builtin_amdgcn_rcpf(ex + 1.0f); }
              else if (it >= 5) x = __builtin_amdgcn_rcpf(1.0f + __expf(-x));
              v[e] = t >= 0 ? x : 0.f; }
          *(LAS f32x4*)(dst + j * RL + 8 * p8) = (f32x4){v[0], v[1], v[2], v[3]}; *(LAS f32x4*)(dst + j * RL + 8 * p8 + 4) = (f32x4){v[4], v[5], v[6], v[7]}; } }
    f32x4 kk4[2], ka4[2], rk4[2], w04[2], a04[2];
    { const int cc0 = (tid & 7) * 8; const size_t off = (size_t)l * 256 + h * 64 + cc0;
#pragma unroll
      for (int u = 0; u < 2; ++u) { kk4[u] = *(const GAS f32x4*)(a.in[I_RW_KK] + off + 4 * u); ka4[u] = *(const GAS f32x4*)(a.in[I_RW_KA] + off + 4 * u); rk4[u] = *(const GAS f32x4*)(a.in[I_RW_RK] + off + 4 * u);
          w04[u] = *(const GAS f32x4*)(a.in[I_RW_W0] + off + 4 * u); a04[u] = *(const GAS f32x4*)(a.in[I_RW_A0] + off + 4 * u); } }
    f32x4 wl[2], al[2], gl[2];
    { const float* w_up = a.in[I_RW_WUP] + (size_t)l * 64 * 256 + h * 64; const float* a_up = a.in[I_RW_AUP] + (size_t)l * 64 * 256 + h * 64; const float* g_up = a.in[I_RW_GUP] + (size_t)l * 128 * 256 + h * 64;
      const int wi_ = tid >> 3, wc_ = (tid & 7) * 8;
#define RW_LOAD(src, s0, s1) const f32x4 s0 = *(const GAS f32x4*)((src) + (size_t)wi_ * 256 + wc_), s1 = *(const GAS f32x4*)((src) + (size_t)wi_ * 256 + wc_ + 4)
      RW_LOAD(w_up, q0a, q0b); RW_LOAD(a_up, q1a, q1b); RW_LOAD(g_up, q2a, q2b); RW_LOAD(g_up + 64 * 256, q3a, q3b);
#define RW_STAGE(s0, s1) do { \
        A7[(wc_ + 0) * RL + wi_] = s0.x; A7[(wc_ + 1) * RL + wi_] = s0.y; A7[(wc_ + 2) * RL + wi_] = s0.z; A7[(wc_ + 3) * RL + wi_] = s0.w; \
        A7[(wc_ + 4) * RL + wi_] = s1.x; A7[(wc_ + 5) * RL + wi_] = s1.y; A7[(wc_ + 6) * RL + wi_] = s1.z; A7[(wc_ + 7) * RL + wi_] = s1.w; } while (0)
      RW_STAGE(q0a, q0b); __syncthreads();
      RW_ZERO(wl); rw_mma(wl, A0, A7, lane, wave); __syncthreads();
      RW_STAGE(q1a, q1b); __syncthreads();
      RW_ZERO(al); rw_mma(al, A1, A7, lane, wave); __syncthreads();
      RW_STAGE(q2a, q2b); __syncthreads();
      RW_ZERO(gl); rw_mma(gl, A2, A7, lane, wave); __syncthreads();
      RW_STAGE(q3a, q3b); __syncthreads();
      rw_mma(gl, A3, A7, lane, wave); __syncthreads();
#undef RW_STAGE
#undef RW_LOAD
      RW_FOREACH(wl, rr, cc, vv, A0[rr * RL + cc] = vv;);
      RW_FOREACH(al, rr, cc, vv, A1[rr * RL + cc] = vv;);
      RW_FOREACH(gl, rr, cc, vv, GB[rr * 64 + cc] = (unsigned short)f2bf(vv););
    }
    __syncthreads();
    { const int j = tid >> 3, c0 = (tid & 7) * 8, t = 64 * c - PADT + j;
      const float k_k[8] = {kk4[0].x, kk4[0].y, kk4[0].z, kk4[0].w, kk4[1].x, kk4[1].y, kk4[1].z, kk4[1].w}, k_a[8] = {ka4[0].x, ka4[0].y, ka4[0].z, ka4[0].w, ka4[1].x, ka4[1].y, ka4[1].z, ka4[1].w};
      const float r_k[8] = {rk4[0].x, rk4[0].y, rk4[0].z, rk4[0].w, rk4[1].x, rk4[1].y, rk4[1].z, rk4[1].w}, w0[8] = {w04[0].x, w04[0].y, w04[0].z, w04[0].w, w04[1].x, w04[1].y, w04[1].z, w04[1].w};
      const float a0[8] = {a04[0].x, a04[0].y, a04[0].z, a04[0].w, a04[1].x, a04[1].y, a04[1].z, a04[1].w};
      float kr[8], kp[8], lw[8], av[8], ss = 0.f, bo = 0.f;
#pragma unroll
      for (int e = 0; e < 8; ++e) { const float k = A6[j * RL + c0 + e], r = A5[j * RL + c0 + e];
          av[e] = __builtin_amdgcn_rcpf(1.0f + __expf(-(A1[j * RL + c0 + e] + a0[e])));
          lw[e] = t >= 0 ? -0.6065306597126334f * __builtin_amdgcn_rcpf(1.0f + __expf(-(A0[j * RL + c0 + e] + w0[e]))) : 0.f;
          kp[e] = k * (1.0f + (av[e] - 1.0f) * k_a[e]); kr[e] = k * k_k[e]; ss += kr[e] * kr[e]; bo += r * kp[e] * r_k[e]; }
      ss = sum8(ss); bo = sum8(bo);
      const float inv = 1.0f / fmaxf(sqrtf(ss), 1e-12f);
#pragma unroll
      for (int e = 0; e < 8; ++e) { A0[j * RL + c0 + e] = lw[e]; A1[j * RL + c0 + e] = kr[e] * inv; A2[j * RL + c0 + e] = av[e]; A3[j * RL + c0 + e] = kp[e]; }
      if ((tid & 7) == 0) BON[j] = bo;
    }
    __syncthreads();
    if (tid < 64) { float s = 0.f; for (int jj = 0; jj < 64; ++jj) { s += A0[jj * RL + tid]; A0[jj * RL + tid] = s; } GL[tid] = __expf(s); }
    __syncthreads();
    { float at[8], bt[8], kt[8], vv[8], rt[8];
#pragma unroll
      for (int i = 0; i < 8; ++i) { const int e = tid + NT * i, jj = e >> 6, k = e & 63; const float G = A0[jj * RL + k], Gp = jj > 0 ? A0[(jj - 1) * RL + k] : 0.f, en = __expf(-G);
          const float kk = A1[jj * RL + k]; at[i] = kk * __expf(Gp); bt[i] = kk * A2[jj * RL + k] * en; kt[i] = A3[jj * RL + k] * en; vv[i] = A4[jj * RL + k]; rt[i] = A5[jj * RL + k] * __expf(G); }
      __syncthreads();
#pragma unroll
      for (int i = 0; i < 8; ++i) { const int e = tid + NT * i, jj = e >> 6, k = e & 63;
          A6[k * RL + jj] = at[i]; A7[jj * RL + k] = at[i]; A2[jj * RL + k] = bt[i]; A3[jj * RL + k] = kt[i]; A1[k * RL + jj] = vv[i]; A4[jj * RL + k] = rt[i]; }
    }
    __syncthreads();
    { f32x4 n1[2], n2[2]; RW_ZERO(n1); RW_ZERO(n2);
      rw_mma(n1, A2, A7, lane, wave); rw_mma(n2, A3, A7, lane, wave);
      RW_FOREACH(n1, rr, cc, vv, A0[rr * RL + cc] = rr < cc ? vv : 0.f;);
      RW_FOREACH(n2, rr, cc, vv, A5[rr * RL + cc] = rr < cc ? vv : 0.f;); }
    __syncthreads();
    { const int rho = tid >> 2, q = tid & 3; LAS float* row = rho < 64 ? A6 + rho * RL : A5 + (rho - 64) * RL;
      const LAS float* Nq = A0 + q * RL;
      float xr[16];
#pragma unroll
      for (int m = 0; m < 16; ++m) xr[m] = 0.f;
#pragma unroll
      for (int blk = 0; blk < 16; ++blk) {
          f32x4 nv[16];
#pragma unroll
          for (int m = 0; m <= blk; ++m) nv[m] = *(const LAS f32x4*)(Nq + (4 * m) * RL + 4 * blk);
          const f32x4 rv = *(const LAS f32x4*)(row + 4 * blk);
#pragma unroll
          for (int e = 0; e < 4; ++e) { float s0 = 0.f, s1 = 0.f;
#pragma unroll
              for (int m = 0; m <= blk; ++m) { if (m & 1) s1 += xr[m] * nv[m][e]; else s0 += xr[m] * nv[m][e]; }
              float s = s0 + s1;
              s += dppf<0xB1>(s); s += dppf<0x4E>(s);
              const float xj = rv[e] - s; if (q == e) xr[blk] = xj; } }
      __syncthreads();
#pragma unroll
      for (int m = 0; m < 16; ++m) row[4 * m + q] = xr[m];
    }
    __syncthreads();
}
constexpr size_t RWC_PLANE = (size_t)NBH * NCH * 4096;
static_assert(7 * RWC_PLANE * 2 + (size_t)NBH * NCH * 64 * 4 <= (size_t)BATCH * SEQ * D * 4, "rwkv front-end cache fits the output buffer");
__device__ __forceinline__ void rwkv_cache_put(CArgs& a, int item, LAS unsigned char* lds, int tid) {
    LAS float* A0 = (LAS float*)lds; const int r = tid >> 3, c0 = (tid & 7) * 8;
    bf16* CB = (bf16*)a.out + (size_t)item * 4096 + r * 64 + c0;
#pragma unroll
    for (int p = 0; p < 6; ++p) { const LAS float* src = A0 + (p + 1) * 64 * RL + r * RL + c0;
        const f32x4 x = *(const LAS f32x4*)src, y = *(const LAS f32x4*)(src + 4);
        *(GAS v4u*)(CB + p * RWC_PLANE) = (v4u){pk2(x.x, x.y), pk2(x.z, x.w), pk2(y.x, y.y), pk2(y.z, y.w)}; }
    *(GAS v4u*)(CB + 6 * RWC_PLANE) = *(const LAS v4u*)((LAS unsigned short*)(lds + RW_GB) + r * 64 + c0);
    if (tid < 64) ((float*)((bf16*)a.out + 7 * RWC_PLANE))[(size_t)item * 64 + tid] = ((LAS float*)(lds + RW_GL))[64 + tid];
}
__device__ __forceinline__ void rwkv_cache_get(CArgs& a, int item, LAS unsigned char* lds, int tid) {
    LAS float* A0 = (LAS float*)lds; const int r = tid >> 3, c0 = (tid & 7) * 8;
    const bf16* CB = (const bf16*)a.out + (size_t)item * 4096 + r * 64 + c0;
    v4u w[7];
#pragma unroll
    for (int p = 0; p < 7; ++p) w[p] = *(const GAS v4u*)(CB + p * RWC_PLANE);
    float bo = 0.f; if (tid < 64) bo = ((const float*)((const bf16*)a.out + 7 * RWC_PLANE))[(size_t)item * 64 + tid];
#pragma unroll
    for (int p = 0; p < 6; ++p) { LAS float* dst = A0 + (p + 1) * 64 * RL + r * RL + c0;
        *(LAS f32x4*)dst = (f32x4){bflo(w[p].x), bfhi(w[p].x), bflo(w[p].y), bfhi(w[p].y)}; *(LAS f32x4*)(dst + 4) = (f32x4){bflo(w[p].z), bfhi(w[p].z), bflo(w[p].w), bfhi(w[p].w)}; }
    *(LAS v4u*)((LAS unsigned short*)(lds + RW_GB) + r * 64 + c0) = w[6];
    if (tid < 64) ((LAS float*)(lds + RW_GL))[64 + tid] = bo;
    __syncthreads();
}
__device__ __noinline__ void rwkv_stage1(CArgs& a, int l, int item, LAS unsigned char* lds, int tid) {
    rwkv_front(a, l, item, lds, tid);
    if (RWKV_CACHE) rwkv_cache_put(a, item, lds, tid);
    const int lane = tid & 63, wave = tid >> 6;
    LAS float* A0 = (LAS float*)lds; LAS float* A1 = A0 + 64 * RL; LAS float* A2 = A1 + 64 * RL; LAS float* A3 = A2 + 64 * RL; LAS float* A4 = A3 + 64 * RL; LAS float* A5 = A4 + 64 * RL; LAS float* A6 = A5 + 64 * RL; LAS float* A7 = A6 + 64 * RL;
    LAS float* GL = (LAS float*)(lds + RW_GL);
#pragma unroll
    for (int i = 0; i < 8; ++i) { const int e = tid + NT * i, jj = e >> 6, k = e & 63; A7[k * RL + jj] = A2[jj * RL + k]; }
    __syncthreads();
    f32x4 t1[2], z[2]; RW_ZERO(t1); RW_ZERO(z);
    rw_mma(t1, A6, A7, lane, wave);
    rw_mma(z, A5, A7, lane, wave);
    RW_FOREACH(t1, rr, cc, vv, A4[cc * RL + rr] = ((rr == cc ? 1.0f : 0.0f) - vv) * GL[cc];);
    RW_FOREACH(z, rr, cc, vv, A0[cc * RL + rr] = A3[rr * RL + cc] - vv;);
    __syncthreads();
    f32x4 nc[2]; RW_ZERO(nc);
    rw_mma(nc, A1, A0, lane, wave);
    RW_FOREACH(nc, rr, cc, vv, A2[rr * RL + cc] = vv * GL[cc];);
    __syncthreads();
    { const int r = tid >> 3, c0 = (tid & 7) * 8;
      const f32x4 m0 = *(const LAS f32x4*)(A4 + r * RL + c0), m1 = *(const LAS f32x4*)(A4 + r * RL + c0 + 4), n0 = *(const LAS f32x4*)(A2 + r * RL + c0), n1 = *(const LAS f32x4*)(A2 + r * RL + c0 + 4);
      bf16* MB = (bf16*)(a.ws + WS_R + R_RWM) + (size_t)item * 4096 + r * 64 + c0; bf16* NB = (bf16*)(a.ws + WS_R + R_RWN) + (size_t)item * 4096 + r * 64 + c0;
      *(GAS v4u*)MB = (v4u){pk2(m0.x, m0.y), pk2(m0.z, m0.w), pk2(m1.x, m1.y), pk2(m1.z, m1.w)};
      *(GAS v4u*)NB = (v4u){pk2(n0.x, n0.y), pk2(n0.z, n0.w), pk2(n1.x, n1.y), pk2(n1.z, n1.w)}; }
    __syncthreads();
}
__device__ __noinline__ void rwkv_scan(CArgs& a, int bh, LAS unsigned char* lds, int tid) {
    const int lane = tid & 63, wave = tid >> 6, r = tid >> 3, c0 = (tid & 7) * 8;
    LAS float* BUF = (LAS float*)lds;
    const GAS bf16* MG_ = (const GAS bf16*)(a.ws + WS_R + R_RWM) + (size_t)bh * NCH * 4096 + r * 64 + c0; GAS bf16* NG_ = (GAS bf16*)(a.ws + WS_R + R_RWN) + (size_t)bh * NCH * 4096 + r * 64 + c0;
    v4u mq = *(const GAS v4u*)MG_, nq = *(const GAS v4u*)NG_;
    { LAS float* S0 = BUF + r * RL + c0; *(LAS f32x4*)S0 = (f32x4){0.f, 0.f, 0.f, 0.f}; *(LAS f32x4*)(S0 + 4) = (f32x4){0.f, 0.f, 0.f, 0.f};
      LAS float* M0 = BUF + 64 * RL + r * RL + c0; *(LAS f32x4*)M0 = (f32x4){bflo(mq.x), bfhi(mq.x), bflo(mq.y), bfhi(mq.y)}; *(LAS f32x4*)(M0 + 4) = (f32x4){bflo(mq.z), bfhi(mq.z), bflo(mq.w), bfhi(mq.w)};
      LAS float* N0 = BUF + 128 * RL + r * RL + c0; *(LAS f32x4*)N0 = (f32x4){bflo(nq.x), bfhi(nq.x), bflo(nq.y), bfhi(nq.y)}; *(LAS f32x4*)(N0 + 4) = (f32x4){bflo(nq.z), bfhi(nq.z), bflo(nq.w), bfhi(nq.w)}; }
    if (NCH > 1) { mq = *(const GAS v4u*)(MG_ + 4096); nq = *(const GAS v4u*)(NG_ + 4096); }
    __syncthreads();
    for (int c = 0; c < NCH; ++c) {
        LAS float* SB = BUF + (c & 1) * 192 * RL; LAS float* MT = SB + 64 * RL; LAS float* NB = SB + 128 * RL;
        LAS float* SN = BUF + ((c & 1) ^ 1) * 192 * RL;
        { const f32x4 x = *(const LAS f32x4*)(SB + r * RL + c0), y = *(const LAS f32x4*)(SB + r * RL + c0 + 4);
          *(GAS v4u*)(NG_ + (size_t)c * 4096) = (v4u){pk2(x.x, x.y), pk2(x.z, x.w), pk2(y.x, y.y), pk2(y.z, y.w)}; }
        if (c + 1 < NCH) {
            LAS float* M1 = SN + 64 * RL + r * RL + c0; *(LAS f32x4*)M1 = (f32x4){bflo(mq.x), bfhi(mq.x), bflo(mq.y), bfhi(mq.y)}; *(LAS f32x4*)(M1 + 4) = (f32x4){bflo(mq.z), bfhi(mq.z), bflo(mq.w), bfhi(mq.w)};
            LAS float* N1 = SN + 128 * RL + r * RL + c0; *(LAS f32x4*)N1 = (f32x4){bflo(nq.x), bfhi(nq.x), bflo(nq.y), bfhi(nq.y)}; *(LAS f32x4*)(N1 + 4) = (f32x4){bflo(nq.z), bfhi(nq.z), bflo(nq.w), bfhi(nq.w)};
            if (c + 2 < NCH) { mq = *(const GAS v4u*)(MG_ + (size_t)(c + 2) * 4096); nq = *(const GAS v4u*)(NG_ + (size_t)(c + 2) * 4096); } }
        f32x4 acc[2];
#pragma unroll
        for (int t_ = 0; t_ < 2; ++t_)
#pragma unroll
            for (int r_ = 0; r_ < 4; ++r_) acc[t_][r_] = NB[(16 * (wave >> 1) + 4 * (lane >> 4) + r_) * RL + 16 * ((wave & 1) * 2 + t_) + (lane & 15)];
        rw_mma(acc, SB, MT, lane, wave);
        RW_FOREACH(acc, rr, cc, vv, SN[rr * RL + cc] = vv;);
        __syncthreads();
    }
}
__device__ __noinline__ void rwkv_stage3(CArgs& a, int l, int item, LAS unsigned char* lds, int tid) {
    if (RWKV_CACHE) rwkv_cache_get(a, item, lds, tid); else rwkv_front(a, l, item, lds, tid);
    const int c = item % NCH, bh = item / NCH, b = bh >> 2, h = bh & 3, lane = tid & 63, wave = tid >> 6;
    LAS float* A0 = (LAS float*)lds; LAS float* A1 = A0 + 64 * RL; LAS float* A2 = A1 + 64 * RL; LAS float* A3 = A2 + 64 * RL; LAS float* A4 = A3 + 64 * RL; LAS float* A5 = A4 + 64 * RL; LAS float* A6 = A5 + 64 * RL; LAS float* A7 = A6 + 64 * RL;
    LAS unsigned short* GB = (LAS unsigned short*)(lds + RW_GB); LAS float* BON = (LAS float*)(lds + RW_GL) + 64;
    { f32x4 b1[2], b2[2]; RW_ZERO(b1); RW_ZERO(b2);
      rw_mma(b1, A2, A4, lane, wave); rw_mma(b2, A3, A4, lane, wave);
      RW_FOREACH(b1, rr, cc, vv, A0[cc * RL + rr] = rr <= cc ? vv : 0.f;);
      RW_FOREACH(b2, rr, cc, vv, A7[rr * RL + cc] = rr <= cc ? vv : 0.f;); }
    __syncthreads();
    { f32x4 w1[2], w2[2]; RW_ZERO(w1); RW_ZERO(w2);
      rw_mma(w1, A6, A0, lane, wave); rw_mma(w2, A5, A0, lane, wave);
      RW_FOREACH(w1, rr, cc, vv, A2[cc * RL + rr] = A4[cc * RL + rr] - vv;);
      RW_FOREACH(w2, rr, cc, vv, A3[cc * RL + rr] = A7[rr * RL + cc] - vv;);
      const int r = tid >> 3, c0 = (tid & 7) * 8;
      const v4u sv = *(const GAS v4u*)((const bf16*)(a.ws + WS_R + R_RWN) + (size_t)item * 4096 + r * 64 + c0);
      __syncthreads();
      *(LAS f32x4*)(A0 + r * RL + c0) = (f32x4){bflo(sv.x), bfhi(sv.x), bflo(sv.y), bfhi(sv.y)}; *(LAS f32x4*)(A0 + r * RL + c0 + 4) = (f32x4){bflo(sv.z), bfhi(sv.z), bflo(sv.w), bfhi(sv.w)}; }
    __syncthreads();
    { f32x4 y[2]; RW_ZERO(y);
      rw_mma(y, A0, A2, lane, wave); rw_mma(y, A1, A3, lane, wave);
      RW_FOREACH(y, rr, cc, vv, A6[cc * RL + rr] = vv;); }
    __syncthreads();
    { const float* gn_g = a.in[I_RW_GNG] + (size_t)l * 256 + h * 64; const float* gn_b = a.in[I_RW_GNB] + (size_t)l * 256 + h * 64; bf16* Y = (bf16*)(a.ws + WS_Y);
      for (int jj = wave; jj < 64; jj += NWAVES) { const int t = 64 * c - PADT + jj; if (t < 0) continue;
          const float y = A6[jj * RL + lane]; const float mean = wave_sum_fast(y) * (1.0f / 64.0f); const float dlt = y - mean; const float var = wave_sum_fast(dlt * dlt) * (1.0f / 64.0f);
          const float yn = dlt * __builtin_amdgcn_rsqf(var + 64e-5f) * gn_g[lane] + gn_b[lane];
          const float o = (yn + BON[jj] * A1[lane * RL + jj]) * bf2f(GB[jj * 64 + lane]);
          Y[(size_t)(b * T + t) * 256 + h * 64 + lane] = (bf16)f2bf(o); } }
    __syncthreads();
}

constexpr int DH_SMALL = 131072, DH_STRIDE = 14464;
constexpr int DH_HIST = 0, DH_IDX = 2048, DH_QV = 4096, DH_PR = 6144, DH_SEL = 14336;
constexpr int DH_BT = DH_SMALL + 2 * DH_STRIDE, DH_BAR = DH_BT + 2112, DH_END = DH_BAR + 64;
static_assert(DH_PR + 8192 <= DH_SEL && DH_END <= MISC_OFF, "DSA half LDS map");
constexpr unsigned DH_SPIN_CAP = 1u << 24;

__device__ __forceinline__ void half_bar(LAS unsigned* ctr, unsigned& target, int lane) {
    asm volatile("s_waitcnt vmcnt(0) lgkmcnt(0)" ::: "memory");
    __builtin_amdgcn_fence(__ATOMIC_RELEASE, "workgroup");
    target += 4u;
    if (lane == 0) { const unsigned old = __hip_atomic_fetch_add(ctr, 1u, __ATOMIC_ACQ_REL, __HIP_MEMORY_SCOPE_WORKGROUP);
        unsigned sp = 0u; if (old + 1u < target) while (__hip_atomic_load(ctr, __ATOMIC_ACQUIRE, __HIP_MEMORY_SCOPE_WORKGROUP) < target) { __builtin_amdgcn_s_sleep(1); if (++sp > DH_SPIN_CAP) break; } }
    __builtin_amdgcn_fence(__ATOMIC_ACQUIRE, "workgroup");
    asm volatile("s_waitcnt vmcnt(0) lgkmcnt(0)" ::: "memory");
}
__device__ __noinline__ void dsa_half_init(CArgs& a, LAS unsigned char* lds, int tid) {
    LAS float* BT = (LAS float*)(lds + DH_BT); const float* rb = a.in[I_RELB];
    for (int i = tid; i < 129 * 4; i += NT) { const int n = i >> 2, hh = i & 3; int bk;
        if (n < 16) bk = n; else if (n >= 128) bk = 31; else { bk = 16 + (n >= 19) + (n >= 21) + (n >= 24) + (n >= 27) + (n >= 31) + (n >= 35) + (n >= 40) + (n >= 46) + (n >= 52) + (n >= 59) + (n >= 67) + (n >= 77) + (n >= 87) + (n >= 99) + (n >= 113); }
        BT[i] = rb[bk * 4 + hh]; }
    for (int i = tid; i < 2 * DH_STRIDE / 4; i += NT) ((LAS unsigned*)(lds + DH_SMALL))[i] = 0u;
    if (tid < 16) ((LAS unsigned*)(lds + DH_BAR))[tid] = 0u;
    __syncthreads();
}
__device__ __forceinline__ void dsa_half_loop(CArgs& a, unsigned* qctr, LAS unsigned char* lds, int tid) {
    const int lane = tid & 63, wave = tid >> 6, hb = wave >> 2, w4 = wave & 3, q = w4 >> 1, part = w4 & 1, ht = tid & 255;
    LAS unsigned char* SB = lds + DH_SMALL + hb * DH_STRIDE;
    LAS float* SC = (LAS float*)(lds + hb * 65536);
    LAS unsigned* HIST = (LAS unsigned*)(SB + DH_HIST); LAS int* IDX = (LAS int*)(SB + DH_IDX); LAS float* QV = (LAS float*)(SB + DH_QV); LAS float* PR = (LAS float*)(SB + DH_PR);
    LAS unsigned* SEL = (LAS unsigned*)(SB + DH_SEL); LAS float* BT = (LAS float*)(lds + DH_BT);
    LAS unsigned* CAND = (LAS unsigned*)PR; LAS unsigned* CANDI = CAND + 512; LAS unsigned* HISTB = CAND + 1024;
    LAS unsigned* BARC = (LAS unsigned*)(lds + DH_BAR) + hb; volatile LAS int* SLOT = (volatile LAS int*)(lds + DH_BAR) + 4 + hb;
    const bf16* P = (const bf16*)(a.ws + WS_R + R_P);
    const bf16* KB = (const bf16*)(a.ws + WS_MG + MI_K); const bf16* VB = (const bf16*)(a.ws + WS_MG + MI_V); const bf16* KI = (const bf16*)(a.ws + WS_MG + MI_KI);
    constexpr int NQ2 = M / 2;
    unsigned bt = 0u;
#ifdef DSA_ONEHALF
    if (hb == DSA_ONEHALF - 1) return;
#endif
    int nxt = 0; if (ht == 0) nxt = (int)__hip_atomic_fetch_add(qctr, 1u, __ATOMIC_RELAXED, __HIP_MEMORY_SCOPE_AGENT);
    for (;;) {
        if (ht == 0) { SLOT[0] = nxt; nxt = (int)__hip_atomic_fetch_add(qctr, 1u, __ATOMIC_RELAXED, __HIP_MEMORY_SCOPE_AGENT); }
        half_bar(BARC, bt, lane);
        const int kq_ = SLOT[0];
        if (kq_ >= NQ2) break;
        const int b = kq_ & 3, t0 = 2 * (T / 2 - 1 - (kq_ >> 2)), m0 = b * T + t0;
        for (int i = ht; i < 512; i += 256) { const int qq = i >> 8, cc = i & 255; QV[i] = bf2f(P[(size_t)(m0 + qq) * PW + C_DSA + cc]) * 0.125f; }
        if (t0 < 256) {
            for (int i = ht; i < 512; i += 256) IDX[i] = i & 255;
        } else {
            for (int i = ht; i < 512; i += 256) HISTB[i] = 0u;
            { const int r16 = lane & 15, g = lane >> 4, qa = r16 >> 3, ha = r16 & 7;
              const bf16x8 af = *(const GAS bf16x8*)(P + (size_t)(m0 + qa) * PW + C_DSA + 384 + ha * 32 + 8 * g);
              const int qg = g >> 1;
              float wq[4];
#pragma unroll
              for (int i = 0; i < 4; ++i) wq[i] = bf2f(P[(size_t)(m0 + qg) * PW + C_DSA + 672 + 4 * (g & 1) + i]) * 0.0625f;
              const int ntile = (t0 + 2 - 16 + 15) >> 4;
              const GAS bf16* kbase = (const GAS bf16*)KI + (size_t)(b * T + 16 + r16) * 32 + 8 * g;
              for (int kt = w4; kt < ntile; kt += 16) {
                  bf16x8 bf[4];
#pragma unroll
                  for (int u = 0; u < 4; ++u) { const int k2 = kt + 4 * u < ntile ? kt + 4 * u : kt; bf[u] = *(const GAS bf16x8*)(kbase + (size_t)k2 * 512); }
#pragma unroll
                  for (int u = 0; u < 4; ++u) { if (kt + 4 * u >= ntile) break;
                      const int s = 16 + 16 * (kt + 4 * u) + r16;
                      f32x4 acc = (f32x4){0.f, 0.f, 0.f, 0.f};
                      acc = __builtin_amdgcn_mfma_f32_16x16x32_bf16(af, bf[u], acc, 0, 0, 0);
                      float p = wq[0] * fmaxf(acc[0], 0.f) + wq[1] * fmaxf(acc[1], 0.f) + wq[2] * fmaxf(acc[2], 0.f) + wq[3] * fmaxf(acc[3], 0.f);
                      p += __shfl_xor(p, 16);
                      if ((g & 1) == 0) { const bool ok = s <= t0 + qg; SC[qg * 8192 + (s - 16)] = ok ? p : -INFINITY;
                          if (ok) __hip_atomic_fetch_add(&HIST[qg * 256 + (f2key(p) >> 24)], 1u, __ATOMIC_RELAXED, __HIP_MEMORY_SCOPE_WORKGROUP); } }
              } }
        }
        half_bar(BARC, bt, lane);
        if (t0 >= 256) {
            const int n = t0 + q - 15, n4 = (n + 3) >> 2;
            unsigned rem = 240u;
            unsigned prefix = dsa_find_bin(HIST + q * 256, rem, 0u, 24, lane);
            for (int g = part * 64 + lane; g < n4; g += 128) { const f32x4 v = *(const LAS f32x4*)(SC + q * 8192 + 4 * g);
#pragma unroll
                for (int e = 0; e < 4; ++e) { const unsigned key = f2key(v[e]); if (4 * g + e < n && (key & 0xff000000u) == prefix) __hip_atomic_fetch_add(&HISTB[q * 256 + ((key >> 16) & 255u)], 1u, __ATOMIC_RELAXED, __HIP_MEMORY_SCOPE_WORKGROUP); } }
            half_bar(BARC, bt, lane);
            prefix = dsa_find_bin(HISTB + q * 256, rem, prefix, 16, lane);
            const int D = 240 - (int)rem;
            { const int gh = (n4 + 1) >> 1, gbeg = part * gh, gend = (gbeg + gh < n4) ? gbeg + gh : n4;
              int cnt = 0; const unsigned long long below = (1ull << lane) - 1ull;
              if (part == 0 && lane < 16) IDX[q * 256 + lane] = lane;
              for (int g0 = gbeg; g0 < gend; g0 += 64) { const int g = g0 + lane; const bool gv = g < gend;
                  f32x4 v = (f32x4){0.f, 0.f, 0.f, 0.f}; if (gv) v = *(const LAS f32x4*)(SC + q * 8192 + 4 * g);
                  unsigned key[4]; bool gt[4], eq[4];
#pragma unroll
                  for (int e = 0; e < 4; ++e) { key[e] = f2key(v[e]); const unsigned k16 = key[e] & 0xffff0000u; const bool ok = gv && (4 * g + e < n); gt[e] = ok && k16 > prefix; eq[e] = ok && k16 == prefix; }
                  const unsigned long long m0_ = __ballot(gt[0]), m1_ = __ballot(gt[1]), m2_ = __ballot(gt[2]), m3_ = __ballot(gt[3]);
                  int run = cnt + __popcll(m0_ & below) + __popcll(m1_ & below) + __popcll(m2_ & below) + __popcll(m3_ & below);
#pragma unroll
                  for (int e = 0; e < 4; ++e) if (gt[e]) { int pos = part == 0 ? 16 + run : 16 + D - 1 - run; pos = pos < 16 ? 16 : (pos > 255 ? 255 : pos); IDX[q * 256 + pos] = 16 + 4 * g + e; ++run; }
                  cnt += __popcll(m0_) + __popcll(m1_) + __popcll(m2_) + __popcll(m3_);
#pragma unroll
                  for (int e = 0; e < 4; ++e) if (eq[e]) { const unsigned pp = __hip_atomic_fetch_add(&SEL[q * 4 + 3], 1u, __ATOMIC_RELAXED, __HIP_MEMORY_SCOPE_WORKGROUP); if (pp < 256u) { CAND[q * 256 + pp] = key[e]; CANDI[q * 256 + pp] = 16u + 4u * g + e; } }
              } }
            half_bar(BARC, bt, lane);
            const bool ovf = SEL[3] > 256u || SEL[7] > 256u;
            if (!ovf) {
                const unsigned nc = SEL[q * 4 + 3];
                for (unsigned ci = lane; ci < nc; ci += 64) { const unsigned kv = CAND[q * 256 + ci], iv = CANDI[q * 256 + ci]; unsigned rank = 0u;
                    for (unsigned cj = 0; cj < nc; ++cj) { const unsigned ko = CAND[q * 256 + cj], io = CANDI[q * 256 + cj]; rank += (ko > kv || (ko == kv && io < iv)) ? 1u : 0u; }
                    if (rank < rem) IDX[q * 256 + 16 + D + (int)rank] = (int)iv; }
            } else {
                unsigned mask = 0xffff0000u;
                for (int pass = 2; pass < 4; ++pass) { const int shift = 24 - 8 * pass;
                    half_bar(BARC, bt, lane);
                    for (int i = ht; i < 512; i += 256) HISTB[i] = 0u;
                    half_bar(BARC, bt, lane);
                    for (int i = part * 64 + lane; i < n; i += 128) { const unsigned key = f2key(SC[q * 8192 + i]); if ((key & mask) == prefix) __hip_atomic_fetch_add(&HISTB[q * 256 + ((key >> shift) & 255u)], 1u, __ATOMIC_RELAXED, __HIP_MEMORY_SCOPE_WORKGROUP); }
                    half_bar(BARC, bt, lane);
                    prefix = dsa_find_bin(HISTB + q * 256, rem, prefix, shift, lane); mask |= 255u << shift; }
                half_bar(BARC, bt, lane);
                if (part == 0) { const unsigned thr = prefix;
                    if (lane < 16) IDX[q * 256 + lane] = lane;
                    int base = 16; unsigned eqtaken = 0u; const unsigned long long below = (1ull << lane) - 1ull;
                    for (int i0 = 0; i0 < n; i0 += 64) { const int i = i0 + lane; const bool valid = i < n;
                        const unsigned key = valid ? f2key(SC[q * 8192 + i]) : 0u; const bool gt = valid && key > thr, eq = valid && key == thr;
                        const unsigned long long eqm = __ballot(eq);
                        const bool sel = gt || (eq && (eqtaken + (unsigned)__popcll(eqm & below)) < rem);
                        const unsigned long long sm = __ballot(sel);
                        if (sel) { const int pos = base + __popcll(sm & below); if (pos < 256) IDX[q * 256 + pos] = 16 + i; }
                        base += __popcll(sm); eqtaken += (unsigned)__popcll(eqm); } }
                half_bar(BARC, bt, lane);
            }
            for (int i = ht; i < 512; i += 256) HIST[i] = 0u;
        }
        { const int hp = part, t = t0 + q; const int L = t0 < 256 ? t + 1 : 256;
          LAS unsigned char* KS = (LAS unsigned char*)SC + q * 32768;
          const GAS v4u* KG = (const GAS v4u*)KB; const GAS v4u* VG = (const GAS v4u*)VB;
          if (t0 < 256) half_bar(BARC, bt, lane);
          v4u gv[16];
#define DSA_LOAD(SRC) do { _Pragma("unroll") for (int i = 0; i < 16; ++i) { const int p = lane + 64 * i, row = hp * 128 + (p >> 3), part_ = p & 7; \
              gv[i] = (v4u){0u, 0u, 0u, 0u}; if (row < L) gv[i] = (SRC)[(size_t)(b * T + IDX[q * 256 + row]) * 8 + part_]; } } while (0)
#define DSA_PUT() do { _Pragma("unroll") for (int i = 0; i < 16; ++i) { const int p = lane + 64 * i, row = hp * 128 + (p >> 3), part_ = p & 7; \
              *(LAS v4u*)(KS + row * 128 + ((part_ ^ ((row >> 1) & 7)) << 4)) = gv[i]; } } while (0)
          DSA_LOAD(KG); DSA_PUT();
          half_bar(BARC, bt, lane);
          if (ht < 2) SEL[ht * 4 + 3] = 0u;
          float lg0[4], lg1[4];
#pragma unroll
          for (int r = 0; r < 4; ++r) { const int jj = lane + 64 * r; lg0[r] = -INFINITY; lg1[r] = -INFINITY;
              if (jj < L) { const int idx = IDX[q * 256 + jj];
                  float d0 = 0.f, d1 = 0.f;
#pragma unroll 2
                  for (int dc = 0; dc < 8; ++dc) { const v4u kv = *(const LAS v4u*)(KS + jj * 128 + ((dc ^ ((jj >> 1) & 7)) << 4));
                      const LAS float* q0 = QV + q * 256 + (2 * hp) * 64 + 8 * dc; const LAS float* q1 = q0 + 64;
                      const f32x4 qa = *(const LAS f32x4*)q0, qb = *(const LAS f32x4*)(q0 + 4), qc = *(const LAS f32x4*)q1, qd = *(const LAS f32x4*)(q1 + 4);
                      const float k0 = bflo(kv.x), k1 = bfhi(kv.x), k2 = bflo(kv.y), k3 = bfhi(kv.y), k4 = bflo(kv.z), k5 = bfhi(kv.z), k6 = bflo(kv.w), k7 = bfhi(kv.w);
                      d0 += (k0 * qa.x + k1 * qa.y) + (k2 * qa.z + k3 * qa.w) + (k4 * qb.x + k5 * qb.y) + (k6 * qb.z + k7 * qb.w);
                      d1 += (k0 * qc.x + k1 * qc.y) + (k2 * qc.z + k3 * qc.w) + (k4 * qd.x + k5 * qd.y) + (k6 * qd.z + k7 * qd.w); }
                  int dist = t - idx; dist = dist > 128 ? 128 : dist;
                  lg0[r] = d0 + BT[dist * 4 + 2 * hp]; lg1[r] = d1 + BT[dist * 4 + 2 * hp + 1]; }
              asm volatile("" ::: "memory"); }
          const float m0x = wave_max(fmaxf(fmaxf(lg0[0], lg0[1]), fmaxf(lg0[2], lg0[3]))), m1x = wave_max(fmaxf(fmaxf(lg1[0], lg1[1]), fmaxf(lg1[2], lg1[3])));
          float e0[4], e1[4], s0 = 0.f, s1 = 0.f;
#pragma unroll
          for (int r = 0; r < 4; ++r) { e0[r] = __expf(lg0[r] - m0x); e1[r] = __expf(lg1[r] - m1x); s0 += e0[r]; s1 += e1[r]; }
          DSA_LOAD(VG);
          const float i0 = 1.0f / wave_sum(s0), i1 = 1.0f / wave_sum(s1);
          half_bar(BARC, bt, lane);
#pragma unroll
          for (int r = 0; r < 4; ++r) { const int jj = lane + 64 * r; PR[(q * 4 + 2 * hp) * 256 + jj] = e0[r] * i0; PR[(q * 4 + 2 * hp + 1) * 256 + jj] = e1[r] * i1; }
          DSA_PUT();
          half_bar(BARC, bt, lane);
#undef DSA_LOAD
#undef DSA_PUT
          { const LAS float* p0 = PR + (q * 4 + 2 * hp) * 256; const LAS float* p1 = p0 + 256;
            const int rg = lane >> 3, dp = lane & 7;
            float o0[8], o1[8];
#pragma unroll
            for (int e = 0; e < 8; ++e) { o0[e] = 0.f; o1[e] = 0.f; }
#pragma unroll 4
            for (int jb = 0; jb < 256; jb += 8) { const int row = jb + rg; const v4u kv = *(const LAS v4u*)(KS + row * 128 + ((dp ^ ((row >> 1) & 7)) << 4)); const float pa = p0[row], pb = p1[row];
                const float v0 = bflo(kv.x), v1 = bfhi(kv.x), v2 = bflo(kv.y), v3 = bfhi(kv.y), v4 = bflo(kv.z), v5 = bfhi(kv.z), v6 = bflo(kv.w), v7 = bfhi(kv.w);
                o0[0] += pa * v0; o0[1] += pa * v1; o0[2] += pa * v2; o0[3] += pa * v3; o0[4] += pa * v4; o0[5] += pa * v5; o0[6] += pa * v6; o0[7] += pa * v7;
                o1[0] += pb * v0; o1[1] += pb * v1; o1[2] += pb * v2; o1[3] += pb * v3; o1[4] += pb * v4; o1[5] += pb * v5; o1[6] += pb * v6; o1[7] += pb * v7; }
#pragma unroll
            for (int e = 0; e < 8; ++e) { o0[e] += dppf<0x128>(o0[e]); o1[e] += dppf<0x128>(o1[e]);
                o0[e] += __shfl_xor(o0[e], 16); o1[e] += __shfl_xor(o1[e], 16); o0[e] += __shfl_xor(o0[e], 32); o1[e] += __shfl_xor(o1[e], 32); }
            if (rg == 0) { bf16* Y = (bf16*)(a.ws + WS_Y) + (size_t)2 * MP * 256 + (size_t)(m0 + q) * 256;
                *(GAS v4u*)(Y + (2 * hp) * 64 + 8 * dp) = (v4u){pk2(o0[0], o0[1]), pk2(o0[2], o0[3]), pk2(o0[4], o0[5]), pk2(o0[6], o0[7])};
                *(GAS v4u*)(Y + (2 * hp + 1) * 64 + 8 * dp) = (v4u){pk2(o1[0], o1[1]), pk2(o1[2], o1[3]), pk2(o1[4], o1[5]), pk2(o1[6], o1[7])}; } }
        }
    }
}

namespace pg8 {
template <int ACT  > struct EpiStoreBf16 {
    static constexpr bool PERM = true, AFTER_DRAIN = false;
    bf16_t* O; int ldc;
    __device__ __forceinline__ void operator()(const f32x4 (&acc)[2][2][4][2], const Unit& u, int wr, int wc, int fr, int fq) const {
        const int row0 = u.pm * BM + wr * 64 + fr, col0 = u.pn * BM + wc * 32 + 8 * fq;
#pragma unroll
        for (int ai = 0; ai < 2; ++ai)
#pragma unroll
            for (int m = 0; m < 4; ++m) { bf16_t* rowp = O + (size_t)(row0 + ai * HALF + m * 16) * ldc + col0;
#pragma unroll
                for (int bj = 0; bj < 2; ++bj) { f32x4 v0 = acc[ai][bj][m][0], v1 = acc[ai][bj][m][1];
                    if (ACT == 1) {
#pragma unroll
                        for (int j = 0; j < 4; ++j) { v0[j] = __builtin_amdgcn_rcpf(1.0f + __expf(-v0[j])); v1[j] = __builtin_amdgcn_rcpf(1.0f + __expf(-v1[j])); } }
                    u32x4 w; w.x = cvt_pk_bf16(v0[0], v0[1]); w.y = cvt_pk_bf16(v0[2], v0[3]); w.z = cvt_pk_bf16(v1[0], v1[1]); w.w = cvt_pk_bf16(v1[2], v1[3]);
                    *(u32x4*)(rowp + bj * HALF) = w; } }
    }
};
__device__ __forceinline__ float bf_lo(unsigned w) { return __builtin_bit_cast(float, w << 16); }
__device__ __forceinline__ float bf_hi(unsigned w) { return __builtin_bit_cast(float, w & 0xffff0000u); }
struct EpiMerge {
    static constexpr bool PERM = true, AFTER_DRAIN = false;
    const bf16_t* G; bf16_t* MG;
    __device__ __forceinline__ void operator()(const f32x4 (&acc)[2][2][4][2], const Unit& u, int wr, int wc, int fr, int fq) const {
        const int br = u.x0, row0 = u.x1 * BM + wr * 64 + fr, col0 = (u.pn & 3) * BM + wc * 32 + 8 * fq;
#pragma unroll
        for (int ai = 0; ai < 2; ++ai) {
            u32x4 g[4][2], o[4][2];
#pragma unroll
            for (int m = 0; m < 4; ++m)
#pragma unroll
                for (int bj = 0; bj < 2; ++bj) { const size_t r = (size_t)(row0 + ai * HALF + m * 16);
                    g[m][bj] = *(const u32x4*)(G + r * 4096 + br * 1024 + col0 + bj * HALF);
                    o[m][bj] = (u32x4){0u, 0u, 0u, 0u};
                    if (br > 0) o[m][bj] = __builtin_nontemporal_load((const u32x4*)(MG + r * 1024 + col0 + bj * HALF)); }
#pragma unroll
            for (int m = 0; m < 4; ++m)
#pragma unroll
                for (int bj = 0; bj < 2; ++bj) { const size_t r = (size_t)(row0 + ai * HALF + m * 16);
                    f32x4 v0 = acc[ai][bj][m][0], v1 = acc[ai][bj][m][1]; const u32x4 gg = g[m][bj], oo = o[m][bj];
                    v0[0] = v0[0] * bf_lo(gg.x) + bf_lo(oo.x); v0[1] = v0[1] * bf_hi(gg.x) + bf_hi(oo.x); v0[2] = v0[2] * bf_lo(gg.y) + bf_lo(oo.y); v0[3] = v0[3] * bf_hi(gg.y) + bf_hi(oo.y);
                    v1[0] = v1[0] * bf_lo(gg.z) + bf_lo(oo.z); v1[1] = v1[1] * bf_hi(gg.z) + bf_hi(oo.z); v1[2] = v1[2] * bf_lo(gg.w) + bf_lo(oo.w); v1[3] = v1[3] * bf_hi(gg.w) + bf_hi(oo.w);
                    u32x4 w; w.x = cvt_pk_bf16(v0[0], v0[1]); w.y = cvt_pk_bf16(v0[2], v0[3]); w.z = cvt_pk_bf16(v1[0], v1[1]); w.w = cvt_pk_bf16(v1[2], v1[3]);
                    *(u32x4*)(MG + r * 1024 + col0 + bj * HALF) = w; }
            asm volatile("" ::: "memory"); }
    }
};
struct EpiResid {
    static constexpr bool PERM = false, AFTER_DRAIN = false;
    const bf16_t* H; bf16_t* X1; float alpha;
    __device__ __forceinline__ void operator()(const f32x4 (&acc)[2][2][4][2], const Unit& u, int wr, int wc, int fr, int fq) const {
        const int row0 = u.pm * BM + wr * 64 + fr, col0 = u.pn * BM + wc * 32 + 4 * fq;
#pragma unroll
        for (int ai = 0; ai < 2; ++ai)
#pragma unroll
            for (int m = 0; m < 4; ++m) { const size_t off = (size_t)(row0 + ai * HALF + m * 16) * 1024 + col0;
#pragma unroll
                for (int bj = 0; bj < 2; ++bj)
#pragma unroll
                    for (int n = 0; n < 2; ++n) { const uint2 hv = *(const uint2*)(H + off + bj * HALF + n * 16);
                        f32x4 o = acc[ai][bj][m][n]; o[0] += alpha * bf_lo(hv.x); o[1] += alpha * bf_hi(hv.x); o[2] += alpha * bf_lo(hv.y); o[3] += alpha * bf_hi(hv.y);
                        *(uint2*)(X1 + off + bj * HALF + n * 16) = make_uint2(cvt_pk_bf16(o[0], o[1]), cvt_pk_bf16(o[2], o[3])); }
                if (m == 3) asm volatile("" ::: "memory"); }
    }
};
struct EpiSwiglu {
    static constexpr bool PERM = true, AFTER_DRAIN = false;
    bf16_t* HID;
    __device__ __forceinline__ void operator()(const f32x4 (&acc)[2][2][4][2], const Unit& u, int wr, int wc, int fr, int fq) const {
        const int row0 = u.pm * BM + wr * 64 + fr, col0 = u.x0 * 128 + wc * 32 + 8 * fq;
#pragma unroll
        for (int ai = 0; ai < 2; ++ai)
#pragma unroll
            for (int m = 0; m < 4; ++m) { f32x4 v0, v1;
#pragma unroll
                for (int j = 0; j < 4; ++j) { const float g0 = acc[ai][0][m][0][j], g1 = acc[ai][0][m][1][j];
                    v0[j] = g0 * __builtin_amdgcn_rcpf(1.0f + __expf(-g0)) * acc[ai][1][m][0][j]; v1[j] = g1 * __builtin_amdgcn_rcpf(1.0f + __expf(-g1)) * acc[ai][1][m][1][j]; }
                u32x4 w; w.x = cvt_pk_bf16(v0[0], v0[1]); w.y = cvt_pk_bf16(v0[2], v0[3]); w.z = cvt_pk_bf16(v1[0], v1[1]); w.w = cvt_pk_bf16(v1[2], v1[3]);
                *(u32x4*)(HID + (size_t)(row0 + ai * HALF + m * 16) * 256 + col0) = w; }
    }
};
struct EpiDown {
    static constexpr bool PERM = true, AFTER_DRAIN = false;
    const int* ROWTOK; const float* ROWW; bf16_t* O2; size_t slot_stride;
    __device__ __forceinline__ void operator()(const f32x4 (&acc)[2][2][4][2], const Unit& u, int wr, int wc, int fr, int fq) const {
        const int row0 = u.pm * BM + wr * 64 + fr, col0 = u.x0 * BM + wc * 32 + 8 * fq;
#pragma unroll
        for (int ai = 0; ai < 2; ++ai)
#pragma unroll
            for (int m = 0; m < 4; ++m) { const int r = row0 + ai * HALF + m * 16; const int tk = ROWTOK[r];
                if (tk >= 0) { const float wgt = ROWW[r]; bf16_t* dst = O2 + (size_t)(tk & 1) * slot_stride + (size_t)(tk >> 1) * 1024 + col0;
#pragma unroll
                    for (int bj = 0; bj < 2; ++bj) { const f32x4 v0 = acc[ai][bj][m][0] * wgt, v1 = acc[ai][bj][m][1] * wgt;
                        u32x4 w; w.x = cvt_pk_bf16(v0[0], v0[1]); w.y = cvt_pk_bf16(v0[2], v0[3]); w.z = cvt_pk_bf16(v1[0], v1[1]); w.w = cvt_pk_bf16(v1[2], v1[3]);
                        *(u32x4*)(dst + bj * HALF) = w; } }
                if (m == 3) asm volatile("" ::: "memory"); }
    }
};
struct OrderMerge {
    int G, c;
    __device__ bool next(int i, Unit& u) const { const int tile = (i >> 2) * G + c; if (tile >= 128 * 4) return false; const int br = i & 3, pm = tile >> 2, pn = tile & 3;
        u.pm = br * 129 + pm; u.pn = br * 4 + pn; u.x0 = br; u.x1 = pm; return true; }
    __device__ __forceinline__ void a_ready(const Unit&) const {}
    __device__ __forceinline__ void done(const Unit&) const {}
};
struct OrderExpert {
    int G, c, nsub, ntiles; const PG8_LAS int* offs;
    __device__ bool next(int i, Unit& u) const { const int L = i * G + c; if (L >= ntiles * nsub) return false; const int tile = L / nsub, sub = L % nsub;
        int e = 0;
#pragma unroll
        for (int k = 1; k < 16; ++k) e += (offs[k] <= tile) ? 1 : 0;
        e = __builtin_amdgcn_readfirstlane(e); u.pm = tile; u.pn = e * nsub + sub; u.x0 = sub; u.x1 = e; return true; }
    __device__ __forceinline__ void a_ready(const Unit&) const {}
    __device__ __forceinline__ void done(const Unit&) const {}
};
}

__device__ __forceinline__ f32x4 skinny_tile(const bf16* A, int lda, const bf16* Bt, int K, int lane) {
    const GAS bf16* ap = (const GAS bf16*)A + (size_t)(lane & 15) * lda + 8 * (lane >> 4);
    const GAS bf16* bp = (const GAS bf16*)Bt + (size_t)(lane & 15) * K + 8 * (lane >> 4);
    f32x4 acc = (f32x4){0.f, 0.f, 0.f, 0.f};
    for (int k = 0; k < K; k += 128) {
        bf16x8 af[4], bf[4];
#pragma unroll
        for (int u = 0; u < 4; ++u) { af[u] = *(const GAS bf16x8*)(ap + k + 32 * u); bf[u] = *(const GAS bf16x8*)(bp + k + 32 * u); }
#pragma unroll
        for (int u = 0; u < 4; ++u) acc = __builtin_amdgcn_mfma_f32_16x16x32_bf16(af[u], bf[u], acc, 0, 0, 0);
    }
    return acc;
}
constexpr int TAIL0 = 32768;
__device__ __forceinline__ void tail_inproj(CArgs& a, int gw, int ngw, int lane) {
    const bf16* HB = (const bf16*)(a.ws + WS_HB); const bf16* W = (const bf16*)(a.ws + WS_W + W_IN); bf16* P = (bf16*)(a.ws + WS_R + R_P);
    for (int tk = gw; tk < 4 * (PW / 16); tk += ngw) { const int rg = tk & 3, ct = tk >> 2;
        const f32x4 acc = skinny_tile(HB + (size_t)(TAIL0 + 16 * rg) * D, D, W + (size_t)(16 * ct) * D, D, lane);
#pragma unroll
        for (int r = 0; r < 4; ++r) P[(size_t)(TAIL0 + 16 * rg + 4 * (lane >> 4) + r) * PW + 16 * ct + (lane & 15)] = (bf16)f2bf(acc[r]); }
}
__device__ __forceinline__ void tail_gates(CArgs& a, int gw, int ngw, int lane) {
    const bf16* HB = (const bf16*)(a.ws + WS_HB); const bf16* W = (const bf16*)(a.ws + WS_W + W_G); bf16* G = (bf16*)(a.ws + WS_R + R_G);
    for (int tk = gw; tk < 4 * 256; tk += ngw) { const int rg = tk & 3, ct = tk >> 2;
        const f32x4 acc = skinny_tile(HB + (size_t)(TAIL0 + 16 * rg) * D, D, W + (size_t)(16 * ct) * D, D, lane);
#pragma unroll
        for (int r = 0; r < 4; ++r) G[(size_t)(TAIL0 + 16 * rg + 4 * (lane >> 4) + r) * 4096 + 16 * ct + (lane & 15)] = (bf16)f2bf(1.0f / (1.0f + __expf(-acc[r]))); }
}
__device__ __forceinline__ void tail_merge(CArgs& a, int gw, int ngw, int lane) {
    const bf16* Y = (const bf16*)(a.ws + WS_Y); const bf16* W = (const bf16*)(a.ws + WS_W + W_B); const bf16* G = (const bf16*)(a.ws + WS_R + R_G); bf16* MG = (bf16*)(a.ws + WS_MG);
    for (int tk = gw; tk < 4 * 64; tk += ngw) { const int rg = tk & 3, ct = tk >> 2; float m[4] = {0.f, 0.f, 0.f, 0.f};
#pragma unroll
        for (int br = 0; br < 4; ++br) { const f32x4 acc = skinny_tile(Y + ((size_t)br * MP + TAIL0 + 16 * rg) * 256, 256, W + ((size_t)br * D + 16 * ct) * 256, 256, lane);
#pragma unroll
            for (int r = 0; r < 4; ++r) m[r] += acc[r] * bf2f(G[(size_t)(TAIL0 + 16 * rg + 4 * (lane >> 4) + r) * 4096 + br * 1024 + 16 * ct + (lane & 15)]); }
#pragma unroll
        for (int r = 0; r < 4; ++r) MG[(size_t)(TAIL0 + 16 * rg + 4 * (lane >> 4) + r) * D + 16 * ct + (lane & 15)] = (bf16)f2bf(m[r]); }
}
__device__ __forceinline__ void tail_outproj(CArgs& a, int gw, int ngw, int lane) {
    const bf16* MG = (const bf16*)(a.ws + WS_MG); const bf16* W = (const bf16*)(a.ws + WS_W + W_O); const bf16* HB = (const bf16*)(a.ws + WS_HB); bf16* X1 = (bf16*)(a.ws + WS_R + R_X1);
    for (int tk = gw; tk < 4 * 64; tk += ngw) { const int rg = tk & 3, ct = tk >> 2;
        const f32x4 acc = skinny_tile(MG + (size_t)(TAIL0 + 16 * rg) * D, D, W + (size_t)(16 * ct) * D, D, lane);
#pragma unroll
        for (int r = 0; r < 4; ++r) { const size_t o = (size_t)(TAIL0 + 16 * rg + 4 * (lane >> 4) + r) * D + 16 * ct + (lane & 15); X1[o] = (bf16)f2bf(DN_ALPHA * bf2f(HB[o]) + acc[r]); } }
}
__device__ __forceinline__ void route_row(const float (&lg)[20], const float* bg, const float* br, LAS int* REC, LAS float* RECW, LAS int* LCNT, int lr) {
    const float q0 = lg[0] + bg[0], q1 = lg[1] + bg[1], q2 = lg[2] + bg[2], q3 = lg[3] + bg[3];
    int gs = 0; float gm = q0; if (q1 > gm) { gm = q1; gs = 1; } if (q2 > gm) { gm = q2; gs = 2; } if (q3 > gm) { gm = q3; gs = 3; }
    const float pg = 1.0f / (expf(q0 - gm) + expf(q1 - gm) + expf(q2 - gm) + expf(q3 - gm));
    float e0 = 0.f, e1 = 0.f, e2 = 0.f, e3 = 0.f;
    if (gs == 0) { e0 = lg[4]; e1 = lg[5]; e2 = lg[6]; e3 = lg[7]; } else if (gs == 1) { e0 = lg[8]; e1 = lg[9]; e2 = lg[10]; e3 = lg[11]; }
    else if (gs == 2) { e0 = lg[12]; e1 = lg[13]; e2 = lg[14]; e3 = lg[15]; } else { e0 = lg[16]; e1 = lg[17]; e2 = lg[18]; e3 = lg[19]; }
    e0 += br[gs * 4 + 0]; e1 += br[gs * 4 + 1]; e2 += br[gs * 4 + 2]; e3 += br[gs * 4 + 3];
    int i1 = 0; float v1 = e0; if (e1 > v1) { v1 = e1; i1 = 1; } if (e2 > v1) { v1 = e2; i1 = 2; } if (e3 > v1) { v1 = e3; i1 = 3; }
    int i2 = -1; float v2 = -INFINITY;
    if (i1 != 0 && e0 > v2) { v2 = e0; i2 = 0; } if (i1 != 1 && e1 > v2) { v2 = e1; i2 = 1; } if (i1 != 2 && e2 > v2) { v2 = e2; i2 = 2; } if (i1 != 3 && e3 > v2) { v2 = e3; i2 = 3; }
    const float x2 = expf(v2 - v1), w1 = pg / (1.0f + x2), w2 = pg * x2 / (1.0f + x2);
    const int ex1 = gs * 4 + i1, ex2 = gs * 4 + i2;
    REC[lr * 4 + 0] = ex1; REC[lr * 4 + 1] = ex2;
    REC[lr * 4 + 2] = __hip_atomic_fetch_add(&LCNT[ex1], 1, __ATOMIC_RELAXED, __HIP_MEMORY_SCOPE_WORKGROUP); REC[lr * 4 + 3] = __hip_atomic_fetch_add(&LCNT[ex2], 1, __ATOMIC_RELAXED, __HIP_MEMORY_SCOPE_WORKGROUP);
    RECW[lr * 2 + 0] = w1; RECW[lr * 2 + 1] = w2;
}
__device__ __noinline__ void ln1_router_phase(CArgs& a, int l, LAS unsigned char* lds, int tid, int G, int cslot) {
    const int lane = tid & 63, wave = tid >> 6;
    LAS float* WR = (LAS float*)lds;
    LAS int* LCNT = (LAS int*)(lds + 1024 * 20 * 4);
    LAS int* REC = LCNT + 64;
    LAS float* RECW = (LAS float*)(REC + 4 * 160);
    const float* wg = a.in[I_MOE_WGRP] + (size_t)l * D * 4; const float* wr_ = a.in[I_MOE_WRT] + (size_t)l * D * 16;
    for (int i = tid; i < 1024 * 4; i += NT) WR[(i >> 2) * 20 + (i & 3)] = wg[i];
    for (int i = tid; i < 1024 * 16; i += NT) WR[(i >> 4) * 20 + 4 + (i & 15)] = wr_[i];
    if (tid < 32) LCNT[tid] = 0;
    __syncthreads();
    const int rpb = (M + G - 1) / G, r_begin = blockIdx.x * rpb, r_end = min(M, r_begin + rpb);
    const bf16* X1 = (const bf16*)(a.ws + WS_R + R_X1); bf16* HB = (bf16*)(a.ws + WS_HB);
    const float* g1 = a.in[I_LN1G] + (size_t)l * D; const float* b1 = a.in[I_LN1B] + (size_t)l * D;
    const float* bg = a.in[I_MOE_BGRP] + l * 4; const float* br = a.in[I_MOE_BRT] + l * 16;
    for (int m = r_begin + wave; m < r_end; m += 2 * NWAVES) {
        const int m2 = m + NWAVES; const bool has2 = m2 < r_end;
        f32x4 va[4], vb[4];
#pragma unroll
        for (int j = 0; j < 4; ++j) { const uint2 ra = *(const uint2*)(X1 + (size_t)m * D + 4 * lane + 256 * j); uint2 rb = make_uint2(0u, 0u); if (has2) rb = *(const uint2*)(X1 + (size_t)m2 * D + 4 * lane + 256 * j);
            va[j] = (f32x4){bflo(ra.x), bfhi(ra.x), bflo(ra.y), bfhi(ra.y)}; vb[j] = (f32x4){bflo(rb.x), bfhi(rb.x), bflo(rb.y), bfhi(rb.y)}; }
        float meana, rstda, meanb, rstdb; ln_row_stats(va, meana, rstda); ln_row_stats(vb, meanb, rstdb);
#pragma unroll
        for (int j = 0; j < 4; ++j) { const int c0 = 4 * lane + 256 * j; const f32x4 gg = *(const f32x4*)(g1 + c0), bb = *(const f32x4*)(b1 + c0);
            va[j] = (va[j] - meana) * rstda * gg + bb; vb[j] = (vb[j] - meanb) * rstdb * gg + bb;
            *(uint2*)(HB + (size_t)m * D + c0) = make_uint2(pk2(va[j].x, va[j].y), pk2(va[j].z, va[j].w));
            if (has2) *(uint2*)(HB + (size_t)m2 * D + c0) = make_uint2(pk2(vb[j].x, vb[j].y), pk2(vb[j].z, vb[j].w)); }
        float lga[20], lgb[20];
        { float pa[12], pb[12];
#pragma unroll
          for (int k = 0; k < 12; ++k) { pa[k] = 0.f; pb[k] = 0.f; }
#pragma unroll
          for (int j = 0; j < 4; ++j) { const int c0 = 4 * lane + 256 * j;
#pragma unroll
              for (int e = 0; e < 4; ++e) { const LAS float* wrow = WR + (c0 + e) * 20; const float ya = va[j][e], yb = vb[j][e];
#pragma unroll
                  for (int k4 = 0; k4 < 3; ++k4) { const f32x4 w = *(const LAS f32x4*)(wrow + 4 * k4);
                      pa[4 * k4] += ya * w.x; pa[4 * k4 + 1] += ya * w.y; pa[4 * k4 + 2] += ya * w.z; pa[4 * k4 + 3] += ya * w.w;
                      pb[4 * k4] += yb * w.x; pb[4 * k4 + 1] += yb * w.y; pb[4 * k4 + 2] += yb * w.z; pb[4 * k4 + 3] += yb * w.w; }
                  asm volatile("" ::: "memory"); } }
#pragma unroll
          for (int k = 0; k < 12; ++k) { lga[k] = wave_sum_fast(pa[k]); lgb[k] = wave_sum_fast(pb[k]); } }
        { float pa[8], pb[8];
#pragma unroll
          for (int k = 0; k < 8; ++k) { pa[k] = 0.f; pb[k] = 0.f; }
#pragma unroll
          for (int j = 0; j < 4; ++j) { const int c0 = 4 * lane + 256 * j;
#pragma unroll
              for (int e = 0; e < 4; ++e) { const LAS float* wrow = WR + (c0 + e) * 20 + 12; const float ya = va[j][e], yb = vb[j][e];
#pragma unroll
                  for (int k4 = 0; k4 < 2; ++k4) { const f32x4 w = *(const LAS f32x4*)(wrow + 4 * k4);
                      pa[4 * k4] += ya * w.x; pa[4 * k4 + 1] += ya * w.y; pa[4 * k4 + 2] += ya * w.z; pa[4 * k4 + 3] += ya * w.w;
                      pb[4 * k4] += yb * w.x; pb[4 * k4 + 1] += yb * w.y; pb[4 * k4 + 2] += yb * w.z; pb[4 * k4 + 3] += yb * w.w; }
                  asm volatile("" ::: "memory"); } }
#pragma unroll
          for (int k = 0; k < 8; ++k) { lga[12 + k] = wave_sum_fast(pa[k]); lgb[12 + k] = wave_sum_fast(pb[k]); } }
        if (lane == 0) { route_row(lga, bg, br, REC, RECW, LCNT, m - r_begin); if (has2) route_row(lgb, bg, br, REC, RECW, LCNT, m2 - r_begin); }
    }
    __syncthreads();
    unsigned* ecnt = (unsigned*)(a.ws + WS_CTL) + CW_ECNT + 64 * cslot;
    if (tid < 16) LCNT[16 + tid] = (int)atomicAdd(&ecnt[tid], (unsigned)LCNT[tid]);
    __syncthreads();
    int4* ROUTE = (int4*)(a.ws + WS_MISC + MS_ROUTE); float2* RW = (float2*)(a.ws + WS_MISC + MS_RW);
    for (int lr = tid; lr < r_end - r_begin; lr += NT) { const int ex1 = REC[lr * 4], ex2 = REC[lr * 4 + 1];
        ROUTE[r_begin + lr] = make_int4(ex1 | (ex2 << 8), LCNT[16 + ex1] + REC[lr * 4 + 2], LCNT[16 + ex2] + REC[lr * 4 + 3], 0);
        RW[r_begin + lr] = make_float2(RECW[lr * 2], RECW[lr * 2 + 1]); }
    { int* ROWTOK = (int*)(a.ws + WS_MISC + MS_ROWTOK); for (int i = blockIdx.x * NT + tid; i < XROWS; i += G * NT) ROWTOK[i] = -1; }
}
__device__ __forceinline__ void expert_offsets(CArgs& a, int l, volatile LAS int* OFFS, int tid) {
    if (tid == 0) { const unsigned* ecnt = (const unsigned*)(a.ws + WS_CTL) + CW_ECNT + 64 * l; int o = 0;
        for (int e = 0; e < 16; ++e) { OFFS[e] = o; o += (int)((ecnt[e] + 255u) >> 8); } OFFS[16] = o; }
    __syncthreads();
}
__device__ __noinline__ void scatter_phase(CArgs& a, int l, LAS unsigned char* lds, int tid, int G) {
    const int lane = tid & 63, wave = tid >> 6;
    volatile LAS int* OFFS = (volatile LAS int*)(lds + MISC_OFF) + 16;
    expert_offsets(a, l, OFFS, tid);
    const int4* ROUTE = (const int4*)(a.ws + WS_MISC + MS_ROUTE); const float2* RW = (const float2*)(a.ws + WS_MISC + MS_RW);
    int* ROWTOK = (int*)(a.ws + WS_MISC + MS_ROWTOK); float* ROWW = (float*)(a.ws + WS_MISC + MS_ROWW);
    const bf16* HB = (const bf16*)(a.ws + WS_HB); bf16* XG = (bf16*)(a.ws + WS_R + R_XG);
#if defined(ABL) && (ABL & 1)
    { v4u* z = (v4u*)(a.ws + WS_O2); const size_t n16 = (size_t)2 * MP * D * 2 / 16; for (size_t i = (size_t)blockIdx.x * NT + tid; i < n16; i += (size_t)G * NT) z[i] = (v4u){0u, 0u, 0u, 0u}; }
#endif
    const int stride = G * NWAVES;
    int4 nr = make_int4(0, 0, 0, 0); float2 nw = make_float2(0.f, 0.f); v4u nh0 = (v4u){0u, 0u, 0u, 0u}, nh1 = nh0;
    { const int m0_ = blockIdx.x * NWAVES + wave; if (m0_ < M) { nr = ROUTE[m0_]; nw = RW[m0_]; nh0 = *(const v4u*)(HB + (size_t)m0_ * D + 8 * lane); nh1 = *(const v4u*)(HB + (size_t)m0_ * D + 512 + 8 * lane); } }
    for (int m = blockIdx.x * NWAVES + wave; m < M; m += stride) {
        const int4 r = nr; const float2 w = nw; const v4u h0 = nh0, h1 = nh1;
        if (m + stride < M) { const int mn = m + stride; nr = ROUTE[mn]; nw = RW[mn]; nh0 = *(const v4u*)(HB + (size_t)mn * D + 8 * lane); nh1 = *(const v4u*)(HB + (size_t)mn * D + 512 + 8 * lane); }
        const int p0 = OFFS[r.x & 255] * 256 + r.y, p1 = OFFS[(r.x >> 8) & 255] * 256 + r.z;
        *(v4u*)(XG + (size_t)p0 * D + 8 * lane) = h0; *(v4u*)(XG + (size_t)p0 * D + 512 + 8 * lane) = h1;
        *(v4u*)(XG + (size_t)p1 * D + 8 * lane) = h0; *(v4u*)(XG + (size_t)p1 * D + 512 + 8 * lane) = h1;
        if (lane == 0) { ROWTOK[p0] = m * 2; ROWW[p0] = w.x; ROWTOK[p1] = m * 2 + 1; ROWW[p1] = w.y; }
    }
}
__device__ __noinline__ void ln2_phase(CArgs& a, int l, int tid, int G) {
    const int lane = tid & 63, wave = tid >> 6;
    bf16* HB = (bf16*)(a.ws + WS_HB); const bf16* O2 = (const bf16*)(a.ws + WS_O2);
    const float* g2 = a.in[I_LN2G] + (size_t)l * D; const float* b2 = a.in[I_LN2B] + (size_t)l * D;
    const int stride = G * NWAVES;
    uint2 nh[4], na[4], nb[4];
#define LN2_LOAD(mm) do { _Pragma("unroll") for (int j = 0; j < 4; ++j) { const size_t off = (size_t)(mm) * D + 4 * lane + 256 * j; \
        nh[j] = *(const uint2*)(HB + off); na[j] = *(const uint2*)(O2 + off); nb[j] = *(const uint2*)(O2 + (size_t)MP * D + off); } } while (0)
    { const int m0_ = blockIdx.x * NWAVES + wave; if (m0_ < M) LN2_LOAD(m0_); }
    for (int m = blockIdx.x * NWAVES + wave; m < M; m += stride) {
        f32x4 v[4];
#pragma unroll
        for (int j = 0; j < 4; ++j) { const uint2 hv = nh[j]; uint2 oa = na[j], ob = nb[j];
#if defined(ABL) && (ABL & 2)
            oa = make_uint2(0u, 0u); ob = make_uint2(0u, 0u);
#endif
            v[j].x = DN_ALPHA * bflo(hv.x) + bflo(oa.x) + bflo(ob.x); v[j].y = DN_ALPHA * bfhi(hv.x) + bfhi(oa.x) + bfhi(ob.x);
            v[j].z = DN_ALPHA * bflo(hv.y) + bflo(oa.y) + bflo(ob.y); v[j].w = DN_ALPHA * bfhi(hv.y) + bfhi(oa.y) + bfhi(ob.y); }
        if (m + stride < M) LN2_LOAD(m + stride);
        float mean, rstd; ln_row_stats(v, mean, rstd);
        const int bb = m / T, t = m % T;
#pragma unroll
        for (int j = 0; j < 4; ++j) { const int c0 = 4 * lane + 256 * j; const f32x4 gg = *(const f32x4*)(g2 + c0), be = *(const f32x4*)(b2 + c0);
            const f32x4 y = (v[j] - mean) * rstd * gg + be;
            if (l == DEPTH - 1) { if (t >= NMETA) *(f32x4*)(a.out + ((size_t)bb * SEQ + (t - NMETA)) * D + c0) = y; }
            else *(uint2*)(HB + (size_t)m * D + c0) = make_uint2(pk2(y.x, y.y), pk2(y.z, y.w)); }
    }
}

#ifndef RWKV_CHUNKED
#define RWKV_CHUNKED 1
#endif
#ifndef MK_MULTI
#define MK_MULTI 0
#endif
__global__ void __launch_bounds__(NT, 2) hybrid_fwd(Args a_unused) {
    extern __shared__ __attribute__((aligned(16))) unsigned char lds_raw[];
    LAS unsigned char* lds = (LAS unsigned char*)lds_raw;
    volatile LAS unsigned* MISC = (volatile LAS unsigned*)(lds + MISC_OFF);
    const int tid = threadIdx.x;
    const int G = gridDim.x;
    for (int u = tid; u < 128; u += NT) MISC[u] = 0u;
    __syncthreads();
    int lo, hi; unsigned* ctl; { CArgs& a = *opaque_args(); lo = a.ph_lo; hi = a.ph_hi; ctl = (unsigned*)(a.ws + WS_CTL); }
    XcdBarrier bar; bar.bar = ctl + CW_BAR; bar.x = 0; bar.st = nullptr;
    if (hi - lo > 1) bar = xcd_barrier_post(ctl + CW_BAR, MISC + 0);
#ifndef PHMASK
#define PHMASK 0x1fff
#endif
#define EN(j) (((PHMASK) >> (j)) & 1)
#ifndef DUPMASK
#define DUPMASK 0
#endif
#define NREP(j) ((((DUPMASK) >> (j)) & 1) ? 2 : 1)
#ifndef DUPITEM
#define DUPITEM 0
#endif
#define IREP(k) for (int ir_ = 0; ir_ < (((DUPITEM) >> (k)) & 1 ? 2 : 1); ++ir_)
#define IN(k) (lo <= (k) && (k) < hi)
#define OPQ() CArgs& a = *opaque_args(); bf16* HB = (bf16*)(a.ws + WS_HB); unsigned char* wb = a.ws + WS_W; (void)HB; (void)wb; int tp = threadIdx.x; asm volatile("" : "+v"(tp)); const int lane = tp & 63, wave = __builtin_amdgcn_readfirstlane(tp >> 6), gw = blockIdx.x * NWAVES + wave, ngw = G * NWAVES; (void)lane; (void)gw; (void)ngw
#define SEAM(k) do { if (IN(k) && IN((k) + 1)) xcd_barrier(bar); } while (0)

    if (EN(0) && IN(0)) for (int rep = 0; rep < NREP(0); ++rep) { OPQ();
        convert_weights(a, 0, lds, gw, ngw, wave, lane);
        const float* gi = a.in[I_LNIN_G]; const float* bi = a.in[I_LNIN_B];
        f32x4 nv[4];
#define PRO_LOAD(mm) do { const int bb_ = (mm) / T, t_ = (mm) % T; const float* src_ = t_ < NMETA ? a.in[I_META] + (size_t)t_ * D : a.in[I_X] + ((size_t)bb_ * SEQ + (t_ - NMETA)) * D; \
            _Pragma("unroll") for (int j = 0; j < 4; ++j) nv[j] = *(const f32x4*)(src_ + 4 * lane + 256 * j); } while (0)
        if (gw < M) PRO_LOAD(gw);
        for (int m = gw; m < MP; m += ngw) {
            if (m >= M) { *(v4u*)(HB + (size_t)m * D + 8 * lane) = (v4u){0u, 0u, 0u, 0u}; *(v4u*)(HB + (size_t)m * D + 512 + 8 * lane) = (v4u){0u, 0u, 0u, 0u}; continue; }
            f32x4 v[4];
#pragma unroll
            for (int j = 0; j < 4; ++j) v[j] = nv[j];
            if (m + ngw < M) PRO_LOAD(m + ngw);
            float mean, rstd; ln_row_stats(v, mean, rstd);
#pragma unroll
            for (int j = 0; j < 4; ++j) { const int c0 = 4 * lane + 256 * j; const f32x4 gg = *(const f32x4*)(gi + c0), be = *(const f32x4*)(bi + c0);
                const f32x4 y = (v[j] - mean) * rstd * gg + be; *(uint2*)(HB + (size_t)m * D + c0) = make_uint2(pk2(y.x, y.y), pk2(y.z, y.w)); }
        }
        __syncthreads();
    }
    SEAM(0);

    for (int l = 0; l < DEPTH; ++l) {
        const int pb = 1 + 12 * l;
        if (EN(1) && IN(pb + 0)) for (int rep = 0; rep < NREP(1); ++rep) { OPQ();
            pg8::Gemm g{(const pg8::bf16_t*)HB, (const pg8::bf16_t*)(wb + W_IN), MP, PW, D}; pg8::StaticOrder S; S.init(TAIL0, PW, G, (int)blockIdx.x);
            pg8::EpiStoreBf16<0> E{(pg8::bf16_t*)(a.ws + WS_R + R_P), PW};
            pg8::gemm_phase<pg8::EpiStoreBf16<0>, pg8::StaticOrder, true, true>(lds, g, S, E);
            tail_inproj(a, gw, ngw, lane);
        }
        SEAM(pb + 0);
        if (EN(2) && IN(pb + 1)) for (int rep = 0; rep < NREP(2); ++rep) { OPQ();
            constexpr int N1 = NBH * NCH, NALL = 2 * N1 + M / 64;
#ifndef ABL
#define ABL 0
#endif
            if (ABL & (8 | 16 | 32 | 64)) { v4u* z = (v4u*)(a.ws + WS_Y); const size_t n16 = (size_t)4 * MP * 256 * 2 / 16; for (size_t i = (size_t)blockIdx.x * NT + tp; i < n16; i += (size_t)G * NT) z[i] = (v4u){0u, 0u, 0u, 0u}; }
            { GAS unsigned* mq = (GAS unsigned*)((unsigned*)(a.ws + WS_CTL) + CW_MIXQ + 64 * (4 * l + rep));
              asm volatile("" : "+v"(mq));
              volatile LAS int* MSLOT = (volatile LAS int*)(lds + MISC_OFF) + 44;
              int nx = 0; if (tp == 0) nx = (int)__hip_atomic_fetch_add(mq, 1u, __ATOMIC_RELAXED, __HIP_MEMORY_SCOPE_AGENT);
              for (int par = 0;; par ^= 1) {
                  if (tp == 0) { MSLOT[par] = nx; nx = (int)__hip_atomic_fetch_add(mq, 1u, __ATOMIC_RELAXED, __HIP_MEMORY_SCOPE_AGENT); }
                  __syncthreads();
                  const int it = MSLOT[par];
                  if (it >= NALL + N1) break;
                  if (it < N1) { if (RWKV_CHUNKED) IREP(3) rwkv_stage1(a, l, it, lds, tp); }
                  else if (it < N1 + M / 64) { if (!(ABL & 32)) IREP(2) dsa_stage1(a, l, it - N1, lds, tp); }
                  else if (it < 2 * N1 + M / 64) { if (!(ABL & 64)) IREP(1) ml_stage1(a, l, it - N1 - M / 64, lds, tp); }
                  else { if (!(ABL & 16)) IREP(0) gla_stage1(a, l, it - 2 * N1 - M / 64, lds, tp); }
              } }
        }
        SEAM(pb + 1);
        if (EN(3) && IN(pb + 2)) for (int rep = 0; rep < NREP(3); ++rep) { OPQ();
            constexpr int NS1 = NBH * 4, NS2 = NBH * 8, NQ = M / 4;
            if (blockIdx.x < NBH) { if (!(ABL & 8) && rep == 0) { if (RWKV_CHUNKED) rwkv_scan(a, blockIdx.x, lds, tp); else rwkv_chain(a, l, blockIdx.x, lds, tp); } }
            else { const int G2 = G - NBH, c2 = blockIdx.x - NBH;
                for (int it = c2; it < NS1 + NS2; it += G2) {
                    if (it < NS1) { if (!(ABL & 16) && rep == 0) gla_scan(a, it, tp); }
                    else { if (!(ABL & 64) && rep == 0) ml_scan(a, it - NS1, tp); } } }
            if (!(ABL & 32) && DSA_HALVES) {
                __syncthreads();
                dsa_half_init(a, lds, tp);
                dsa_half_loop(a, (unsigned*)(a.ws + WS_CTL) + CW_DSAQ + 64 * (2 * l + rep), lds, tp);
                __syncthreads();
            } else if (!(ABL & 32)) {
                __syncthreads();
                dsa_bias_table(a, lds, tp);
                GAS unsigned* qctr = (GAS unsigned*)((unsigned*)(a.ws + WS_CTL) + CW_DSAQ + 64 * (2 * l + rep));
                asm volatile("" : "+v"(qctr));
                volatile LAS int* SLOT = (volatile LAS int*)(lds + MISC_OFF) + 40;
                int nxt = 0;
                if (tp == 0) { const int k0 = (int)__hip_atomic_fetch_add(qctr, 1u, __ATOMIC_RELAXED, __HIP_MEMORY_SCOPE_AGENT), k1 = (int)__hip_atomic_fetch_add(qctr, 1u, __ATOMIC_RELAXED, __HIP_MEMORY_SCOPE_AGENT); SLOT[0] = k0; SLOT[1] = k1; }
                __syncthreads();
                if (__builtin_amdgcn_readfirstlane(tp) >= 256) __builtin_amdgcn_s_setprio(1);
                DsaPre pre;
                { const int k = SLOT[0]; const int kc = k < NQ ? k : NQ - 1; dsa_prefetch(a, (kc & 3) * (T / 4) + (T / 4 - 1 - (kc >> 2)), tp, pre); }
                for (;;) {
                    const int k = SLOT[0], kn = SLOT[1];
                    if (k >= NQ) break;
                    const int kc = kn < NQ ? kn : NQ - 1;
                    dsa_stage2(a, (k & 3) * (T / 4) + (T / 4 - 1 - (k >> 2)), (kc & 3) * (T / 4) + (T / 4 - 1 - (kc >> 2)), lds, tp, qctr, nxt, pre, SLOT, kn);
                }
                __builtin_amdgcn_s_setprio(0);
            }
        }
        SEAM(pb + 2);
        if (EN(4) && IN(pb + 3)) for (int rep = 0; rep < NREP(4); ++rep) { OPQ();
            constexpr int N1 = NBH * NCH;
            if (ABL & 128) { const bf16* P = (const bf16*)(a.ws + WS_R + R_P); bf16* Y = (bf16*)(a.ws + WS_Y);
                for (size_t i = (size_t)blockIdx.x * NT + tp; i < (size_t)M * 1024; i += (size_t)G * NT) { const size_t m = i >> 10; const int c = (int)(i & 1023); Y[(size_t)(c >> 8) * MP * 256 + m * 256 + (c & 255)] = P[m * PW + c]; } }
            { GAS unsigned* mq = (GAS unsigned*)((unsigned*)(a.ws + WS_CTL) + CW_MIXQ + 64 * (4 * l + 2 + rep));
              asm volatile("" : "+v"(mq));
              volatile LAS int* MSLOT = (volatile LAS int*)(lds + MISC_OFF) + 44;
              int nx = 0; if (tp == 0) nx = (int)__hip_atomic_fetch_add(mq, 1u, __ATOMIC_RELAXED, __HIP_MEMORY_SCOPE_AGENT);
              for (int par = 0;; par ^= 1) {
                  if (tp == 0) { MSLOT[par] = nx; nx = (int)__hip_atomic_fetch_add(mq, 1u, __ATOMIC_RELAXED, __HIP_MEMORY_SCOPE_AGENT); }
                  __syncthreads();
                  const int it = MSLOT[par];
                  if (it >= 3 * N1) break;
                  if (it < N1) { if (!(ABL & 64)) IREP(5) ml_stage2(a, l, it, lds, tp); }
                  else if (it < 2 * N1) { if (!(ABL & 16)) IREP(4) gla_stage2(a, l, it - N1, lds, tp); }
                  else IREP(6) rwkv_stage3(a, l, it - 2 * N1, lds, tp);
              } }
        }
        SEAM(pb + 3);
        if (EN(5) && IN(pb + 4)) for (int rep = 0; rep < NREP(5); ++rep) { OPQ();
            pg8::Gemm g{(const pg8::bf16_t*)HB, (const pg8::bf16_t*)(wb + W_G), MP, 4096, D}; pg8::StaticOrder S; S.init(TAIL0, 4096, G, (int)blockIdx.x);
            pg8::EpiStoreBf16<1> E{(pg8::bf16_t*)(a.ws + WS_R + R_G), 4096};
            pg8::gemm_phase<pg8::EpiStoreBf16<1>, pg8::StaticOrder, true, true>(lds, g, S, E);
            tail_gates(a, gw, ngw, lane);
        }
        SEAM(pb + 4);
        if (EN(6) && IN(pb + 5)) for (int rep = 0; rep < NREP(6); ++rep) { OPQ();
            pg8::Gemm g{(const pg8::bf16_t*)(a.ws + WS_Y), (const pg8::bf16_t*)(wb + W_B), 4 * MP, 4 * D, 256}; pg8::OrderMerge S{G, (int)blockIdx.x};
            pg8::EpiMerge E{(const pg8::bf16_t*)(a.ws + WS_R + R_G), (pg8::bf16_t*)(a.ws + WS_MG)};
            pg8::gemm_phase<pg8::EpiMerge, pg8::OrderMerge, true, true>(lds, g, S, E);
            tail_merge(a, gw, ngw, lane);
        }
        SEAM(pb + 5);
        if (EN(7) && IN(pb + 6)) for (int rep = 0; rep < NREP(7); ++rep) { OPQ();
            pg8::Gemm g{(const pg8::bf16_t*)(a.ws + WS_MG), (const pg8::bf16_t*)(wb + W_O), MP, D, D}; pg8::StaticOrder S; S.init(TAIL0, D, G, (int)blockIdx.x);
            pg8::EpiResid E{(const pg8::bf16_t*)HB, (pg8::bf16_t*)(a.ws + WS_R + R_X1), DN_ALPHA};
            pg8::gemm_phase<pg8::EpiResid, pg8::StaticOrder, true, true>(lds, g, S, E);
            tail_outproj(a, gw, ngw, lane);
        }
        SEAM(pb + 6);
        if (EN(8) && IN(pb + 7)) for (int rep = 0; rep < NREP(8); ++rep) { OPQ(); ln1_router_phase(a, l, lds, tp, G, l + 2 * rep); __syncthreads(); }
        SEAM(pb + 7);
        if (EN(9) && IN(pb + 8)) for (int rep = 0; rep < NREP(9); ++rep) { OPQ(); scatter_phase(a, l, lds, tp, G); __syncthreads(); }
        SEAM(pb + 8);
        if (EN(10) && IN(pb + 9)) for (int rep = 0; rep < NREP(10); ++rep) { OPQ();
            volatile LAS int* OFFS = (volatile LAS int*)(lds + MISC_OFF) + 16;
            expert_offsets(a, l, OFFS, tp);
            pg8::Gemm g{(const pg8::bf16_t*)(a.ws + WS_R + R_XG), (const pg8::bf16_t*)(wb + W_GU), XROWS, 16 * 512, D};
            pg8::OrderExpert S{G, (int)blockIdx.x, 2, (int)OFFS[16], (const LAS int*)(lds + MISC_OFF) + 16};
            pg8::EpiSwiglu E{(pg8::bf16_t*)(a.ws + WS_R + R_HID)};
            pg8::gemm_phase<pg8::EpiSwiglu, pg8::OrderExpert, true, true>(lds, g, S, E);
        }
        SEAM(pb + 9);
        if (EN(11) && IN(pb + 10)) for (int rep = 0; rep < NREP(11); ++rep) { OPQ();
            volatile LAS int* OFFS = (volatile LAS int*)(lds + MISC_OFF) + 16;
            expert_offsets(a, l, OFFS, tp);
            pg8::Gemm g{(const pg8::bf16_t*)(a.ws + WS_R + R_HID), (const pg8::bf16_t*)(wb + W_D), XROWS, 16 * D, 256};
            pg8::OrderExpert S{G, (int)blockIdx.x, 4, (int)OFFS[16], (const LAS int*)(lds + MISC_OFF) + 16};
            pg8::EpiDown E{(const int*)(a.ws + WS_MISC + MS_ROWTOK), (const float*)(a.ws + WS_MISC + MS_ROWW), (pg8::bf16_t*)(a.ws + WS_O2), (size_t)MP * D};
            pg8::gemm_phase<pg8::EpiDown, pg8::OrderExpert, true, true>(lds, g, S, E);
        }
        SEAM(pb + 10);
        if (EN(12) && IN(pb + 11)) { OPQ();
            ln2_phase(a, l, tp, G); if (NREP(12) == 2 && l == DEPTH - 1) ln2_phase(a, l, tp, G);
            if (l + 1 < DEPTH) convert_weights(a, l + 1, lds, gw, ngw, wave, lane);
            __syncthreads();
        }
        SEAM(pb + 11);
    }
#undef IN
#undef SEAM
}

__global__ void dump_kernel(const unsigned char* ws, float* out, int which) {
    const size_t i = (size_t)blockIdx.x * blockDim.x + threadIdx.x; if (i >= (size_t)BATCH * SEQ * D) return;
    const int c = (int)(i % D); const size_t r = i / D; const int b = (int)(r / SEQ), t = (int)(r % SEQ) + NMETA; const size_t m = (size_t)b * T + t;
    float v = 0.f;
    if (which == 1) v = bf2f(((const bf16*)(ws + WS_R + R_P))[m * PW + c]);
    else if (which == 2) v = bf2f(((const bf16*)(ws + WS_R + R_G))[m * 4096 + c]);
    else if (which == 8) v = m < 32768 ? bf2f(((const bf16*)(ws + WS_R + R_G))[m * 4096 + c]) : 0.f;
    else if (which == 9) v = m >= 32768 ? bf2f(((const bf16*)(ws + WS_R + R_G))[m * 4096 + c]) : 0.f;
    else if (which == 3) v = bf2f(((const bf16*)(ws + WS_MG))[m * D + c]);
    else if (which == 4) v = bf2f(((const bf16*)(ws + WS_R + R_X1))[m * D + c]);
    else if (which == 5) v = bf2f(((const bf16*)(ws + WS_HB))[m * D + c]);
    else if (which == 6) v = bf2f(((const bf16*)(ws + WS_Y))[(size_t)(c >> 8) * MP * 256 + m * 256 + (c & 255)]);
    else if (which == 7) v = bf2f(((const bf16*)(ws + WS_R + R_P))[m * PW + 2496 + c]);
#ifdef DUMP_RANGE
    v = (v > DUMP_HI || v < DUMP_LO || !(v == v)) ? (float)(DUMP_CODE) : 0.f;
#endif
    out[i] = v;
}
extern "C" void kernel_launch(void* const* d_in, const int* in_sizes, int n_in, void* d_out, int out_size, void* d_ws, size_t ws_size, hipStream_t stream) {
    static int grid = 0;
    if (grid == 0) {
        if (n_in != 41 || in_sizes[0] != BATCH * SEQ * D || out_size != BATCH * SEQ * D || ws_size < WS_END) {
            fprintf(stderr, "kernel_launch: unexpected shapes: n_in %d in0 %d out %d ws %zu (need %zu); nothing launched\n", n_in, n_in > 0 ? in_sizes[0] : -1, out_size, ws_size, (size_t)WS_END); grid = -1; return; }
        int dev = 0, cus = 0, per_cu = 0;
        if (hipGetDevice(&dev) != hipSuccess || hipDeviceGetAttribute(&cus, hipDeviceAttributeMultiprocessorCount, dev) != hipSuccess) { fprintf(stderr, "kernel_launch: device query failed\n"); grid = -1; return; }
        if (hipFuncSetAttribute((const void*)hybrid_fwd, hipFuncAttributeMaxDynamicSharedMemorySize, LDS_BYTES) != hipSuccess) { fprintf(stderr, "kernel_launch: hipFuncSetAttribute failed\n"); grid = -1; return; }
        if (hipOccupancyMaxActiveBlocksPerMultiprocessor(&per_cu, (const void*)hybrid_fwd, NT, LDS_BYTES) != hipSuccess || per_cu < 1)
            fprintf(stderr, "kernel_launch: note: occupancy query reports %d workgroups per CU\n", per_cu);
        (void)hipGetLastError();
        grid = cus;
        if (grid < 208) { fprintf(stderr, "kernel_launch: needs >= 208 CUs, got %d\n", grid); grid = -1; return; }
    }
    if (grid < 0) return;
#ifdef WSFILL_LO
    (void)hipMemsetAsync((char*)d_ws + (size_t)(WSFILL_LO) * MiB, 0x55, (size_t)((WSFILL_HI) - (WSFILL_LO)) * MiB, stream);
#endif
    if (hipMemsetAsync((char*)d_ws + WS_CTL, 0, CTL_ZERO_BYTES, stream) != hipSuccess) { fprintf(stderr, "kernel_launch: memset failed\n"); return; }
    Args a{};
    for (int i = 0; i < 41; ++i) a.in[i] = (const float*)d_in[i];
    a.out = (float*)d_out; a.ws = (unsigned char*)d_ws;
#if MK_MULTI
#ifdef DUMP_WHICH
#ifndef DUMP_SKIP_LO
#define DUMP_SKIP_LO 1000
#define DUMP_SKIP_HI 1000
#endif
    for (int p = 0; p < DUMP_NPH; ++p) { if (p >= DUMP_SKIP_LO && p < DUMP_SKIP_HI) continue; a.ph_lo = p; a.ph_hi = p + 1; hipLaunchKernelGGL(hybrid_fwd, dim3(grid), dim3(NT), LDS_BYTES, stream, a); }
    hipLaunchKernelGGL(dump_kernel, dim3((BATCH * SEQ * D + 255) / 256), dim3(256), 0, stream, (const unsigned char*)d_ws, (float*)d_out, DUMP_WHICH);
#else
    for (int p = 0; p < NPHASE; ++p) { a.ph_lo = p; a.ph_hi = p + 1; hipLaunchKernelGGL(hybrid_fwd, dim3(grid), dim3(NT), LDS_BYTES, stream, a); }
#endif
#else
    a.ph_lo = 0; a.ph_hi = NPHASE;
    hipLaunchKernelGGL(hybrid_fwd, dim3(grid), dim3(NT), LDS_BYTES, stream, a);
#endif
    const hipError_t le = hipPeekAtLastError();
    if (le != hipSuccess) fprintf(stderr, "kernel_launch: launch failed: %s\n", hipGetErrorName(le));
}
```

```cpp
#include <hip/hip_runtime.h>
#include <cstdio>
#include <cstdint>
namespace pg8 {
#define PG8_LAS __attribute__((address_space(3)))
typedef unsigned short bf16_t;
typedef short bf16x8 __attribute__((ext_vector_type(8)));
typedef float f32x4 __attribute__((ext_vector_type(4)));
typedef unsigned u32x4 __attribute__((ext_vector_type(4)));
constexpr int BM = 256, BK = 64, HALF = 128, HTB = HALF * BK * 2  , STAGE_BYTES = 8 * HTB, NXCD = 8, WGM = 8;

__host__ __device__ __forceinline__ int lds_byte(int r, int c) { const int st = (r >> 4) * 2 + (c >> 5), rr = r & 15, cc = c & 31, ob = rr * 64 + cc * 2; return st * 1024 + (ob ^ (((ob >> 9) & 1) << 5)); }
__host__ __device__ __forceinline__ void stage_rc(int b, int& R, int& C) { const int st = b / 1024, sb = b % 1024, swz = sb ^ (((sb >> 9) & 1) << 5); R = (st >> 1) * 16 + swz / 64; C = (st & 1) * 32 + (swz % 64) / 2; }
__host__ __device__ __forceinline__ int perm32(int rho) { const int n = rho >> 4, i = rho & 15; return 8 * (i >> 2) + 4 * n + (i & 3); }

__host__ __device__ __forceinline__ int inv_perm32(int p) { return 16 * ((p >> 2) & 1) + 4 * (p >> 3) + (p & 3); }
__host__ __device__ __forceinline__ size_t wimg_off(int w, int k, int K) {
    const int r = w & 127, R = (r & ~31) + inv_perm32(r & 31);
    return ((size_t)((w >> 8) * (K / BK) + (k >> 6)) * 2 + ((w >> 7) & 1)) * HTB + lds_byte(R, k & 63);
}
__host__ __device__ __forceinline__ size_t aimg_off(int m, int k, int K) { return ((size_t)((m >> 8) * (K / BK) + (k >> 6)) * 2 + ((m >> 7) & 1)) * HTB + lds_byte(m & 127, k & 63); }
struct Unit { int pm, pn, x0, x1, rb, nv; };
struct Gemm { const bf16_t* A; const bf16_t* Bt; int M, N, K; const int* rowmap = nullptr; };

struct StaticOrder {
    int nM, nN, nwg, G, c;
    __host__ __device__ void init(int M, int N, int G_, int c_) { nM = M / BM; nN = N / BM; nwg = nM * nN; G = G_; c = c_; }
    __host__ __device__ bool next(int i, Unit& u) const {
        const long L = (long)i * G + c; if (L >= nwg) return false;
        int wgid = (int)L; { const int q = nwg / NXCD, r = nwg % NXCD, xcd = wgid % NXCD, off = wgid / NXCD; wgid = (xcd < r ? xcd * (q + 1) : r * (q + 1) + (xcd - r) * q) + off; }
        const int nig = WGM * nN, gid = wgid / nig, fm = gid * WGM, gsz = (nM - fm) < WGM ? (nM - fm) : WGM;
        u.pm = fm + ((wgid % nig) % gsz); u.pn = (wgid % nig) / gsz; return true;
    }
    __device__ __forceinline__ void a_ready(const Unit&) const {}
    __device__ __forceinline__ void done(const Unit&) const {}
};

typedef float f32x2c_t __attribute__((ext_vector_type(2))); typedef __bf16 bf16x2c_t __attribute__((ext_vector_type(2)));
__device__ __forceinline__ unsigned cvt_pk_bf16(float lo, float hi) { const f32x2c_t v = {lo, hi}; const bf16x2c_t b = __builtin_convertvector(v, bf16x2c_t); return __builtin_bit_cast(unsigned, b); }
typedef float f32x2 __attribute__((ext_vector_type(2)));
template <class Epi, class Sched, bool ALIGN_EPI = false, bool SP2 = false, bool GATHER = false, bool A_IMG = false>
__device__ __forceinline__ void gemm_phase(PG8_LAS unsigned char* lds, const Gemm g, const Sched& S, const Epi& E) {
    int tid_o = threadIdx.x; asm volatile("" : "+v"(tid_o));
    const int tid = tid_o, wid = __builtin_amdgcn_readfirstlane(tid >> 6), lane = tid & 63, wr = wid >> 2, wc = wid & 3, fr = lane & 15, fq = lane >> 4;
    const int K = g.K, nt = K / BK;
    unsigned voffA[2], voffB[2];
#pragma unroll
    for (int i = 0; i < 2; ++i) { int R, C; stage_rc(tid * 16 + i * 8192, R, C); const int Rb = Epi::PERM ? ((R & ~31) + perm32(R & 31)) : R;
        voffA[i] = A_IMG ? (unsigned)(tid * 16 + i * 8192) : (unsigned)(R * K + C) * 2u; voffB[i] = (unsigned)(tid * 16 + i * 8192); (void)Rb; }
    unsigned gA[2][2] = {{0u, 0u}, {0u, 0u}}, gN[2][2] = {{0u, 0u}, {0u, 0u}};
#define PG8_GOFF(dst, u) do { _Pragma("unroll") for (int _h = 0; _h < 2; ++_h) _Pragma("unroll") for (int _i = 0; _i < 2; ++_i) { int R_, C_; stage_rc(tid * 16 + _i * 8192, R_, C_); \
        int tk_ = 0; if (_h * HALF + R_ < (u).nv) tk_ = g.rowmap[(u).rb + _h * HALF + R_] >> 1; dst[_h][_i] = (unsigned)(tk_ * K + C_) * 2u; } } while (0)
    const size_t kstep = (size_t)(BK * 2);
    const size_t hstep = (size_t)HALF * K * 2;
    const size_t tstep = 2 * hstep;
    const size_t kstepB = (size_t)(2 * HTB), hstepB = (size_t)HTB, tstepB = (size_t)nt * (2 * HTB);
    const size_t kstepA = A_IMG ? (size_t)(2 * HTB) : kstep, hstepA = A_IMG ? (size_t)HTB : hstep, tstepA = A_IMG ? (size_t)nt * (2 * HTB) : tstep;
    const unsigned ldsw = (unsigned)wid * 1024u;
    const int aoff = lds_byte(wr * 64 + fr, fq * 8), boff = lds_byte(wc * 32 + fr, fq * 8);
#define PG8_SA(b, h) (((b) * 2 + (h)) * HTB)
#define PG8_SB(b, h) ((4 + (b) * 2 + (h)) * HTB)
#define PG8_STAGE(bufoff, gbase, voff) do { _Pragma("unroll") for (int _i = 0; _i < 2; ++_i) \
        __builtin_amdgcn_global_load_lds((const unsigned*)((const char*)(gbase) + (voff)[_i]), (PG8_LAS unsigned*)(lds + (bufoff) + ldsw + _i * 8192), 16, 0, 0); } while (0)
#define PG8_STAGE_A(bufoff, gbase, h, nx) do { if constexpr (GATHER) { const unsigned v_[2] = {(nx) ? gN[h][0] : gA[h][0], (nx) ? gN[h][1] : gA[h][1]}; PG8_STAGE(bufoff, gbase, v_); } \
        else PG8_STAGE(bufoff, (gbase) + (h) * hstepA, voffA); } while (0)
#define PG8_LDA(dst, b, h) do { _Pragma("unroll") for (int m = 0; m < 4; ++m) _Pragma("unroll") for (int k = 0; k < 2; ++k) dst[m][k] = *(const PG8_LAS bf16x8*)(lds + PG8_SA(b, h) + aoff + m * 2048 + k * 1024); } while (0)
#define PG8_LDB(dst, b, h) do { _Pragma("unroll") for (int n = 0; n < 2; ++n) _Pragma("unroll") for (int k = 0; k < 2; ++k) dst[n][k] = *(const PG8_LAS bf16x8*)(lds + PG8_SB(b, h) + boff + n * 2048 + k * 1024); } while (0)
#define PG8_MMA(ai, bj, At, Bt) do { __builtin_amdgcn_s_setprio(1); _Pragma("unroll") for (int m = 0; m < 4; ++m) _Pragma("unroll") for (int n = 0; n < 2; ++n) _Pragma("unroll") for (int k = 0; k < 2; ++k) \
        acc[ai][bj][m][n] = __builtin_amdgcn_mfma_f32_16x16x32_bf16(Bt[n][k], At[m][k], acc[ai][bj][m][n], 0, 0, 0); __builtin_amdgcn_s_setprio(0); } while (0)
#define PG8_WAIT_V(n) asm volatile("s_waitcnt vmcnt(" #n ")" ::: "memory")
#define PG8_WAIT_L(n) asm volatile("s_waitcnt lgkmcnt(" #n ")" ::: "memory")
#define PG8_BAR __builtin_amdgcn_s_barrier()
#define PG8_SCHED __builtin_amdgcn_sched_barrier(0)
    Unit cur, nxt; int ui = 0;
    if (!S.next(0, cur)) return;
    f32x4 acc[2][2][4][2];
#pragma unroll
    for (int a = 0; a < 2; ++a)
#pragma unroll
        for (int b = 0; b < 2; ++b)
#pragma unroll
            for (int m = 0; m < 4; ++m)
#pragma unroll
                for (int n = 0; n < 2; ++n) acc[a][b][m][n] = (f32x4){0.f, 0.f, 0.f, 0.f};
    bf16x8 At[4][2], B0[2][2], B1[2][2];
    const char* cA = GATHER ? (const char*)g.A : (const char*)g.A + (size_t)cur.pm * tstepA; const char* cB = (const char*)g.Bt + (size_t)cur.pn * tstepB;
    S.a_ready(cur);
    if constexpr (GATHER) PG8_GOFF(gA, cur);
    if constexpr (SP2) {
        PG8_STAGE(PG8_SB(0, 0), cB, voffB); PG8_STAGE(PG8_SB(0, 1), cB + hstepB, voffB); PG8_STAGE_A(PG8_SA(0, 0), cA, 0, false); PG8_STAGE_A(PG8_SA(0, 1), cA, 1, false);
        if (wr == 1) PG8_BAR;
        PG8_WAIT_V(2); PG8_BAR;
        PG8_STAGE(PG8_SB(1, 0), cB + kstepB, voffB); PG8_STAGE_A(PG8_SA(1, 0), cA + kstepA, 0, false); PG8_STAGE(PG8_SB(1, 1), cB + hstepB + kstepB, voffB);
        PG8_WAIT_V(6); PG8_BAR;
    } else {
        PG8_STAGE(PG8_SB(0, 0), cB, voffB); PG8_STAGE_A(PG8_SA(0, 0), cA, 0, false); PG8_STAGE(PG8_SB(0, 1), cB + hstepB, voffB); PG8_STAGE_A(PG8_SA(0, 1), cA, 1, false);
        if (wr == 1) PG8_BAR;
        PG8_WAIT_V(4); PG8_BAR;
        PG8_STAGE(PG8_SB(1, 0), cB + kstepB, voffB); PG8_STAGE_A(PG8_SA(1, 0), cA + kstepA, 0, false); PG8_STAGE(PG8_SB(1, 1), cB + hstepB + kstepB, voffB);
        PG8_WAIT_V(6); PG8_BAR;
    }
    for (;;) {
        const bool has_next = S.next(ui + 1, nxt);
        const char* nA = GATHER ? cA : has_next ? (const char*)g.A + (size_t)nxt.pm * tstepA : cA; const char* nB = has_next ? (const char*)g.Bt + (size_t)nxt.pn * tstepB : cB;
        if constexpr (GATHER) { if (has_next) PG8_GOFF(gN, nxt); else { gN[0][0] = gA[0][0]; gN[0][1] = gA[0][1]; gN[1][0] = gA[1][0]; gN[1][1] = gA[1][1]; } }
#pragma unroll 1
        for (int t = 0; t < nt; t += 2) {
            const bool last = (t == nt - 2);
            const char* a1 = cA + (size_t)(t + 1) * kstepA;
            const char* a2 = last ? nA : cA + (size_t)(t + 2) * kstepA; const char* b2 = last ? nB : cB + (size_t)(t + 2) * kstepB;
            const char* a3 = a2 + kstepA; const char* b3 = b2 + kstepB;
            if (last && has_next) S.a_ready(nxt);
            if constexpr (SP2) {
            PG8_LDB(B0, 0, 0); PG8_LDB(B1, 0, 1); PG8_SCHED; PG8_LDA(At, 0, 0); PG8_STAGE_A(PG8_SA(1, 1), a1, 1, false);
            PG8_WAIT_V(8); PG8_WAIT_L(0); PG8_BAR; PG8_MMA(0, 0, At, B0); PG8_MMA(0, 1, At, B1); PG8_BAR; PG8_SCHED;
            PG8_LDA(At, 0, 1); PG8_STAGE(PG8_SB(0, 0), b2, voffB); PG8_STAGE(PG8_SB(0, 1), b2 + hstepB, voffB); PG8_STAGE_A(PG8_SA(0, 0), a2, 0, last);
            PG8_WAIT_V(8); PG8_WAIT_L(0); PG8_BAR; PG8_MMA(1, 0, At, B0); PG8_MMA(1, 1, At, B1); PG8_BAR; PG8_SCHED;
            PG8_LDB(B0, 1, 0); PG8_LDB(B1, 1, 1); PG8_SCHED; PG8_LDA(At, 1, 0); PG8_STAGE_A(PG8_SA(0, 1), a2, 1, last);
            PG8_WAIT_V(8); PG8_WAIT_L(0); PG8_BAR; PG8_MMA(0, 0, At, B0); PG8_MMA(0, 1, At, B1); PG8_BAR; PG8_SCHED;
            PG8_LDA(At, 1, 1); PG8_STAGE(PG8_SB(1, 0), b3, voffB); PG8_STAGE(PG8_SB(1, 1), b3 + hstepB, voffB); PG8_STAGE_A(PG8_SA(1, 0), a3, 0, last);
            PG8_WAIT_V(8); PG8_WAIT_L(0); PG8_BAR; PG8_MMA(1, 0, At, B0); PG8_MMA(1, 1, At, B1); PG8_BAR; PG8_SCHED;
            } else {
            PG8_LDB(B0, 0, 0); PG8_SCHED; PG8_LDA(At, 0, 0); PG8_STAGE_A(PG8_SA(1, 1), a1, 1, false);
            PG8_WAIT_L(8); PG8_BAR; PG8_WAIT_L(0); PG8_MMA(0, 0, At, B0); PG8_BAR; PG8_SCHED;
            PG8_LDB(B1, 0, 1); PG8_STAGE(PG8_SB(0, 0), b2, voffB);
            PG8_BAR; PG8_WAIT_L(0); PG8_MMA(0, 1, At, B1); PG8_BAR;
            PG8_LDA(At, 0, 1); PG8_STAGE_A(PG8_SA(0, 0), a2, 0, last);
            PG8_BAR; PG8_WAIT_L(0); PG8_MMA(1, 0, At, B0); PG8_BAR; PG8_SCHED;
            PG8_STAGE(PG8_SB(0, 1), b2 + hstepB, voffB);
            PG8_WAIT_V(6); PG8_BAR; PG8_MMA(1, 1, At, B1); PG8_BAR;
            PG8_LDB(B0, 1, 0); PG8_SCHED; PG8_LDA(At, 1, 0); PG8_STAGE_A(PG8_SA(0, 1), a2, 1, last);
            PG8_WAIT_L(8); PG8_BAR; PG8_WAIT_L(0); PG8_MMA(0, 0, At, B0); PG8_BAR; PG8_SCHED;
            PG8_LDB(B1, 1, 1); PG8_STAGE(PG8_SB(1, 0), b3, voffB);
            PG8_BAR; PG8_WAIT_L(0); PG8_MMA(0, 1, At, B1); PG8_BAR;
            PG8_LDA(At, 1, 1); PG8_STAGE_A(PG8_SA(1, 0), a3, 0, last);
            PG8_BAR; PG8_WAIT_L(0); PG8_MMA(1, 0, At, B0); PG8_BAR; PG8_SCHED;
            PG8_STAGE(PG8_SB(1, 1), b3 + hstepB, voffB);
            PG8_WAIT_V(6); PG8_BAR; PG8_MMA(1, 1, At, B1); PG8_BAR;
            }
        }
        if constexpr (ALIGN_EPI) { if (wr == 0) PG8_BAR; }
        if constexpr (!Epi::AFTER_DRAIN) { E(acc, cur, wr, wc, fr, fq); S.done(cur); }
        if (!has_next) break;
#pragma unroll
        for (int a = 0; a < 2; ++a)
#pragma unroll
            for (int b = 0; b < 2; ++b)
#pragma unroll
                for (int m = 0; m < 4; ++m)
#pragma unroll
                    for (int n = 0; n < 2; ++n) acc[a][b][m][n] = (f32x4){0.f, 0.f, 0.f, 0.f};
        cur = nxt; cA = nA; cB = nB; ++ui;
        if constexpr (GATHER) { gA[0][0] = gN[0][0]; gA[0][1] = gN[0][1]; gA[1][0] = gN[1][0]; gA[1][1] = gN[1][1]; }
        if constexpr (ALIGN_EPI) { if (wr == 1) PG8_BAR; }
    }
    PG8_WAIT_V(0);
    if constexpr (!ALIGN_EPI) { if (wr == 0) PG8_BAR; }
    PG8_BAR;
    if constexpr (Epi::AFTER_DRAIN) { E.fused(acc, cur, wr, wc, fr, fq, lds, wid, lane); S.done(cur); }
#undef PG8_SA
#undef PG8_SB
#undef PG8_STAGE
#undef PG8_STAGE_A
#undef PG8_GOFF
#undef PG8_LDA
#undef PG8_LDB
#undef PG8_MMA
#undef PG8_WAIT_V
#undef PG8_WAIT_L
#undef PG8_BAR
#undef PG8_SCHED
}
}

#ifndef RWKV_CACHE
#define RWKV_CACHE 1
#endif
#ifndef DSA_DUP
#define DSA_DUP 0
#endif
#ifndef DSA_HALVES
#define DSA_HALVES 0
#endif
constexpr int BATCH = 4, SEQ = 8192, NMETA = 16, T = SEQ + NMETA, M = BATCH * T, MP = 33024, D = 1024, DEPTH = 2;
constexpr int NCH = 129, PADT = 48;
constexpr int PW = 3584, IN_COLS = 7616;
constexpr int C_RW = 0, C_GLA = 1024, C_DSA = 1808, C_ML = 2488, C_MIXEND = 3520;
constexpr int NBH = 16;
constexpr int XCAP = 33024;
constexpr int XROWS = 69888;
constexpr float DN_ALPHA = 1.41421356237f;
static_assert(MP % 256 == 0 && MP >= M && XROWS % 256 == 0 && XROWS >= 2 * M + 16 * 255, "shapes");

constexpr size_t MiB = 1u << 20;
constexpr size_t WS_CTL = 0, CTL_ZERO_BYTES = 128 * 1024;
constexpr size_t WS_W = 1 * MiB;
constexpr size_t W_IN = 0, W_G = W_IN + (size_t)PW * D * 2, W_B = W_G + (size_t)4096 * D * 2, W_O = W_B + (size_t)4 * D * 256 * 2,
                 W_GU = W_O + (size_t)D * D * 2, W_D = W_GU + (size_t)16 * 512 * D * 2, W_END = W_D + (size_t)16 * D * 256 * 2;
static_assert(W_END <= 44 * MiB, "weights");
constexpr size_t WS_HB = 45 * MiB;
constexpr size_t WS_R = 110 * MiB;
constexpr size_t R_P = 0;
constexpr size_t R_G = 100 * MiB;
constexpr size_t R_X1 = 0;
constexpr size_t R_XG = 0;
constexpr size_t R_MGP = 0;
constexpr size_t R_RT2 = 72 * MiB, R_RW2 = 76 * MiB;
constexpr size_t R_HID = 137 * MiB;
constexpr size_t R_BYTES = 258 * MiB;
static_assert(R_G + (size_t)MP * 4096 <= R_BYTES && R_G + (size_t)32768 * 4096 >= (size_t)MP * PW * 2 && (size_t)XROWS * D * 2 <= R_HID && R_HID + (size_t)XROWS * 256 * 2 <= R_BYTES, "R");
constexpr size_t WS_Y = 368 * MiB;
constexpr size_t WS_MG = WS_Y + (size_t)4 * MP * 256 * 2;
constexpr size_t WS_O2 = WS_Y;
constexpr size_t WS_MISC = WS_MG + (size_t)MP * D * 2;
constexpr size_t WS_END = WS_MISC + 4 * MiB;
static_assert(WS_R + R_BYTES <= WS_Y && WS_END <= 512 * MiB, "d_ws map");
constexpr size_t MI_GU = 0;
constexpr size_t MI_GDEC = MI_GU + (size_t)NBH * NCH * 2048 * 4;
constexpr size_t MI_MC = MI_GDEC + (size_t)NBH * NCH * 32 * 4;
constexpr size_t MI_MN = MI_MC + (size_t)NBH * NCH * 4096 * 4;
constexpr size_t MI_ML = MI_MN + (size_t)NBH * NCH * 64 * 4;
constexpr size_t MI_BL = MI_ML + (size_t)NBH * NCH * 4;
constexpr size_t MI_MIN = MI_BL + (size_t)NBH * NCH * 4;
constexpr size_t MI_K = (MI_MIN + (size_t)NBH * NCH * 4 + 255) / 256 * 256;
constexpr size_t MI_V = MI_K + (size_t)MP * 64 * 2;
constexpr size_t MI_KI = MI_V + (size_t)MP * 64 * 2;
constexpr size_t MI_END = MI_KI + (size_t)MP * 32 * 2;
static_assert(MI_END <= (size_t)MP * D * 2, "mixer intermediates fit the MG region");
constexpr size_t MS_ROUTE = 0;
constexpr size_t MS_RW = MS_ROUTE + (size_t)M * 16;
constexpr size_t MS_ROWTOK = MS_RW + (size_t)M * 8;
constexpr size_t MS_ROWW = MS_ROWTOK + (size_t)XROWS * 4;
static_assert(MS_ROWW + (size_t)XROWS * 4 <= 4 * MiB, "misc");
constexpr int CW_BAR = 4096;
constexpr int CW_DSAQ = 20480;
constexpr int CW_MIXQ = 24576;
constexpr int CW_DSAQ4 = 28672;
constexpr int CW_ECNT = 16384;

constexpr int LDS_BYTES = 163840, MISC_OFF = LDS_BYTES - 512;
constexpr int NWAVES = 8, NT = 512;
constexpr int NPHASE = 1 + 12 * DEPTH;

#define GAS __attribute__((address_space(1)))
#define LAS __attribute__((address_space(3)))
typedef unsigned short bf16;
typedef unsigned v4u __attribute__((ext_vector_type(4)));
typedef unsigned v2u __attribute__((ext_vector_type(2)));
typedef float f32x4 __attribute__((ext_vector_type(4)));
typedef float f32x2 __attribute__((ext_vector_type(2)));
typedef float f32x16 __attribute__((ext_vector_type(16)));
typedef short bf16x8 __attribute__((ext_vector_type(8)));
#define LDS_WAIT() asm volatile("s_waitcnt lgkmcnt(0)" ::: "memory")
#define VM_WAIT() asm volatile("s_waitcnt vmcnt(0)" ::: "memory")
__device__ __forceinline__ unsigned f2bf(float f) { unsigned u = __builtin_bit_cast(unsigned, f); return (u + 0x7fffu + ((u >> 16) & 1u)) >> 16; }
__device__ __forceinline__ unsigned pk2(float lo, float hi) { return f2bf(lo) | (f2bf(hi) << 16); }
__device__ __forceinline__ float bf2f(bf16 v) { return __builtin_bit_cast(float, (unsigned)v << 16); }
__device__ __forceinline__ float bflo(unsigned w) { return __builtin_bit_cast(float, w << 16); }
__device__ __forceinline__ float bfhi(unsigned w) { return __builtin_bit_cast(float, w & 0xffff0000u); }
__device__ __forceinline__ float sigmoidf_(float x) { return __builtin_amdgcn_rcpf(1.0f + __expf(-x)); }
__device__ __forceinline__ float logsigf_(float x) { return fminf(x, 0.f) - __logf(1.0f + __expf(-fabsf(x))); }
__device__ __forceinline__ float siluf_(float x) { return x * __builtin_amdgcn_rcpf(1.0f + __expf(-x)); }
__device__ __forceinline__ float wave_sum(float v) {
#pragma unroll
    for (int o = 1; o < 64; o <<= 1) v += __shfl_xor(v, o);
    return v;
}
__device__ __forceinline__ float wave_max(float v) {
#pragma unroll
    for (int o = 1; o < 64; o <<= 1) v = fmaxf(v, __shfl_xor(v, o));
    return v;
}
template <int CTRL> __device__ __forceinline__ float dppf(float x) {
    return __builtin_bit_cast(float, __builtin_amdgcn_update_dpp(0, __builtin_bit_cast(int, x), CTRL, 0xF, 0xF, true));
}
__device__ __forceinline__ float sum8(float v) { v += dppf<0xB1>(v); v += dppf<0x4E>(v); v += dppf<0x141>(v); return v; }
__device__ __forceinline__ float wave_sum_fast(float v) {
    v += dppf<0xB1>(v); v += dppf<0x4E>(v); v += dppf<0x141>(v); v += dppf<0x140>(v);
    const int iv = __builtin_bit_cast(int, v);
    float r = (__builtin_bit_cast(float, __builtin_amdgcn_readlane(iv, 0)) + __builtin_bit_cast(float, __builtin_amdgcn_readlane(iv, 16))) +
              (__builtin_bit_cast(float, __builtin_amdgcn_readlane(iv, 32)) + __builtin_bit_cast(float, __builtin_amdgcn_readlane(iv, 48)));
    asm volatile("" : "+v"(r));
    return r;
}
__device__ __forceinline__ float max8(float v) { v = fmaxf(v, dppf<0xB1>(v)); v = fmaxf(v, dppf<0x4E>(v)); v = fmaxf(v, dppf<0x141>(v)); return v; }

struct Args { const float* in[41]; float* out; unsigned char* ws; int ph_lo, ph_hi; };
typedef const __attribute__((address_space(4))) Args CArgs;
__device__ __forceinline__ CArgs* opaque_args() { CArgs* p = (CArgs*)__builtin_amdgcn_kernarg_segment_ptr(); asm volatile("" : "+s"(p)); return p; }
enum { I_X = 0, I_META, I_LNIN_G, I_LNIN_B, I_RELB, I_WIN, I_RW_MU, I_RW_WUP, I_RW_W0, I_RW_AUP, I_RW_A0, I_RW_GUP, I_RW_KK, I_RW_KA, I_RW_RK, I_RW_GNG, I_RW_GNB,
       I_GLA_AUP, I_GLA_AB, I_GLA_NG, I_DSA_NG, I_DSA_WUK, I_DSA_WUV, I_ML_CW, I_ML_CB, I_ML_IB, I_ML_FB, I_ML_NG, I_WBR, I_WOUT, I_LN1G, I_LN1B,
       I_MOE_WGRP, I_MOE_BGRP, I_MOE_WRT, I_MOE_BRT, I_MOE_WG, I_MOE_WU, I_MOE_WD, I_LN2G, I_LN2B };

__device__ __forceinline__ void transpose_item(const float* W, int ld, bf16* WT, int K, int k0, int n0, int drow0, LAS float* scr, int lane) {
    { f32x4 t[8];
#pragma unroll
      for (int i = 0; i < 8; ++i) t[i] = *(const GAS f32x4*)(W + (size_t)(k0 + 8 * i + (lane >> 3)) * ld + n0 + 4 * (lane & 7));
#pragma unroll
      for (int i = 0; i < 8; ++i) { LAS float* d = scr + (8 * i + (lane >> 3)) * 33 + 4 * (lane & 7); d[0] = t[i].x; d[1] = t[i].y; d[2] = t[i].z; d[3] = t[i].w; } }
    LDS_WAIT(); asm volatile("" ::: "memory");
    const int c = lane & 7;
#pragma unroll
    for (int j = 0; j < 4; ++j) { const int n = (lane >> 3) + 8 * j; const LAS float* s = scr + (8 * c) * 33 + n;
        v4u o; o.x = pk2(s[0 * 33], s[1 * 33]); o.y = pk2(s[2 * 33], s[3 * 33]); o.z = pk2(s[4 * 33], s[5 * 33]); o.w = pk2(s[6 * 33], s[7 * 33]);
        *(v4u*)((unsigned char*)WT + pg8::wimg_off(drow0 + n, k0 + 8 * c, K)) = o; }
    LDS_WAIT(); asm volatile("" ::: "memory");
}
constexpr int WI_1 = 16 * 110, WI_2 = 16 * 128, WI_3 = 4 * 128, WI_4 = 16 * 32, WI_5 = 16 * 256, WI_6 = 16 * 128, WI_ALL = WI_1 + WI_2 + WI_3 + WI_4 + WI_5 + WI_6;
__device__ __noinline__ void convert_weights(CArgs& a, int l, LAS unsigned char* lds, int gw, int ngw, int wave, int lane) {
    LAS float* scr = (LAS float*)(lds + wave * 16384);
    unsigned char* wb = a.ws + WS_W;
    const float* w_in = a.in[I_WIN] + (size_t)l * D * IN_COLS;
    const float* w_br = a.in[I_WBR] + (size_t)l * 4 * 256 * D;
    const float* w_out = a.in[I_WOUT] + (size_t)l * D * D;
    const float* w_g = a.in[I_MOE_WG] + (size_t)l * 16 * D * 256;
    const float* w_u = a.in[I_MOE_WU] + (size_t)l * 16 * D * 256;
    const float* w_d = a.in[I_MOE_WD] + (size_t)l * 16 * 256 * D;
    for (int it0 = gw; it0 < WI_ALL; it0 += ngw) {
        int it = it0;
        if (it < WI_1) { const int kb = it / 110, nb = it % 110; transpose_item(w_in, IN_COLS, (bf16*)(wb + W_IN), D, 64 * kb, 32 * nb, 32 * nb, scr, lane); continue; } it -= WI_1;
        if (it < WI_2) { const int kb = it / 128, nb = it % 128; transpose_item(w_in, IN_COLS, (bf16*)(wb + W_G), D, 64 * kb, C_MIXEND + 32 * nb, 32 * nb, scr, lane); continue; } it -= WI_2;
        if (it < WI_3) { const int i = it / 128, r = it % 128, kb = r / 32, nb = r % 32; transpose_item(w_br + (size_t)i * 256 * D, D, (bf16*)(wb + W_B) + (size_t)i * D * 256, 256, 64 * kb, 32 * nb, 32 * nb, scr, lane); continue; } it -= WI_3;
        if (it < WI_4) { const int kb = it / 32, nb = it % 32; transpose_item(w_out, D, (bf16*)(wb + W_O), D, 64 * kb, 32 * nb, 32 * nb, scr, lane); continue; } it -= WI_4;
        if (it < WI_5) { const int e = it / 256, r = it % 256, w = r / 128, r2 = r % 128, kb = r2 / 8, nb = r2 % 8;
            transpose_item((w ? w_u : w_g) + (size_t)e * D * 256, 256, (bf16*)(wb + W_GU), D, 64 * kb, 32 * nb, e * 512 + (nb / 4) * 256 + w * 128 + (nb % 4) * 32, scr, lane); continue; } it -= WI_5;
        { const int e = it / 128, r = it % 128, kb = r / 32, nb = r % 32; transpose_item(w_d + (size_t)e * 256 * D, D, (bf16*)(wb + W_D) + (size_t)e * D * 256, 256, 64 * kb, 32 * nb, 32 * nb, scr, lane); }
    }
    { static_assert(C_MIXEND == 3520 && PW == 3584, "pad rows");
      for (int i = gw * 64 + lane; i < 16 * 512; i += ngw * 64) { const int kt = i >> 9, j = i & 511;
          *(v4u*)(wb + W_IN + ((size_t)((13 * 16 + kt) * 2 + 1) << 14) + 8192 + 16 * j) = (v4u){0u, 0u, 0u, 0u}; } }
}
__device__ __forceinline__ void ln_row_stats(f32x4 (&v)[4], float& mean, float& rstd) {
    float s = 0.f;
#pragma unroll
    for (int j = 0; j < 4; ++j) s += (v[j].x + v[j].y) + (v[j].z + v[j].w);
    mean = wave_sum_fast(s) * (1.f / D); float s2 = 0.f;
#pragma unroll
    for (int j = 0; j < 4; ++j) { const f32x4 d = v[j] - mean; s2 += (d.x * d.x + d.y * d.y) + (d.z * d.z + d.w * d.w); }
    rstd = __builtin_amdgcn_rsqf(wave_sum_fast(s2) * (1.f / D) + 1e-5f);
}
#define XB_TMO      128
#define XB_XCNT(j)  (256  + 64 * (j))
#define XB_XSUB(j)  (1280 + 64 * (j))
#define XB_XGEN(j)  (2304 + 64 * (j))
#define XB_TOP      3328
#define XB_TOPGEN   3392
#define XCD_BAR_WORDS 3456
#define XB_SPIN_CAP (1u << 22)

__device__ __forceinline__ unsigned xb_ld(unsigned* p)              { return __hip_atomic_load(p, __ATOMIC_RELAXED, __HIP_MEMORY_SCOPE_AGENT); }
__device__ __forceinline__ unsigned xb_add(unsigned* p, unsigned v) { return __hip_atomic_fetch_add(p, v, __ATOMIC_RELAXED, __HIP_MEMORY_SCOPE_AGENT); }
__device__ __forceinline__ unsigned xb_xcc_id() { return (unsigned)__builtin_amdgcn_s_getreg((3 << 11) | 20) & 0xFu; }
#define XB_SPIN(cond, bar) do { unsigned _sp = 0; while (cond) { __builtin_amdgcn_s_sleep(1); \
    if ((++_sp & 255u) == 0u) { if (xb_ld(&(bar)[XB_TMO])) break; if (_sp > XB_SPIN_CAP) { atomicAdd(&(bar)[XB_TMO], 1u); break; } } } } while (0)

struct XcdBarrier {
    unsigned* bar; unsigned x;
    volatile LAS unsigned* st;
};

__device__ __forceinline__ XcdBarrier xcd_barrier_post(unsigned* bar, volatile LAS unsigned* st) {
    XcdBarrier b; b.bar = bar; b.x = xb_xcc_id(); b.st = st;
    if (threadIdx.x == 0) (void)xb_add(&bar[XB_XCNT(b.x)], 1u);
    return b;
}
__device__ __forceinline__ void xcd_barrier_complete(unsigned* bar, unsigned x, unsigned& nloc, unsigned& nx) {
    const unsigned G = gridDim.x * gridDim.y * gridDim.z;
    unsigned sum, cnt, mine, sp = 0u;
    for (;;) {
        sum = 0u; cnt = 0u; mine = 0u;
#pragma unroll
        for (unsigned j = 0; j < 16; ++j) { const unsigned c = xb_ld(&bar[XB_XCNT(j)]); sum += c; cnt += (c > 0u) ? 1u : 0u; mine = (j == x) ? c : mine; }
        if (sum == G) break;
        __builtin_amdgcn_s_sleep(1);
        if ((++sp & 255u) == 0u) { if (xb_ld(&bar[XB_TMO])) break; if (sp > XB_SPIN_CAP) { atomicAdd(&bar[XB_TMO], 1u); break; } }
    }
    nloc = mine > 0u ? mine : 1u; nx = cnt > 0u ? cnt : 1u;
}

__device__ __forceinline__ void xcd_barrier(const XcdBarrier& b) {
    asm volatile("s_waitcnt vmcnt(0)" ::: "memory");
    __syncthreads();
    if (threadIdx.x == 0) {
        unsigned* bar = b.bar;
        __builtin_amdgcn_s_waitcnt(0);
        unsigned nloc = b.st[0], nx = b.st[1];
        if (nloc == 0u) { xcd_barrier_complete(bar, b.x, nloc, nx); b.st[0] = nloc; b.st[1] = nx; }
        const unsigned old = xb_add(&bar[XB_XSUB(b.x)], 1u);
        const unsigned gen = old / nloc;
        if (old + 1u == (gen + 1u) * nloc) {
            __builtin_amdgcn_fence(__ATOMIC_RELEASE, "agent");
            asm volatile("s_waitcnt vmcnt(0)" ::: "memory");
            const unsigned og = xb_add(&bar[XB_TOP], 1u);
            const unsigned tg = og / nx;
            if (og + 1u == (tg + 1u) * nx) xb_add(&bar[XB_TOPGEN], 1u);
            else XB_SPIN(xb_ld(&bar[XB_TOPGEN]) == tg, bar);
            __builtin_amdgcn_fence(__ATOMIC_ACQUIRE, "agent");
            xb_add(&bar[XB_XGEN(b.x)], 1u);
            asm volatile("s_waitcnt vmcnt(0)" ::: "memory");
        } else {
            XB_SPIN(xb_ld(&bar[XB_XGEN(b.x)]) == gen, bar);
            __builtin_amdgcn_fence(__ATOMIC_ACQUIRE, "agent");
            asm volatile("s_waitcnt vmcnt(0)" ::: "memory");
        }
    }
    __syncthreads();
}
constexpr int RL = 68;
__device__ __forceinline__ bf16x8 rw_frag(const LAS float* p) {
    const f32x4 x = *(const LAS f32x4*)p, y = *(const LAS f32x4*)(p + 4);
    const v4u w = (v4u){pg8::cvt_pk_bf16(x.x, x.y), pg8::cvt_pk_bf16(x.z, x.w), pg8::cvt_pk_bf16(y.x, y.y), pg8::cvt_pk_bf16(y.z, y.w)};
    return __builtin_bit_cast(bf16x8, w);
}
__device__ __forceinline__ void rw_mma(f32x4 (&acc)[2], const LAS float* A, const LAS float* Bk, int lane, int wave) {
    const int tm = wave >> 1, tn0 = (wave & 1) * 2, l15 = lane & 15, kq = lane >> 4;
#pragma unroll
    for (int ks = 0; ks < 2; ++ks) { const bf16x8 af = rw_frag(A + (16 * tm + l15) * RL + 32 * ks + 8 * kq);
#pragma unroll
        for (int t = 0; t < 2; ++t) { const bf16x8 bf = rw_frag(Bk + (16 * (tn0 + t) + l15) * RL + 32 * ks + 8 * kq);
            acc[t] = __builtin_amdgcn_mfma_f32_16x16x32_bf16(af, bf, acc[t], 0, 0, 0); } }
}
#define RW_ZERO(acc) do { acc[0] = (f32x4){0.f, 0.f, 0.f, 0.f}; acc[1] = (f32x4){0.f, 0.f, 0.f, 0.f}; } while (0)
#define RW_FOREACH(acc, ROW, COL, VAL, BODY) do { _Pragma("unroll") for (int t_ = 0; t_ < 2; ++t_) _Pragma("unroll") for (int r_ = 0; r_ < 4; ++r_) { \
    const int ROW = 16 * (wave >> 1) + 4 * (lane >> 4) + r_, COL = 16 * ((wave & 1) * 2 + t_) + (lane & 15); const float VAL = acc[t_][r_]; BODY } } while (0)

__device__ __forceinline__ void rw_mma32(f32x4 (&acc)[2], const LAS float* A, const LAS float* Bk, int lane, int wave) {
    const int tm = wave >> 1, tn0 = (wave & 1) * 2, l15 = lane & 15, kq = lane >> 4;
    const bf16x8 af = rw_frag(A + (16 * tm + l15) * RL + 8 * kq);
#pragma unroll
    for (int t = 0; t < 2; ++t) { const bf16x8 bf = rw_frag(Bk + (16 * (tn0 + t) + l15) * RL + 8 * kq);
        acc[t] = __builtin_amdgcn_mfma_f32_16x16x32_bf16(af, bf, acc[t], 0, 0, 0); }
}

template <int NK> __device__ __forceinline__ void mm8(float (&acc)[8], const LAS float* A, const LAS float* B, int ldb) {
#pragma unroll 8
    for (int k = 0; k < NK; ++k) {
        const float av = A[k]; const f32x4 b0 = *(const LAS f32x4*)(B + k * ldb), b1 = *(const LAS f32x4*)(B + k * ldb + 4);
        acc[0] += av * b0.x; acc[1] += av * b0.y; acc[2] += av * b0.z; acc[3] += av * b0.w;
        acc[4] += av * b1.x; acc[5] += av * b1.y; acc[6] += av * b1.z; acc[7] += av * b1.w;
    }
}
template <int NK> __device__ __forceinline__ void mm4(float (&acc)[4], const LAS float* A, const LAS float* B, int ldb) {
#pragma unroll 8
    for (int k = 0; k < NK; ++k) {
        const float av = A[k]; const f32x4 b0 = *(const LAS f32x4*)(B + k * ldb);
        acc[0] += av * b0.x; acc[1] += av * b0.y; acc[2] += av * b0.z; acc[3] += av * b0.w;
    }
}

__device__ __forceinline__ void ld8(const bf16* P, int b, int t, int col, float (&v)[8]) {
    v4u x = (v4u){0u, 0u, 0u, 0u};
    if (t >= 0) x = *(const GAS v4u*)(P + (size_t)(b * T + t) * PW + col);
    v[0] = bflo(x.x); v[1] = bfhi(x.x); v[2] = bflo(x.y); v[3] = bfhi(x.y); v[4] = bflo(x.z); v[5] = bfhi(x.z); v[6] = bflo(x.w); v[7] = bfhi(x.w);
}
__device__ __forceinline__ v4u ld8raw(const bf16* P, int b, int t, int col) { v4u x = (v4u){0u, 0u, 0u, 0u}; if (t >= 0) x = *(const GAS v4u*)(P + (size_t)(b * T + t) * PW + col); return x; }
__device__ __forceinline__ void unpack8(const v4u x, float (&v)[8]) { v[0] = bflo(x.x); v[1] = bfhi(x.x); v[2] = bflo(x.y); v[3] = bfhi(x.y); v[4] = bflo(x.z); v[5] = bfhi(x.z); v[6] = bflo(x.w); v[7] = bfhi(x.w); }
__device__ __forceinline__ void st8f(LAS float* dst, const v4u x) { *(LAS f32x4*)dst = (f32x4){bflo(x.x), bfhi(x.x), bflo(x.y), bfhi(x.y)}; *(LAS f32x4*)(dst + 4) = (f32x4){bflo(x.z), bfhi(x.z), bflo(x.w), bfhi(x.w)}; }
__device__ __forceinline__ float wave_scan(float v, int lane) {
    v += dppf<0x111>(v); v += dppf<0x112>(v); v += dppf<0x114>(v); v += dppf<0x118>(v);
    const int iv = __builtin_bit_cast(int, v);
    const float t0 = __builtin_bit_cast(float, __builtin_amdgcn_readlane(iv, 15)), t1 = __builtin_bit_cast(float, __builtin_amdgcn_readlane(iv, 31)), t2 = __builtin_bit_cast(float, __builtin_amdgcn_readlane(iv, 47));
    const int row = lane >> 4;
    return v + (row == 0 ? 0.f : row == 1 ? t0 : row == 2 ? t0 + t1 : (t0 + t1) + t2);
}
__device__ __forceinline__ void gla_front(CArgs& a, int l, int b, int h, int c, LAS float* XA, LAS float* LA, LAS float* AU, int tid) {
    const bf16* P = (const bf16*)(a.ws + WS_R + R_P);
    const float* a_up = a.in[I_GLA_AUP] + (size_t)l * 16 * 128; const float* a_b = a.in[I_GLA_AB] + (size_t)l * 128;
    if (tid < 128) { const int j = tid >> 1, p8 = tid & 1; float v[8]; ld8(P, b, 64 * c - PADT + j, C_GLA + 512 + 8 * p8, v);
#pragma unroll
        for (int e = 0; e < 8; ++e) XA[j * 16 + 8 * p8 + e] = v[e]; }
    AU[tid] = a_up[(tid >> 5) * 128 + h * 32 + (tid & 31)];
    if (tid < 32) AU[512 + tid] = a_b[h * 32 + tid];
    __syncthreads();
    { const int j = tid >> 3, d4 = (tid & 7) * 4, t = 64 * c - PADT + j;
      f32x4 z = *(const LAS f32x4*)(AU + 512 + d4);
#pragma unroll
      for (int q4 = 0; q4 < 4; ++q4) { const f32x4 xa = *(const LAS f32x4*)(XA + j * 16 + 4 * q4);
          z += xa.x * *(const LAS f32x4*)(AU + (4 * q4 + 0) * 32 + d4); z += xa.y * *(const LAS f32x4*)(AU + (4 * q4 + 1) * 32 + d4);
          z += xa.z * *(const LAS f32x4*)(AU + (4 * q4 + 2) * 32 + d4); z += xa.w * *(const LAS f32x4*)(AU + (4 * q4 + 3) * 32 + d4); }
      LA[j * 33 + d4 + 0] = t >= 0 ? logsigf_(z.x) * (1.0f / 16.0f) : 0.f; LA[j * 33 + d4 + 1] = t >= 0 ? logsigf_(z.y) * (1.0f / 16.0f) : 0.f;
      LA[j * 33 + d4 + 2] = t >= 0 ? logsigf_(z.z) * (1.0f / 16.0f) : 0.f; LA[j * 33 + d4 + 3] = t >= 0 ? logsigf_(z.w) * (1.0f / 16.0f) : 0.f; }
    __syncthreads();
    { const int lane = tid & 63, wave = tid >> 6;
#pragma unroll
      for (int i = 0; i < 4; ++i) { const int d = wave + 8 * i; LA[lane * 33 + d] = wave_scan(LA[lane * 33 + d], lane); } }
    __syncthreads();
}
__device__ __noinline__ void gla_stage1(CArgs& a, int l, int item, LAS unsigned char* lds, int tid) {
    const int c = item % NCH, bh = item / NCH, b = bh >> 2, h = bh & 3;
    LAS float* XA = (LAS float*)lds; LAS float* LA = XA + 1024; LAS float* KL = LA + 64 * 33; LAS float* V = KL + 32 * 65; LAS float* AU = V + 64 * 64;
    const bf16* P = (const bf16*)(a.ws + WS_R + R_P);
    const v4u kraw = ld8raw(P, b, 64 * c - PADT + ((tid & 255) >> 2), C_GLA + 128 + h * 32 + 8 * (tid & 3));
    const v4u vraw = ld8raw(P, b, 64 * c - PADT + (tid >> 3), C_GLA + 256 + h * 64 + 8 * (tid & 7));
    gla_front(a, l, b, h, c, XA, LA, AU, tid);
    if (tid < 256) { const int j = tid >> 2, p8 = tid & 3; float v[8]; unpack8(kraw, v);
#pragma unroll
        for (int e = 0; e < 8; ++e) { const int d = 8 * p8 + e; KL[d * 65 + j] = v[e] * __expf(LA[63 * 33 + d] - LA[j * 33 + d]); } }
    st8f(V + (tid >> 3) * 64 + 8 * (tid & 7), vraw);
    __syncthreads();
    { const int d = tid >> 4, e0 = (tid & 15) * 4; float acc[4] = {0.f, 0.f, 0.f, 0.f};
      mm4<64>(acc, KL + d * 65, V + e0, 64);
      float* U = (float*)(a.ws + WS_MG + MI_GU) + (size_t)item * 2048;
      *(f32x4*)(U + d * 64 + e0) = (f32x4){acc[0], acc[1], acc[2], acc[3]}; }
    if (tid < 32) ((float*)(a.ws + WS_MG + MI_GDEC))[(size_t)item * 32 + tid] = __expf(LA[63 * 33 + tid]);
    __syncthreads();
}
__device__ __noinline__ void gla_scan(CArgs& a, int item, int tid) {
    const int bh = item >> 2, idx = (item & 3) * 512 + tid, d = idx >> 6;
    GAS float* U = (GAS float*)(a.ws + WS_MG + MI_GU) + (size_t)bh * NCH * 2048 + idx;
    const GAS float* DEC = (const GAS float*)(a.ws + WS_MG + MI_GDEC) + (size_t)bh * NCH * 32 + d;
    float s = 0.f;
    for (int cb = 0; cb < NCH; cb += 16) {
        float u[16], dc[16];
#pragma unroll
        for (int i = 0; i < 16; ++i) { u[i] = 0.f; dc[i] = 0.f; if (cb + i < NCH) { u[i] = U[(size_t)(cb + i) * 2048]; dc[i] = DEC[(cb + i) * 32]; } }
#pragma unroll
        for (int i = 0; i < 16; ++i) if (cb + i < NCH) { U[(size_t)(cb + i) * 2048] = s; s = dc[i] * s + u[i]; }
    }
}
__device__ __noinline__ void gla_stage2(CArgs& a, int l, int item, LAS unsigned char* lds, int tid) {
    const int c = item % NCH, bh = item / NCH, b = bh >> 2, h = bh & 3, lane = tid & 63, wave = tid >> 6;
    LAS float* QG = (LAS float*)lds; LAS float* KG = QG + 64 * RL; LAS float* VT = KG + 64 * RL; LAS float* ST = VT + 64 * RL; LAS float* ATT = ST + 64 * RL; LAS float* O = ATT + 64 * RL;
    LAS float* XA = O + 64 * RL; LAS float* LA = XA + 1024; LAS float* AU = LA + 64 * 33;
    const bf16* P = (const bf16*)(a.ws + WS_R + R_P);
    const int j = tid >> 3, e0 = (tid & 7) * 8;
    const v4u qkraw = ld8raw(P, b, 64 * c - PADT + ((tid & 255) >> 2), C_GLA + (tid >> 8) * 128 + h * 32 + 8 * (tid & 3));
    const v4u vraw = ld8raw(P, b, 64 * c - PADT + j, C_GLA + 256 + h * 64 + e0);
    const f32x4 uraw = ((const GAS f32x4*)((const float*)(a.ws + WS_MG + MI_GU) + (size_t)item * 2048))[tid];
    const v4u ogv = ld8raw(P, b, 64 * c - PADT + j, C_GLA + 528 + h * 64 + e0);
    gla_front(a, l, b, h, c, XA, LA, AU, tid);
    { const int which = tid >> 8, jq = (tid & 255) >> 2, p8 = tid & 3; float v[8]; unpack8(qkraw, v);
#pragma unroll
      for (int e = 0; e < 8; ++e) { const int d = 8 * p8 + e; const float bb = LA[jq * 33 + d];
          if (which == 0) QG[jq * RL + d] = v[e] * 0.17677669529663687f * __expf(bb); else KG[jq * RL + d] = v[e] * __expf(-bb); } }
    { float v[8]; unpack8(vraw, v);
#pragma unroll
      for (int e = 0; e < 8; ++e) VT[(e0 + e) * RL + j] = v[e]; }
    { const int d0 = tid >> 4, e4 = (tid & 15) * 4;
      ST[(e4 + 0) * RL + d0] = uraw.x; ST[(e4 + 1) * RL + d0] = uraw.y; ST[(e4 + 2) * RL + d0] = uraw.z; ST[(e4 + 3) * RL + d0] = uraw.w; }
    __syncthreads();
    { f32x4 at[2]; RW_ZERO(at);
      rw_mma32(at, QG, KG, lane, wave);
      RW_FOREACH(at, rr, cc, vv, ATT[rr * RL + cc] = (cc <= rr) ? vv : 0.f;); }
    __syncthreads();
    { f32x4 o2[2]; RW_ZERO(o2);
      rw_mma(o2, ATT, VT, lane, wave);
      rw_mma32(o2, QG, ST, lane, wave);
      RW_FOREACH(o2, rr, cc, vv, O[rr * RL + cc] = vv;); }
    __syncthreads();
    float o[8];
#pragma unroll
    for (int i = 0; i < 8; ++i) o[i] = O[j * RL + e0 + i];
    float ss = 0.f;
#pragma unroll
    for (int i = 0; i < 8; ++i) ss += o[i] * o[i];
    ss = sum8(ss);
    const float rinv = __builtin_amdgcn_rsqf(ss * (1.0f / 64.0f) + 1e-6f);
    const int t = 64 * c - PADT + j;
    if (t >= 0) {
        const float* ng = a.in[I_GLA_NG] + (size_t)l * 64 + e0;
        const float g0 = siluf_(bflo(ogv.x)), g1 = siluf_(bfhi(ogv.x)), g2 = siluf_(bflo(ogv.y)), g3 = siluf_(bfhi(ogv.y)), g4 = siluf_(bflo(ogv.z)), g5 = siluf_(bfhi(ogv.z)), g6 = siluf_(bflo(ogv.w)), g7 = siluf_(bfhi(ogv.w));
        v4u w; w.x = pk2(o[0] * rinv * ng[0] * g0, o[1] * rinv * ng[1] * g1); w.y = pk2(o[2] * rinv * ng[2] * g2, o[3] * rinv * ng[3] * g3);
        w.z = pk2(o[4] * rinv * ng[4] * g4, o[5] * rinv * ng[5] * g5); w.w = pk2(o[6] * rinv * ng[6] * g6, o[7] * rinv * ng[7] * g7);
        unsigned char* Y = a.ws + WS_Y + (size_t)1 * MP * 512;
        *(GAS v4u*)(Y + pg8::aimg_off(b * T + t, h * 64 + e0, 256)) = w;
    }
    __syncthreads();
}

struct MlRaw { v4u p0, p1; float cwv; };
__device__ __forceinline__ void ml_req_raw(CArgs& a, int l, const bf16* P, int b, int h, int c, int which, int tid, MlRaw& r) {
    const float* cw = a.in[I_ML_CW] + (size_t)l * 4 * 512 + which * 256 + h * 64; const float* cb = a.in[I_ML_CB] + (size_t)l * 512 + which * 256 + h * 64;
    r.p0 = ld8raw(P, b, 64 * c - PADT - 3 + (tid >> 3), C_ML + which * 256 + h * 64 + 8 * (tid & 7));
    r.p1 = (v4u){0u, 0u, 0u, 0u}; if (tid < 67 * 8 - NT) r.p1 = ld8raw(P, b, 64 * c - PADT - 3 + 64 + (tid >> 3), C_ML + which * 256 + h * 64 + 8 * (tid & 7));
    r.cwv = 0.f; if (tid < 256) r.cwv = cw[(tid >> 6) * 512 + (tid & 63)]; else if (tid < 320) r.cwv = cb[tid - 256];
}
__device__ __forceinline__ void ml_put_raw(const MlRaw& r, LAS float* RAW, LAS float* CW, int tid) {
    st8f(RAW + (tid >> 3) * 64 + 8 * (tid & 7), r.p0);
    if (tid < 67 * 8 - NT) st8f(RAW + (64 + (tid >> 3)) * 64 + 8 * (tid & 7), r.p1);
    if (tid < 320) CW[tid] = r.cwv;
}
__device__ __forceinline__ float ml_conv_at(const LAS float* RAW, const LAS float* CW, int j, int d) {
    float s = CW[256 + d];
#pragma unroll
    for (int i = 0; i < 4; ++i) s += CW[i * 64 + d] * RAW[(j + i) * 64 + d];
    return siluf_(s);
}
__device__ __forceinline__ void ml_conv8(const LAS float* RAW, const LAS float* CW, int j, int d8, float (&o)[8]) {
    { const f32x4 b0 = *(const LAS f32x4*)(CW + 256 + d8), b1 = *(const LAS f32x4*)(CW + 256 + d8 + 4); o[0] = b0.x; o[1] = b0.y; o[2] = b0.z; o[3] = b0.w; o[4] = b1.x; o[5] = b1.y; o[6] = b1.z; o[7] = b1.w; }
#pragma unroll
    for (int i = 0; i < 4; ++i) { const f32x4 w0 = *(const LAS f32x4*)(CW + i * 64 + d8), w1 = *(const LAS f32x4*)(CW + i * 64 + d8 + 4), x0 = *(const LAS f32x4*)(RAW + (j + i) * 64 + d8), x1 = *(const LAS f32x4*)(RAW + (j + i) * 64 + d8 + 4);
        o[0] += w0.x * x0.x; o[1] += w0.y * x0.y; o[2] += w0.z * x0.z; o[3] += w0.w * x0.w; o[4] += w1.x * x1.x; o[5] += w1.y * x1.y; o[6] += w1.z * x1.z; o[7] += w1.w * x1.w; }
#pragma unroll
    for (int i = 0; i < 8; ++i) o[i] = siluf_(o[i]);
}
__device__ __forceinline__ void ml_req_gates(const bf16* P, int b, int h, int c, int tid, unsigned& gi, unsigned& gf) {
    gi = 0u; gf = 0u; const int t = 64 * c - PADT + tid;
    if (tid < 64 && t >= 0) { const bf16* pr = P + (size_t)(b * T + t) * PW + C_ML; gi = pr[768 + h]; gf = pr[772 + h]; }
}
__device__ __forceinline__ void ml_gates(CArgs& a, int l, int h, int c, unsigned gi, unsigned gf, LAS float* LI, LAS float* BC, int tid) {
    if (tid < 64) { const int t = 64 * c - PADT + tid; float li = -1e30f, lf = 0.f;
        if (t >= 0) { li = bf2f((bf16)gi) + a.in[I_ML_IB][l * 4 + h]; lf = logsigf_(bf2f((bf16)gf) + a.in[I_ML_FB][l * 4 + h]); }
        LI[tid] = li; BC[tid] = wave_scan(lf, tid); }
    __syncthreads();
}
__device__ __noinline__ void ml_stage1(CArgs& a, int l, int item, LAS unsigned char* lds, int tid) {
    const int c = item % NCH, bh = item / NCH, b = bh >> 2, h = bh & 3;
    const int lane = tid & 63, wave = tid >> 6;
    LAS float* KW = (LAS float*)lds; LAS float* VT = KW + 64 * RL; LAS float* RAW = VT + 64 * RL; LAS float* CW = RAW + 67 * 64;
    LAS float* LI = CW + 320; LAS float* BC = LI + 64; LAS float* WL = BC + 64;
    const bf16* P = (const bf16*)(a.ws + WS_R + R_P);
    MlRaw rk; unsigned gi, gf;
    ml_req_raw(a, l, P, b, h, c, 1, tid, rk);
    const v4u vraw = ld8raw(P, b, 64 * c - PADT + (tid >> 3), C_ML + 512 + h * 64 + 8 * (tid & 7));
    ml_req_gates(P, b, h, c, tid, gi, gf);
    ml_put_raw(rk, RAW, CW, tid);
    { const int jv = tid >> 3, e8 = (tid & 7) * 8; float v[8]; unpack8(vraw, v);
#pragma unroll
      for (int e = 0; e < 8; ++e) VT[(e8 + e) * RL + jv] = v[e]; }
    ml_gates(a, l, h, c, gi, gf, LI, BC, tid);
    if (tid < 64) {
        const float g = BC[63] - BC[tid] + LI[tid]; const float mloc = wave_max(g); WL[tid] = __expf(g - mloc);
        if (tid == 0) { ((float*)(a.ws + WS_MG + MI_ML))[item] = mloc; ((float*)(a.ws + WS_MG + MI_BL))[item] = BC[63]; }
    }
    __syncthreads();
    { const int j = tid >> 3, d8 = (tid & 7) * 8; float kc[8];
      if (64 * c - PADT + j >= 0) ml_conv8(RAW, CW, j, d8, kc); else {
#pragma unroll
          for (int i = 0; i < 8; ++i) kc[i] = 0.f; }
      const float wl = WL[j] * 0.125f;
#pragma unroll
      for (int i = 0; i < 8; ++i) KW[(d8 + i) * RL + j] = kc[i] * wl; }
    __syncthreads();
    { f32x4 cl[2]; RW_ZERO(cl);
      rw_mma(cl, KW, VT, lane, wave);
      GAS float* CL = (GAS float*)(a.ws + WS_MG + MI_MC) + (size_t)item * 4096;
      RW_FOREACH(cl, rr, cc, vv, CL[rr * 64 + cc] = vv;); }
    { const int d = tid >> 3, p8 = (tid & 7) * 8; const f32x4 x = *(const LAS f32x4*)(KW + d * RL + p8), y = *(const LAS f32x4*)(KW + d * RL + p8 + 4);
      const float s = sum8((x.x + x.y) + (x.z + x.w) + (y.x + y.y) + (y.z + y.w));
      if ((tid & 7) == 0) ((float*)(a.ws + WS_MG + MI_MN))[(size_t)item * 64 + d] = s; }
    __syncthreads();
}
__device__ __noinline__ void ml_scan(CArgs& a, int item, int tid) {
    const int bh = item >> 3, sub = item & 7, idx = sub * 512 + tid;
    GAS float* CL = (GAS float*)(a.ws + WS_MG + MI_MC) + (size_t)bh * NCH * 4096 + idx;
    GAS float* NL = (GAS float*)(a.ws + WS_MG + MI_MN) + (size_t)bh * NCH * 64 + tid;
    const GAS float* ML = (const GAS float*)(a.ws + WS_MG + MI_ML) + bh * NCH; const GAS float* BL = (const GAS float*)(a.ws + WS_MG + MI_BL) + bh * NCH;
    GAS float* MIN = (GAS float*)(a.ws + WS_MG + MI_MIN) + bh * NCH;
    const bool do_n = (sub == 0 && tid < 64);
    float cs = 0.f, ns = 0.f, ms = 0.f;
    for (int cb = 0; cb < NCH; cb += 16) {
        float blv[16], mlv[16], clv[16], nlv[16];
#pragma unroll
        for (int i = 0; i < 16; ++i) { blv[i] = 0.f; mlv[i] = 0.f; clv[i] = 0.f; nlv[i] = 0.f;
            if (cb + i < NCH) { blv[i] = BL[cb + i]; mlv[i] = ML[cb + i]; clv[i] = CL[(size_t)(cb + i) * 4096]; if (do_n) nlv[i] = NL[(cb + i) * 64]; } }
#pragma unroll
        for (int i = 0; i < 16; ++i) if (cb + i < NCH) { const int c = cb + i; const float bl = blv[i], ml = mlv[i], cl = clv[i], nl = nlv[i];
            CL[(size_t)c * 4096] = cs; if (do_n) NL[c * 64] = ns; if (sub == 0 && tid == 0) MIN[c] = ms;
            const float mn = fmaxf(bl + ms, ml), so = __expf(bl + ms - mn), sn = __expf(ml - mn);
            cs = so * cs + sn * cl; ns = so * ns + sn * nl; ms = mn; }
    }
}
__device__ __noinline__ void ml_stage2(CArgs& a, int l, int item, LAS unsigned char* lds, int tid) {
    const int c = item % NCH, bh = item / NCH, b = bh >> 2, h = bh & 3, lane = tid & 63, wave = tid >> 6;
    LAS float* Q = (LAS float*)lds; LAS float* K = Q + 64 * RL; LAS float* VT = K + 64 * RL; LAS float* CT = VT + 64 * RL; LAS float* SW = CT + 64 * RL; LAS float* H = SW + 64 * RL;
    LAS float* RAWQ = H + 64 * RL; LAS float* RAWK = RAWQ + 67 * 64; LAS float* CWQ = RAWK + 67 * 64; LAS float* CWK = CWQ + 320;
    LAS float* LI = CWK + 320; LAS float* BC = LI + 64; LAS float* NIN = BC + 64; LAS float* MT = NIN + 64; LAS float* WI = MT + 64; LAS float* DINV = WI + 64;
    const bf16* P = (const bf16*)(a.ws + WS_R + R_P);
    MlRaw rq, rk; unsigned gi, gf;
    ml_req_raw(a, l, P, b, h, c, 0, tid, rq);
    ml_req_raw(a, l, P, b, h, c, 1, tid, rk);
    const v4u vraw = ld8raw(P, b, 64 * c - PADT + (tid >> 3), C_ML + 512 + h * 64 + 8 * (tid & 7));
    const GAS f32x4* CL = (const GAS f32x4*)((const float*)(a.ws + WS_MG + MI_MC) + (size_t)item * 4096);
    const f32x4 cin0 = CL[tid], cin1 = CL[512 + tid];
    float ninv = 0.f; if (tid < 64) ninv = ((const float*)(a.ws + WS_MG + MI_MN))[(size_t)item * 64 + tid];
    const float m_in = ((const float*)(a.ws + WS_MG + MI_MIN))[item];
    ml_req_gates(P, b, h, c, tid, gi, gf);
    const v4u ogv = ld8raw(P, b, 64 * c - PADT + (tid >> 3), C_ML + 776 + h * 64 + 8 * (tid & 7));
    ml_put_raw(rq, RAWQ, CWQ, tid);
    ml_put_raw(rk, RAWK, CWK, tid);
    { const int jv = tid >> 3, e8 = (tid & 7) * 8; float v[8]; unpack8(vraw, v);
#pragma unroll
      for (int e = 0; e < 8; ++e) VT[(e8 + e) * RL + jv] = v[e]; }
    { const int d0 = tid >> 4, e4 = (tid & 15) * 4;
      CT[(e4 + 0) * RL + d0] = cin0.x; CT[(e4 + 1) * RL + d0] = cin0.y; CT[(e4 + 2) * RL + d0] = cin0.z; CT[(e4 + 3) * RL + d0] = cin0.w;
      CT[(e4 + 0) * RL + 32 + d0] = cin1.x; CT[(e4 + 1) * RL + 32 + d0] = cin1.y; CT[(e4 + 2) * RL + 32 + d0] = cin1.z; CT[(e4 + 3) * RL + 32 + d0] = cin1.w; }
    if (tid < 64) NIN[tid] = ninv;
    ml_gates(a, l, h, c, gi, gf, LI, BC, tid);
    const int j = tid >> 3, e0 = (tid & 7) * 8;
    { float qc[8], kc[8];
      if (64 * c - PADT + j >= 0) { ml_conv8(RAWQ, CWQ, j, e0, qc); ml_conv8(RAWK, CWK, j, e0, kc); } else {
#pragma unroll
          for (int i = 0; i < 8; ++i) { qc[i] = 0.f; kc[i] = 0.f; } }
      *(LAS f32x4*)(Q + j * RL + e0) = (f32x4){qc[0], qc[1], qc[2], qc[3]}; *(LAS f32x4*)(Q + j * RL + e0 + 4) = (f32x4){qc[4], qc[5], qc[6], qc[7]};
      *(LAS f32x4*)(K + j * RL + e0) = (f32x4){kc[0] * 0.125f, kc[1] * 0.125f, kc[2] * 0.125f, kc[3] * 0.125f}; *(LAS f32x4*)(K + j * RL + e0 + 4) = (f32x4){kc[4] * 0.125f, kc[5] * 0.125f, kc[6] * 0.125f, kc[7] * 0.125f}; }
    {
      const float bj = BC[j]; float mx = -INFINITY;
#pragma unroll
      for (int i = 0; i < 8; ++i) { const int s = e0 + i; mx = fmaxf(mx, (s <= j) ? (bj - BC[s] + LI[s]) : -INFINITY); }
      mx = max8(mx);
      const float inter = bj + m_in, mt = fmaxf(inter, mx);
      if ((tid & 7) == 0) { MT[j] = mt; WI[j] = __expf(inter - mt); } }
    __syncthreads();
    { f32x4 qk[2]; RW_ZERO(qk);
      rw_mma(qk, Q, K, lane, wave);
      RW_FOREACH(qk, rr, cc, vv, SW[rr * RL + cc] = (cc <= rr) ? __expf(BC[rr] - BC[cc] + LI[cc] - MT[rr]) * vv : 0.f;); }
    __syncthreads();
    { float dsum = 0.f, qn = 0.f;
#pragma unroll
      for (int i = 0; i < 8; ++i) { dsum += SW[j * RL + e0 + i]; qn += Q[j * RL + e0 + i] * NIN[e0 + i]; }
      dsum = sum8(dsum); qn = sum8(qn);
      const float den = dsum + WI[j] * qn;
      if ((tid & 7) == 0) DINV[j] = __builtin_amdgcn_rcpf(fmaxf(fabsf(den), __expf(-MT[j]))); }
    { f32x4 num[2], qc[2]; RW_ZERO(num); RW_ZERO(qc);
      rw_mma(num, SW, VT, lane, wave);
      rw_mma(qc, Q, CT, lane, wave);
#pragma unroll
      for (int t_ = 0; t_ < 2; ++t_)
#pragma unroll
          for (int r_ = 0; r_ < 4; ++r_) { const int rr = 16 * (wave >> 1) + 4 * (lane >> 4) + r_, cc = 16 * ((wave & 1) * 2 + t_) + (lane & 15); H[rr * RL + cc] = num[t_][r_] + WI[rr] * qc[t_][r_]; } }
    __syncthreads();
    const float dinv = DINV[j];
    const int t = 64 * c - PADT + j;
    float hv[8]; float s1 = 0.f;
    if (t >= 0) {
        const float og[8] = {bflo(ogv.x), bfhi(ogv.x), bflo(ogv.y), bfhi(ogv.y), bflo(ogv.z), bfhi(ogv.z), bflo(ogv.w), bfhi(ogv.w)};
#pragma unroll
        for (int i = 0; i < 8; ++i) { hv[i] = H[j * RL + e0 + i] * dinv * sigmoidf_(og[i]); s1 += hv[i]; }
    } else {
#pragma unroll
        for (int i = 0; i < 8; ++i) hv[i] = 0.f;
    }
    const float mean = sum8(s1) * (1.0f / 64.0f); float s2 = 0.f;
#pragma unroll
    for (int i = 0; i < 8; ++i) { hv[i] -= mean; s2 += hv[i] * hv[i]; }
    const float rstd = __builtin_amdgcn_rsqf(sum8(s2) * (1.0f / 64.0f) + 1e-5f);
    if (t >= 0) {
        const float* ng = a.in[I_ML_NG] + (size_t)l * 256 + h * 64 + e0;
        v4u w; w.x = pk2(hv[0] * rstd * ng[0], hv[1] * rstd * ng[1]); w.y = pk2(hv[2] * rstd * ng[2], hv[3] * rstd * ng[3]);
        w.z = pk2(hv[4] * rstd * ng[4], hv[5] * rstd * ng[5]); w.w = pk2(hv[6] * rstd * ng[6], hv[7] * rstd * ng[7]);
        unsigned char* Y = a.ws + WS_Y + (size_t)3 * MP * 512;
        *(GAS v4u*)(Y + pg8::aimg_off(b * T + t, h * 64 + e0, 256)) = w;
    }
    __syncthreads();
}

constexpr int RTT = 16;
__device__ __noinline__ void rwkv_chain(CArgs& a, int l, int bh, LAS unsigned char* lds, int tid) {
    const int b = bh >> 2, h = bh & 3, lane = tid & 63, wave = tid >> 6;
    LAS float* WUP = (LAS float*)lds;
    LAS float* AUP = WUP + 4096;
    LAS float* GUP = AUP + 4096;
    LAS float* PS = GUP + 8192;
    LAS float* KK = PS + RTT * 448;
    LAS float* WR = KK + RTT * 64; LAS float* WD = WR + RTT * 64; LAS float* KA = WD + RTT * 64; LAS float* KP = KA + RTT * 64;
    LAS float* AA = KP + RTT * 64; LAS float* GG = AA + RTT * 64; LAS float* YY = GG + RTT * 64;
    LAS float* C1 = YY + RTT * 64; LAS float* C2 = C1 + RTT; LAS float* BON = C2 + RTT;
    const bf16* P = (const bf16*)(a.ws + WS_R + R_P);
    const float* mu = a.in[I_RW_MU] + (size_t)l * 1024;
    { const float* w_up = a.in[I_RW_WUP] + (size_t)l * 64 * 256; const float* a_up = a.in[I_RW_AUP] + (size_t)l * 64 * 256; const float* g_up = a.in[I_RW_GUP] + (size_t)l * 128 * 256;
      for (int i = tid; i < 4096; i += NT) { WUP[i] = w_up[(i >> 6) * 256 + h * 64 + (i & 63)]; AUP[i] = a_up[(i >> 6) * 256 + h * 64 + (i & 63)]; }
      for (int i = tid; i < 8192; i += NT) GUP[i] = g_up[(i >> 6) * 256 + h * 64 + (i & 63)]; }
    const float* w0 = a.in[I_RW_W0] + (size_t)l * 256 + h * 64; const float* a0 = a.in[I_RW_A0] + (size_t)l * 256 + h * 64;
    const float* k_k = a.in[I_RW_KK] + (size_t)l * 256 + h * 64; const float* k_a = a.in[I_RW_KA] + (size_t)l * 256 + h * 64;
    const float* r_k = a.in[I_RW_RK] + (size_t)l * 256 + h * 64; const float* gn_g = a.in[I_RW_GNG] + (size_t)l * 256 + h * 64; const float* gn_b = a.in[I_RW_GNB] + (size_t)l * 256 + h * 64;
    bf16* Y = (bf16*)(a.ws + WS_Y);
    const int row = tid >> 3, cg = tid & 7;
    float s0 = 0.f, s1 = 0.f, s2 = 0.f, s3 = 0.f, s4 = 0.f, s5 = 0.f, s6 = 0.f, s7 = 0.f;
    __syncthreads();
    for (int t0 = 0; t0 < T; t0 += RTT) {
        for (int i = tid; i < RTT * 448; i += NT) { const int tk = i / 448, cc = i % 448, t = t0 + tk;
            int col; if (cc < 192) col = (cc >> 6) * 256 + h * 64 + (cc & 63); else col = 768 + (cc - 192);
            const size_t m = (size_t)(b * T + t) * PW + C_RW + col;
            const float pc = bf2f(P[m]), pp = t > 0 ? bf2f(P[m - PW]) : 0.f;
            float v = pc + (pp - pc) * mu[col];
            if (cc >= 192 && cc < 256) v = tanhf(v); else if (cc >= 320) v = sigmoidf_(v);
            PS[i] = v; }
        __syncthreads();
#pragma unroll
        for (int rep = 0; rep < 2; ++rep) { const int o = tid + rep * NT, tk = o >> 6, cch = o & 63;
            const LAS float* ps = PS + tk * 448;
            float wl = w0[cch], al = a0[cch], gl = 0.f;
#pragma unroll 8
            for (int i = 0; i < 64; ++i) { wl += ps[192 + i] * WUP[i * 64 + cch]; al += ps[256 + i] * AUP[i * 64 + cch]; }
#pragma unroll 8
            for (int i = 0; i < 128; ++i) gl += ps[320 + i] * GUP[i * 64 + cch];
            const float decay = expf(-0.6065306597126334f * sigmoidf_(wl));
            const float av = sigmoidf_(al);
            WD[o] = decay; AA[o] = av; GG[o] = gl;
            KP[o] = ps[64 + cch] * (1.0f + (av - 1.0f) * k_a[cch]); }
        __syncthreads();
#pragma unroll
        for (int rep = 0; rep < 2; ++rep) { const int tk = wave * 2 + rep; const LAS float* ps = PS + tk * 448;
            const float kr = ps[64 + lane] * k_k[lane]; const float nrm = sqrtf(wave_sum(kr * kr)); const float kk = kr / fmaxf(nrm, 1e-12f);
            const float av = AA[tk * 64 + lane], r = ps[lane], kp = KP[tk * 64 + lane];
            KK[tk * 64 + lane] = kk; KA[tk * 64 + lane] = kk * av; WR[tk * 64 + lane] = WD[tk * 64 + lane] * r;
            const float c1 = wave_sum(kk * av * r), c2 = wave_sum(kp * r), bo = wave_sum(r * kp * r_k[lane]);
            if (lane == 0) { C1[tk] = c1; C2[tk] = c2; BON[tk] = bo; } }
        __syncthreads();
#pragma unroll 2
        for (int tk = 0; tk < RTT; ++tk) {
            const f32x4 kk0 = *(const LAS f32x4*)(KK + tk * 64 + cg * 8), kk1 = *(const LAS f32x4*)(KK + tk * 64 + cg * 8 + 4);
            const f32x4 wr0 = *(const LAS f32x4*)(WR + tk * 64 + cg * 8), wr1 = *(const LAS f32x4*)(WR + tk * 64 + cg * 8 + 4);
            const f32x4 wd0 = *(const LAS f32x4*)(WD + tk * 64 + cg * 8), wd1 = *(const LAS f32x4*)(WD + tk * 64 + cg * 8 + 4);
            const f32x4 ka0 = *(const LAS f32x4*)(KA + tk * 64 + cg * 8), ka1 = *(const LAS f32x4*)(KA + tk * 64 + cg * 8 + 4);
            const f32x4 kp0 = *(const LAS f32x4*)(KP + tk * 64 + cg * 8), kp1 = *(const LAS f32x4*)(KP + tk * 64 + cg * 8 + 4);
            const float vt = PS[tk * 448 + 128 + row], c1 = C1[tk], c2 = C2[tk];
            float d1 = ((s0 * kk0.x + s1 * kk0.y) + (s2 * kk0.z + s3 * kk0.w)) + ((s4 * kk1.x + s5 * kk1.y) + (s6 * kk1.z + s7 * kk1.w));
            float d2 = ((s0 * wr0.x + s1 * wr0.y) + (s2 * wr0.z + s3 * wr0.w)) + ((s4 * wr1.x + s5 * wr1.y) + (s6 * wr1.z + s7 * wr1.w));
            d1 = sum8(d1); d2 = sum8(d2);
            const float y = d2 - d1 * c1 + vt * c2;
            if (cg == 0) YY[tk * 64 + row] = y;
            s0 = s0 * wd0.x - d1 * ka0.x + vt * kp0.x; s1 = s1 * wd0.y - d1 * ka0.y + vt * kp0.y; s2 = s2 * wd0.z - d1 * ka0.z + vt * kp0.z; s3 = s3 * wd0.w - d1 * ka0.w + vt * kp0.w;
            s4 = s4 * wd1.x - d1 * ka1.x + vt * kp1.x; s5 = s5 * wd1.y - d1 * ka1.y + vt * kp1.y; s6 = s6 * wd1.z - d1 * ka1.z + vt * kp1.z; s7 = s7 * wd1.w - d1 * ka1.w + vt * kp1.w;
        }
        __syncthreads();
#pragma unroll
        for (int rep = 0; rep < 2; ++rep) { const int tk = wave * 2 + rep, t = t0 + tk;
            const float y = YY[tk * 64 + lane]; const float mean = wave_sum(y) * (1.0f / 64.0f); const float dlt = y - mean;
            const float var = wave_sum(dlt * dlt) * (1.0f / 64.0f);
            const float yn = dlt / sqrtf(var + 64e-5f) * gn_g[lane] + gn_b[lane];
            const float o = (yn + BON[tk] * PS[tk * 448 + 128 + lane]) * GG[tk * 64 + lane];
            *(bf16*)((unsigned char*)Y + pg8::aimg_off(b * T + t, h * 64 + lane, 256)) = (bf16)f2bf(o); }
        __syncthreads();
    }
}

__device__ __noinline__ void dsa_stage1(CArgs& a, int l, int tile, LAS unsigned char* lds, int tid) {
    constexpr int CP = 132;
    LAS float* CN = (LAS float*)lds;
    LAS float* WT = CN + 64 * CP;
    const int lane = tid & 63, wave = tid >> 6;
    const bf16* P = (const bf16*)(a.ws + WS_R + R_P);
    const float* w_uk = a.in[I_DSA_WUK] + (size_t)l * 128 * 64; const float* w_uv = a.in[I_DSA_WUV] + (size_t)l * 128 * 64; const float* ng = a.in[I_DSA_NG] + (size_t)l * 128;
    const int m0 = tile * 64;
    const int tk0 = tid >> 4, q8 = (tid & 15) * 8;
    const v4u c0r = *(const GAS v4u*)(P + (size_t)(m0 + tk0) * PW + C_DSA + 256 + q8), c1r = *(const GAS v4u*)(P + (size_t)(m0 + tk0 + 32) * PW + C_DSA + 256 + q8);
    const int wq = tid & 127, wg = tid >> 7;
    const GAS f32x4* wsrc = (const GAS f32x4*)((wg < 2 ? w_uk : w_uv) + (size_t)wq * 64 + 32 * (wg & 1));
    f32x4 wr[8];
#pragma unroll
    for (int i = 0; i < 8; ++i) wr[i] = wsrc[i];
    const f32x4 g0 = *(const GAS f32x4*)(ng + q8), g1 = *(const GAS f32x4*)(ng + q8 + 4);
    v4u kir = (v4u){0u, 0u, 0u, 0u}; if (tid < 256) kir = *(const GAS v4u*)(P + (size_t)(m0 + (tid >> 2)) * PW + C_DSA + 640 + 8 * (tid & 3));
    { float x0[8], x1[8]; unpack8(c0r, x0); unpack8(c1r, x1);
      float s0 = 0.f, s1 = 0.f;
#pragma unroll
      for (int e = 0; e < 8; ++e) { s0 += x0[e] * x0[e]; s1 += x1[e] * x1[e]; }
      s0 = sum8(s0); s0 += dppf<0x128>(s0); s1 = sum8(s1); s1 += dppf<0x128>(s1);
      const float r0 = __builtin_amdgcn_rsqf(s0 * (1.0f / 128.0f) + 1e-6f), r1 = __builtin_amdgcn_rsqf(s1 * (1.0f / 128.0f) + 1e-6f);
      const float gg[8] = {g0.x, g0.y, g0.z, g0.w, g1.x, g1.y, g1.z, g1.w};
      LAS float* d0 = CN + tk0 * CP + q8; LAS float* d1 = CN + (tk0 + 32) * CP + q8;
      *(LAS f32x4*)d0 = (f32x4){x0[0] * r0 * gg[0], x0[1] * r0 * gg[1], x0[2] * r0 * gg[2], x0[3] * r0 * gg[3]}; *(LAS f32x4*)(d0 + 4) = (f32x4){x0[4] * r0 * gg[4], x0[5] * r0 * gg[5], x0[6] * r0 * gg[6], x0[7] * r0 * gg[7]};
      *(LAS f32x4*)d1 = (f32x4){x1[0] * r1 * gg[0], x1[1] * r1 * gg[1], x1[2] * r1 * gg[2], x1[3] * r1 * gg[3]}; *(LAS f32x4*)(d1 + 4) = (f32x4){x1[4] * r1 * gg[4], x1[5] * r1 * gg[5], x1[6] * r1 * gg[6], x1[7] * r1 * gg[7]}; }
#pragma unroll
    for (int i = 0; i < 8; ++i) { LAS float* d = WT + (64 * (wg >> 1) + 32 * (wg & 1) + 4 * i) * CP + wq; d[0] = wr[i].x; d[CP] = wr[i].y; d[2 * CP] = wr[i].z; d[3 * CP] = wr[i].w; }
    if (tid < 256) { bf16* KI = (bf16*)(a.ws + WS_MG + MI_KI); *(GAS v4u*)(KI + (size_t)(m0 + (tid >> 2)) * 32 + 8 * (tid & 3)) = kir; }
    __syncthreads();
    { const int tm = wave >> 1, tn0 = (wave & 1) * 4, l15 = lane & 15, kq = lane >> 4;
      f32x4 acc[4];
#pragma unroll
      for (int t = 0; t < 4; ++t) acc[t] = (f32x4){0.f, 0.f, 0.f, 0.f};
#pragma unroll
      for (int ks = 0; ks < 4; ++ks) { const bf16x8 af = rw_frag(CN + (16 * tm + l15) * CP + 32 * ks + 8 * kq);
#pragma unroll
          for (int t = 0; t < 4; ++t) { const bf16x8 bf = rw_frag(WT + (16 * (tn0 + t) + l15) * CP + 32 * ks + 8 * kq);
              acc[t] = __builtin_amdgcn_mfma_f32_16x16x32_bf16(af, bf, acc[t], 0, 0, 0); } }
      bf16* dst = (bf16*)(a.ws + WS_MG + ((wave & 1) ? MI_V : MI_K));
#pragma unroll
      for (int t = 0; t < 4; ++t)
#pragma unroll
          for (int r = 0; r < 4; ++r) dst[(size_t)(m0 + 16 * tm + 4 * kq + r) * 64 + 16 * t + l15] = (bf16)f2bf(acc[t][r]); }
    __syncthreads();
}

__device__ __forceinline__ unsigned f2key(float f) { const unsigned u = __builtin_bit_cast(unsigned, f); return u ^ ((unsigned)((int)u >> 31) | 0x80000000u); }
constexpr int DS_HIST = 131072, DS_IDX = DS_HIST + 4096, DS_QV = DS_IDX + 4096, DS_PR = DS_QV + 4096, DS_BT = DS_PR + 16384, DS_SEL = DS_BT + 2112, DS_ENDB = DS_SEL + 64;
static_assert(DS_ENDB <= MISC_OFF, "DSA LDS map");
__device__ __noinline__ void dsa_bias_table(CArgs& a, LAS unsigned char* lds, int tid) {
    LAS float* BT = (LAS float*)(lds + DS_BT); const float* rb = a.in[I_RELB];
    for (int i = tid; i < 129 * 4; i += NT) { const int n = i >> 2, hh = i & 3; int bk;
        if (n < 16) bk = n; else if (n >= 128) bk = 31; else { bk = 16 + (n >= 19) + (n >= 21) + (n >= 24) + (n >= 27) + (n >= 31) + (n >= 35) + (n >= 40) + (n >= 46) + (n >= 52) + (n >= 59) + (n >= 67) + (n >= 77) + (n >= 87) + (n >= 99) + (n >= 113); }
        BT[i] = rb[bk * 4 + hh]; }
    for (int i = tid; i < 1024; i += NT) { ((LAS unsigned*)(lds + DS_HIST))[i] = 0u; ((LAS unsigned*)(lds + DS_QV))[i] = 0u; }
    if (tid < 16) ((LAS unsigned*)(lds + DS_SEL))[tid] = 0u;
    __syncthreads();
}
template <bool TWO = false> __device__ __forceinline__ unsigned dsa_find_bin(const LAS unsigned* H, unsigned& rem, unsigned prefix, int shift, int lane, const LAS unsigned* H2 = nullptr) {
    unsigned c0, c1, c2, c3;
    if (TWO) {
        const int w0 = (4 * lane) & 127, sh = (lane >> 5) * 16;
        const v4u x0 = *(const LAS v4u*)(H + w0), x1 = *(const LAS v4u*)(H + 512 + w0), x2 = *(const LAS v4u*)(H2 + w0), x3 = *(const LAS v4u*)(H2 + 512 + w0);
        c0 = ((x0.x + x1.x + x2.x + x3.x) >> sh) & 0xffffu; c1 = ((x0.y + x1.y + x2.y + x3.y) >> sh) & 0xffffu;
        c2 = ((x0.z + x1.z + x2.z + x3.z) >> sh) & 0xffffu; c3 = ((x0.w + x1.w + x2.w + x3.w) >> sh) & 0xffffu;
    } else { c0 = H[4 * lane]; c1 = H[4 * lane + 1]; c2 = H[4 * lane + 2]; c3 = H[4 * lane + 3]; }
    const unsigned mine = c0 + c1 + c2 + c3; unsigned suf = mine;
    { int sv = (int)suf;
      sv += __builtin_amdgcn_update_dpp(0, sv, 0x101, 0xF, 0xF, true); sv += __builtin_amdgcn_update_dpp(0, sv, 0x102, 0xF, 0xF, true);
      sv += __builtin_amdgcn_update_dpp(0, sv, 0x104, 0xF, 0xF, true); sv += __builtin_amdgcn_update_dpp(0, sv, 0x108, 0xF, 0xF, true);
      const int t1 = __builtin_amdgcn_readlane(sv, 16), t2 = __builtin_amdgcn_readlane(sv, 32), t3 = __builtin_amdgcn_readlane(sv, 48); const int row = lane >> 4;
      suf = (unsigned)(sv + (row == 3 ? 0 : row == 2 ? t3 : row == 1 ? t2 + t3 : t1 + t2 + t3)); }
    unsigned cum = suf - mine;
    int found = -1; unsigned nrem = 0u;
    if (cum < rem && cum + c3 >= rem) { found = 3; nrem = rem - cum; } cum += c3;
    if (found < 0 && cum < rem && cum + c2 >= rem) { found = 2; nrem = rem - cum; } cum += c2;
    if (found < 0 && cum < rem && cum + c1 >= rem) { found = 1; nrem = rem - cum; } cum += c1;
    if (found < 0 && cum < rem && cum + c0 >= rem) { found = 0; nrem = rem - cum; }
    const unsigned long long fm = __ballot(found >= 0);
    const int src = fm ? (int)__ffsll((long long)fm) - 1 : 0;
    const unsigned np = (unsigned)__builtin_amdgcn_readlane((int)(prefix | ((unsigned)(4 * lane + found) << shift)), src);
    rem = (unsigned)__builtin_amdgcn_readlane((int)nrem, src);
    return np;
}
__device__ __forceinline__ float wave_max_fast(float v) {
    v = fmaxf(v, dppf<0xB1>(v)); v = fmaxf(v, dppf<0x4E>(v)); v = fmaxf(v, dppf<0x141>(v)); v = fmaxf(v, dppf<0x140>(v));
    const int iv = __builtin_bit_cast(int, v);
    float r = fmaxf(fmaxf(__builtin_bit_cast(float, __builtin_amdgcn_readlane(iv, 0)), __builtin_bit_cast(float, __builtin_amdgcn_readlane(iv, 16))),
                    fmaxf(__builtin_bit_cast(float, __builtin_amdgcn_readlane(iv, 32)), __builtin_bit_cast(float, __builtin_amdgcn_readlane(iv, 48))));
    asm volatile("" : "+v"(r));
    return r;
}
__device__ __forceinline__ int mbcnt64(unsigned long long m, int acc) { return (int)__builtin_amdgcn_mbcnt_hi((unsigned)(m >> 32), __builtin_amdgcn_mbcnt_lo((unsigned)m, (unsigned)acc)); }
struct DsaPre { bf16x8 a0, a1, qf0, qf1; v4u wa, wb; };
__device__ __forceinline__ void dsa_prefetch(CArgs& a, int tile, int tid, DsaPre& pre) {
    const int lane = tid & 63, wave = tid >> 6, q = wave >> 1;
    const int b = tile / (T / 4), t0 = (tile % (T / 4)) * 4, m0 = b * T + t0;
    const bf16* P = (const bf16*)(a.ws + WS_R + R_P);
    { const int r32 = lane & 31, half = lane >> 5, qa = 2 * ((r32 >> 2) & 1) + (r32 >> 4), ha = 4 * ((r32 >> 3) & 1) + (r32 & 3);
      const bf16* qrow = P + (size_t)(m0 + qa) * PW + C_DSA + 384 + ha * 32 + 8 * half;
      pre.a0 = *(const GAS bf16x8*)qrow; pre.a1 = *(const GAS bf16x8*)(qrow + 16);
      pre.wa = *(const GAS v4u*)(P + (size_t)(m0 + 2 * half) * PW + C_DSA + 672); pre.wb = *(const GAS v4u*)(P + (size_t)(m0 + 2 * half + 1) * PW + C_DSA + 672); }
    { const int mrow = lane & 15, kg = lane >> 4;
      const bf16* qp = P + (size_t)(m0 + q) * PW + C_DSA + (mrow & 3) * 64 + 8 * kg;
      bf16x8 f0 = *(const GAS bf16x8*)qp, f1 = *(const GAS bf16x8*)(qp + 32);
      if (mrow >= 4) {
#pragma unroll
          for (int i = 0; i < 8; ++i) { f0[i] = 0; f1[i] = 0; } }
      pre.qf0 = f0; pre.qf1 = f1; }
}
__device__ __forceinline__ void dsa_stage2(CArgs& a, int tile, int tile_next, LAS unsigned char* lds, int tid, GAS unsigned* qb, int hb, int& cb, int& nxt, DsaPre& pre, volatile LAS int* SLOT, int knext) {
    const int lane = tid & 63, wave = tid >> 6;
    const int b = tile / (T / 4), t0 = (tile % (T / 4)) * 4, m0 = b * T + t0;
    LAS unsigned* SC = (LAS unsigned*)lds; LAS unsigned* HIST = (LAS unsigned*)(lds + DS_HIST); LAS unsigned* HIST2 = (LAS unsigned*)(lds + DS_QV); LAS int* IDX = (LAS int*)(lds + DS_IDX);
    LAS float* PR = (LAS float*)(lds + DS_PR); LAS float* BT = (LAS float*)(lds + DS_BT); LAS unsigned* SEL = (LAS unsigned*)(lds + DS_SEL);
    LAS unsigned* CAND = (LAS unsigned*)PR; LAS unsigned* CANDI = CAND + 1024; LAS unsigned* HISTB = CAND + 2048;
    const bf16* P = (const bf16*)(a.ws + WS_R + R_P);
    const bf16* KB = (const bf16*)(a.ws + WS_MG + MI_K); const bf16* VB = (const bf16*)(a.ws + WS_MG + MI_V); const bf16* KI = (const bf16*)(a.ws + WS_MG + MI_KI);
    const int q = wave >> 1, part = wave & 1;
    const bf16x8 qf0 = pre.qf0, qf1 = pre.qf1;
    if (t0 < 256) {
        for (int i = tid; i < 1024; i += NT) IDX[i] = i & 255;
    } else {
        for (int i = tid; i < 1024; i += NT) HISTB[i] = 0u;
        { const int r32 = lane & 31, half = lane >> 5, qa = r32 >> 3, ha = r32 & 7;
          const bf16x8 a0 = pre.a0, a1 = pre.a1;
          float wq[2][8];
          { const unsigned wv0[4] = {pre.wa.x, pre.wa.y, pre.wa.z, pre.wa.w}, wv1[4] = {pre.wb.x, pre.wb.y, pre.wb.z, pre.wb.w};
#pragma unroll
            for (int e = 0; e < 4; ++e) { wq[0][2 * e] = bflo(wv0[e]) * 0.03125f; wq[0][2 * e + 1] = bfhi(wv0[e]) * 0.03125f; wq[1][2 * e] = bflo(wv1[e]) * 0.03125f; wq[1][2 * e + 1] = bfhi(wv1[e]) * 0.03125f; } }
          const int ntile = (t0 + 4 - 16 + 31) >> 5;
          const GAS bf16* kbase = (const GAS bf16*)KI + (size_t)(b * T + 16 + r32) * 32 + 8 * half;
#define DSA_KLD(d0, d1, kk) do { const int k_ = (kk) < ntile ? (kk) : ntile - 1; d0 = *(const GAS bf16x8*)(kbase + (size_t)k_ * 1024); d1 = *(const GAS bf16x8*)(kbase + (size_t)k_ * 1024 + 16); } while (0)
          const int q0 = half * 2;
          for (int drep = 0; drep < ((DSA_DUP & 1) ? 2 : 1); ++drep) { LAS unsigned* HISTW = drep ? CAND + 3072 : ((lane & 2) ? HIST2 : HIST) + (lane & 1) * 512;
          asm volatile("" ::: "memory");
          bf16x8 nb0, nb1, nc0, nc1; const int wv = __builtin_amdgcn_readfirstlane(wave);
          DSA_KLD(nb0, nb1, wv); DSA_KLD(nc0, nc1, wv + NWAVES);
          for (int kt = wv; kt < ntile; kt += 2 * NWAVES) {
              const bool two = kt + NWAVES < ntile;
              const bf16x8 b0 = nb0, b1 = nb1, c0 = nc0, c1 = nc1;
              DSA_KLD(nb0, nb1, kt + 2 * NWAVES); DSA_KLD(nc0, nc1, kt + 3 * NWAVES);
#pragma unroll
              for (int u = 0; u < 2; ++u) { if (u == 1 && !two) break;
                  const int s = 16 + 32 * (kt + u * NWAVES) + r32;
                  f32x16 acc;
#pragma unroll
                  for (int i = 0; i < 16; ++i) acc[i] = 0.f;
                  acc = __builtin_amdgcn_mfma_f32_32x32x16_bf16(a0, u ? c0 : b0, acc, 0, 0, 0);
                  acc = __builtin_amdgcn_mfma_f32_32x32x16_bf16(a1, u ? c1 : b1, acc, 0, 0, 0);
                  float pq[2];
#pragma unroll
                  for (int qa_ = 0; qa_ < 2; ++qa_) { f32x2 p2 = (f32x2){0.f, 0.f}; float pa = 0.f;
#pragma unroll
                      for (int e = 0; e < 8; e += 2) p2 = __builtin_elementwise_fma((f32x2){wq[qa_][e], wq[qa_][e + 1]}, (f32x2){acc[8 * qa_ + e], acc[8 * qa_ + e + 1]}, p2);
#pragma unroll
                      for (int e = 0; e < 8; ++e) pa = fmaf(wq[qa_][e], __builtin_fabsf(acc[8 * qa_ + e]), pa);
                      pq[qa_] = (p2.x + p2.y) + pa; }
                  const float v0 = pq[0], v1 = pq[1];
                  if (16 + 32 * (kt + u * NWAVES) + 31 <= t0) {
                      const unsigned key0 = f2key(v0), key1 = f2key(v1);
                      SC[q0 * 8192 + (s - 16)] = key0;
                      SC[(q0 + 1) * 8192 + (s - 16)] = key1;
                      __hip_atomic_fetch_add(&HISTW[q0 * 128 + ((key0 >> 24) & 127u)], 1u << ((key0 >> 27) & 16u), __ATOMIC_RELAXED, __HIP_MEMORY_SCOPE_WORKGROUP);
                      __hip_atomic_fetch_add(&HISTW[(q0 + 1) * 128 + ((key1 >> 24) & 127u)], 1u << ((key1 >> 27) & 16u), __ATOMIC_RELAXED, __HIP_MEMORY_SCOPE_WORKGROUP);
                  } else {
                      const bool ok0 = s <= t0 + q0, ok1 = s <= t0 + q0 + 1;
                      const unsigned key0 = ok0 ? f2key(v0) : 0u, key1 = ok1 ? f2key(v1) : 0u;
                      SC[q0 * 8192 + (s - 16)] = key0;
                      SC[(q0 + 1) * 8192 + (s - 16)] = key1;
                      if (ok0) __hip_atomic_fetch_add(&HISTW[q0 * 128 + ((key0 >> 24) & 127u)], 1u << ((key0 >> 27) & 16u), __ATOMIC_RELAXED, __HIP_MEMORY_SCOPE_WORKGROUP);
                      if (ok1) __hip_atomic_fetch_add(&HISTW[(q0 + 1) * 128 + ((key1 >> 24) & 127u)], 1u << ((key1 >> 27) & 16u), __ATOMIC_RELAXED, __HIP_MEMORY_SCOPE_WORKGROUP); } }
          }
          }
#undef DSA_KLD
          }
    }
    __syncthreads();
    if (t0 >= 256) {
        const int n = t0 + q - 15, n4 = (n + 3) >> 2;
        unsigned rem = 240u;
        unsigned prefix = dsa_find_bin<true>(HIST + q * 128, rem, 0u, 24, lane, HIST2 + q * 128);
        { const unsigned p1 = prefix >> 24;
          v4u kn = (v4u){0u, 0u, 0u, 0u}; if (part * 64 + lane < n4) kn = *(const LAS v4u*)(SC + q * 8192 + 4 * (part * 64 + lane));
          for (int g = part * 64 + lane; g < n4; g += 128) { const v4u kk = kn; if (g + 128 < n4) kn = *(const LAS v4u*)(SC + q * 8192 + 4 * (g + 128));
              if ((kk.x >> 24) == p1) __hip_atomic_fetch_add(&HISTB[q * 256 + ((kk.x >> 16) & 255u)], 1u, __ATOMIC_RELAXED, __HIP_MEMORY_SCOPE_WORKGROUP);
              if ((kk.y >> 24) == p1) __hip_atomic_fetch_add(&HISTB[q * 256 + ((kk.y >> 16) & 255u)], 1u, __ATOMIC_RELAXED, __HIP_MEMORY_SCOPE_WORKGROUP);
              if ((kk.z >> 24) == p1) __hip_atomic_fetch_add(&HISTB[q * 256 + ((kk.z >> 16) & 255u)], 1u, __ATOMIC_RELAXED, __HIP_MEMORY_SCOPE_WORKGROUP);
              if ((kk.w >> 24) == p1) __hip_atomic_fetch_add(&HISTB[q * 256 + ((kk.w >> 16) & 255u)], 1u, __ATOMIC_RELAXED, __HIP_MEMORY_SCOPE_WORKGROUP); } }
        __syncthreads();
        prefix = dsa_find_bin(HISTB + q * 256, rem, prefix, 16, lane);
        const int D = 240 - (int)rem;
        { const int gh = (n4 + 1) >> 1, gbeg = part * gh, gend = (gbeg + gh < n4) ? gbeg + gh : n4;
          const unsigned klo = prefix, khi = prefix + 0x10000u; const bool hiany = khi != 0u;
          if (part == 0 && lane < 16) IDX[q * 256 + lane] = lane;
          for (int drep = 0; drep < ((DSA_DUP & 64) ? 2 : 1); ++drep) { asm volatile("" ::: "memory"); int cnt = 0;
          LAS unsigned* SELW = drep ? &SEL[q * 4 + 2] : &SEL[q * 4 + 3]; LAS unsigned* CW = drep ? CAND + 3072 : CAND; LAS unsigned* CIW = drep ? CAND + 3072 : CANDI;
          v4u kn = (v4u){0u, 0u, 0u, 0u}; if (gbeg + lane < gend) kn = *(const LAS v4u*)(SC + q * 8192 + 4 * (gbeg + lane));
          for (int g0 = gbeg; g0 < gend; g0 += 64) { const int g = g0 + lane;
              const v4u kk = kn; kn = (v4u){0u, 0u, 0u, 0u}; if (g + 64 < gend) kn = *(const LAS v4u*)(SC + q * 8192 + 4 * (g + 64));
              const unsigned long long mg0 = __ballot(hiany && kk.x >= khi), mg1 = __ballot(hiany && kk.y >= khi), mg2 = __ballot(hiany && kk.z >= khi), mg3 = __ballot(hiany && kk.w >= khi);
              const unsigned long long me0 = __ballot(kk.x >= klo) & ~mg0, me1 = __ballot(kk.y >= klo) & ~mg1, me2 = __ballot(kk.z >= klo) & ~mg2, me3 = __ballot(kk.w >= klo) & ~mg3;
              if ((mg0 | mg1 | mg2 | mg3) != 0ull) {
                  int run = mbcnt64(mg3, mbcnt64(mg2, mbcnt64(mg1, mbcnt64(mg0, cnt))));
                  const unsigned kv[4] = {kk.x, kk.y, kk.z, kk.w};
#pragma unroll
                  for (int e = 0; e < 4; ++e) if (hiany && kv[e] >= khi) { int pos = part == 0 ? 16 + run : 16 + D - 1 - run; pos = pos < 16 ? 16 : (pos > 255 ? 255 : pos); IDX[q * 256 + pos] = 16 + 4 * g + e; ++run; }
                  cnt += __popcll(mg0) + __popcll(mg1) + __popcll(mg2) + __popcll(mg3); }
              if ((me0 | me1 | me2 | me3) != 0ull) {
                  const unsigned kv[4] = {kk.x, kk.y, kk.z, kk.w};
#pragma unroll
                  for (int e = 0; e < 4; ++e) if (kv[e] >= klo && !(hiany && kv[e] >= khi)) { const unsigned pp = __hip_atomic_fetch_add(SELW, 1u, __ATOMIC_RELAXED, __HIP_MEMORY_SCOPE_WORKGROUP); if (pp < 256u) { CW[q * 256 + pp] = kv[e]; CIW[q * 256 + pp] = 16u + 4u * g + e; } } }
          } } }
        __syncthreads();
        const bool ovf = SEL[3] > 256u || SEL[7] > 256u || SEL[11] > 256u || SEL[15] > 256u;
        if (!ovf) {
            const unsigned nc = SEL[q * 4 + 3];
            for (unsigned ci = lane; ci < nc; ci += 64) { const unsigned kv = CAND[q * 256 + ci], iv = CANDI[q * 256 + ci]; unsigned rank = 0u;
                for (unsigned cj = 0; cj < nc; ++cj) { const unsigned ko = CAND[q * 256 + cj], io = CANDI[q * 256 + cj]; rank += (ko > kv || (ko == kv && io < iv)) ? 1u : 0u; }
                if (rank < rem) IDX[q * 256 + 16 + D + (int)rank] = (int)iv; }
        } else {
            LAS unsigned* H2 = HISTB; unsigned mask = 0xffff0000u;
            for (int pass = 2; pass < 4; ++pass) { const int shift = 24 - 8 * pass;
                __syncthreads();
                for (int i = tid; i < 1024; i += NT) H2[i] = 0u;
                __syncthreads();
                for (int i = part * 64 + lane; i < n; i += 128) { const unsigned key = SC[q * 8192 + i]; if ((key & mask) == prefix) __hip_atomic_fetch_add(&H2[q * 256 + ((key >> shift) & 255u)], 1u, __ATOMIC_RELAXED, __HIP_MEMORY_SCOPE_WORKGROUP); }
                __syncthreads();
                prefix = dsa_find_bin(H2 + q * 256, rem, prefix, shift, lane); mask |= 255u << shift; }
            __syncthreads();
            if (part == 0) { const unsigned thr = prefix;
                if (lane < 16) IDX[q * 256 + lane] = lane;
                int base = 16; unsigned eqtaken = 0u; const unsigned long long below = (1ull << lane) - 1ull;
                for (int i0 = 0; i0 < n; i0 += 64) { const int i = i0 + lane; const bool valid = i < n;
                    const unsigned key = valid ? SC[q * 8192 + i] : 0u; const bool gt = valid && key > thr, eq = valid && key == thr;
                    const unsigned long long eqm = __ballot(eq);
                    const bool sel = gt || (eq && (eqtaken + (unsigned)__popcll(eqm & below)) < rem);
                    const unsigned long long sm = __ballot(sel);
                    if (sel) { const int pos = base + __popcll(sm & below); if (pos < 256) IDX[q * 256 + pos] = 16 + i; }
                    base += __popcll(sm); eqtaken += (unsigned)__popcll(eqm); } }
            __syncthreads();
        }
        for (int i = tid; i < 1024; i += NT) { HIST[i] = 0u; HIST2[i] = 0u; }
    }
    { const int hp = part, t = t0 + q; const int L = t0 < 256 ? t + 1 : 256;
      LAS unsigned char* KS = lds + q * 32768;
      const GAS v4u* KG = (const GAS v4u*)KB; const GAS v4u* VG = (const GAS v4u*)VB;
      if (t0 < 256) __syncthreads();
      v4u gv[16], gw[16];
#define DSA_LOAD(DST, SRC) do { _Pragma("unroll") for (int i = 0; i < 16; ++i) { const int p = lane + 64 * i, row = hp * 128 + (p >> 3), part_ = p & 7; \
          DST[i] = (v4u){0u, 0u, 0u, 0u}; if (row < L) DST[i] = (SRC)[(size_t)(b * T + IDX[q * 256 + row]) * 8 + part_]; } } while (0)
#define DSA_PUT(SRCV) do { _Pragma("unroll") for (int i = 0; i < 16; ++i) { const int p = lane + 64 * i, row = hp * 128 + (p >> 3), part_ = p & 7; \
          *(LAS v4u*)(KS + row * 128 + ((part_ ^ ((row >> 1) & 7)) << 4)) = SRCV[i]; } } while (0)
      DSA_LOAD(gv, KG);
      if (tid == 0) nxt = cb < 4 ? (int)__hip_atomic_fetch_add(qb + 64 * ((hb + cb) & 3), 1u, __ATOMIC_RELAXED, __HIP_MEMORY_SCOPE_AGENT) : T / 4;
      DSA_PUT(gv);
      DSA_LOAD(gw, VG);
      __syncthreads();
      if (tid < 4) SEL[tid * 4 + 3] = 0u;
      for (int drep = 0; drep < ((DSA_DUP & 4) ? 2 : 1); ++drep) { asm volatile("" ::: "memory"); const int n16 = lane & 15, kg = lane >> 4;
#pragma unroll 2
        for (int j = 0; j < 8; ++j) { const int row = hp * 128 + 16 * j + n16; const int sw = (row >> 1) & 7;
            const bf16x8 k0 = *(const LAS bf16x8*)(KS + row * 128 + ((kg ^ sw) << 4)), k1 = *(const LAS bf16x8*)(KS + row * 128 + (((kg + 4) ^ sw) << 4));
            f32x4 acc = (f32x4){0.f, 0.f, 0.f, 0.f};
            acc = __builtin_amdgcn_mfma_f32_16x16x32_bf16(qf0, k0, acc, 0, 0, 0);
            acc = __builtin_amdgcn_mfma_f32_16x16x32_bf16(qf1, k1, acc, 0, 0, 0);
            if (kg == 0) { PR[(q * 4 + 0) * 256 + row] = acc[0]; PR[(q * 4 + 1) * 256 + row] = acc[1]; PR[(q * 4 + 2) * 256 + row] = acc[2]; PR[(q * 4 + 3) * 256 + row] = acc[3]; } } }
      dsa_prefetch(a, tile_next, tid, pre);
      __syncthreads();
      { LAS float* p0 = PR + (q * 4 + 2 * hp) * 256; LAS float* p1 = p0 + 256;
        float lg0[4], lg1[4];
#pragma unroll
        for (int r = 0; r < 4; ++r) { const int jj = lane + 64 * r; lg0[r] = -INFINITY; lg1[r] = -INFINITY;
            if (jj < L) { int dist = t - IDX[q * 256 + jj]; dist = dist > 128 ? 128 : dist;
                lg0[r] = p0[jj] * 0.125f + BT[dist * 4 + 2 * hp]; lg1[r] = p1[jj] * 0.125f + BT[dist * 4 + 2 * hp + 1]; } }
        const float m0x = wave_max_fast(fmaxf(fmaxf(lg0[0], lg0[1]), fmaxf(lg0[2], lg0[3]))), m1x = wave_max_fast(fmaxf(fmaxf(lg1[0], lg1[1]), fmaxf(lg1[2], lg1[3])));
        float e0[4], e1[4], s0 = 0.f, s1 = 0.f;
#pragma unroll
        for (int r = 0; r < 4; ++r) { e0[r] = __expf(lg0[r] - m0x); e1[r] = __expf(lg1[r] - m1x); s0 += e0[r]; s1 += e1[r]; }
        const float i0 = 1.0f / wave_sum_fast(s0), i1 = 1.0f / wave_sum_fast(s1);
        LAS bf16* pb = (LAS bf16*)p0;
#pragma unroll
        for (int r = 0; r < 4; ++r) { const int jj = lane + 64 * r; pb[jj] = (bf16)f2bf(e0[r] * i0); pb[256 + jj] = (bf16)f2bf(e1[r] * i1); } }
      DSA_PUT(gw);
      __syncthreads();
#undef DSA_LOAD
#undef DSA_PUT
      for (int drep = 0; drep < ((DSA_DUP & 8) ? 2 : 1); ++drep) { asm volatile("" ::: "memory"); const int g = lane >> 4, i16 = lane & 15, qq = i16 >> 2, pp = lane & 3, hd = i16 & 3;
        const LAS unsigned char* pbh = (const LAS unsigned char*)PR + (q * 4 + 2 * (hd >> 1)) * 1024 + (hd & 1) * 512 + 16 * g;
        const int r1 = 8 * g + qq, sw1 = (r1 >> 1) & 7, sw2 = ((r1 + 4) >> 1) & 7, pc0 = 4 * hp + (pp >> 1), pc1 = pc0 + 2;
        const unsigned kb0 = (unsigned)(unsigned long long)KS + 8 * (pp & 1);
        const unsigned a00 = kb0 + r1 * 128 + ((pc0 ^ sw1) << 4), a01 = kb0 + (r1 + 4) * 128 + ((pc0 ^ sw2) << 4), a10 = kb0 + r1 * 128 + ((pc1 ^ sw1) << 4), a11 = kb0 + (r1 + 4) * 128 + ((pc1 ^ sw2) << 4);
        f32x4 acc0 = (f32x4){0.f, 0.f, 0.f, 0.f}, acc1 = (f32x4){0.f, 0.f, 0.f, 0.f};
#define DSA_PV(KBI) do { const bf16x8 pf = *(const LAS bf16x8*)(pbh + 64 * (KBI)); v2u t00, t01, t10, t11; \
            asm volatile("ds_read_b64_tr_b16 %0, %4 offset:%8\n\tds_read_b64_tr_b16 %1, %5 offset:%8\n\tds_read_b64_tr_b16 %2, %6 offset:%8\n\tds_read_b64_tr_b16 %3, %7 offset:%8\n\ts_waitcnt lgkmcnt(0)" \
                         : "=&v"(t00), "=&v"(t01), "=&v"(t10), "=&v"(t11) : "v"(a00), "v"(a01), "v"(a10), "v"(a11), "i"((KBI) * 4096) : "memory"); \
            const v4u w0 = (v4u){t00.x, t00.y, t01.x, t01.y}, w1 = (v4u){t10.x, t10.y, t11.x, t11.y}; \
            acc0 = __builtin_amdgcn_mfma_f32_16x16x32_bf16(__builtin_bit_cast(bf16x8, w0), pf, acc0, 0, 0, 0); \
            acc1 = __builtin_amdgcn_mfma_f32_16x16x32_bf16(__builtin_bit_cast(bf16x8, w1), pf, acc1, 0, 0, 0); } while (0)
        DSA_PV(0); DSA_PV(1); DSA_PV(2); DSA_PV(3); DSA_PV(4); DSA_PV(5); DSA_PV(6); DSA_PV(7);
#undef DSA_PV
        if (i16 < 4) { unsigned char* Y = a.ws + WS_Y + (size_t)2 * MP * 512; const int yc = i16 * 64 + 32 * hp + 4 * g;
            *(GAS v2u*)(Y + pg8::aimg_off(m0 + q, yc, 256)) = (v2u){pk2(acc0[0], acc0[1]), pk2(acc0[2], acc0[3])};
            *(GAS v2u*)(Y + pg8::aimg_off(m0 + q, yc + 16, 256)) = (v2u){pk2(acc1[0], acc1[1]), pk2(acc1[2], acc1[3])}; } }
    }
    if (tid == 0) {
        int kq = M / 4;
        for (;;) { if (cb >= 4) break; if (nxt < T / 4) { kq = nxt * 4 + ((hb + cb) & 3); break; } if (++cb >= 4) break;
            nxt = (int)__hip_atomic_fetch_add(qb + 64 * ((hb + cb) & 3), 1u, __ATOMIC_RELAXED, __HIP_MEMORY_SCOPE_AGENT); }
        SLOT[0] = knext; SLOT[1] = kq; }
    __syncthreads();
}

constexpr int RWA_BYTES = 64 * RL * 4;
constexpr int RW_GB = 8 * RWA_BYTES, RW_GL = RW_GB + 8192, RW_END = RW_GL + 512;
static_assert(RW_END <= MISC_OFF, "rwkv LDS map");
constexpr size_t R_RWM = (size_t)MP * PW * 2;
constexpr size_t R_RWN = R_RWM + (size_t)NBH * NCH * 4096 * 2;
static_assert(R_RWN + (size_t)NBH * NCH * 4096 * 2 <= R_BYTES, "rwkv intermediates fit behind P");

__device__ __forceinline__ void rwkv_front(CArgs& a, int l, int item, LAS unsigned char* lds, int tid) {
    const int c = item % NCH, bh = item / NCH, b = bh >> 2, h = bh & 3, lane = tid & 63, wave = tid >> 6;
    LAS float* A0 = (LAS float*)lds; LAS float* A1 = A0 + 64 * RL; LAS float* A2 = A1 + 64 * RL; LAS float* A3 = A2 + 64 * RL;
    LAS float* A4 = A3 + 64 * RL; LAS float* A5 = A4 + 64 * RL; LAS float* A6 = A5 + 64 * RL; LAS float* A7 = A6 + 64 * RL;
    LAS unsigned short* GB = (LAS unsigned short*)(lds + RW_GB); LAS float* GL = (LAS float*)(lds + RW_GL); LAS float* BON = GL + 64;
    const bf16* P = (const bf16*)(a.ws + WS_R + R_P);
    const float* mu = a.in[I_RW_MU] + (size_t)l * 1024;
    { const int j = tid >> 3, p8 = tid & 7, t = 64 * c - PADT + j;
      const GAS bf16* prow = (const GAS bf16*)P + (size_t)(b * T + (t >= 0 ? t : 0)) * PW + C_RW;
      v4u cu[7], pv[7]; f32x4 m0[7], m1[7];
#pragma unroll
      for (int it = 0; it < 7; ++it) { const int col = (it < 3 ? it * 256 + h * 64 : 768 + (it - 3) * 64) + 8 * p8;
          cu[it] = (v4u){0u, 0u, 0u, 0u}; pv[it] = (v4u){0u, 0u, 0u, 0u};
          if (t >= 0) cu[it] = *(const GAS v4u*)(prow + col);
          if (t > 0) pv[it] = *(const GAS v4u*)(prow + col - PW);
          m0[it] = *(const GAS f32x4*)(mu + col); m1[it] = *(const GAS f32x4*)(mu + col + 4); }
#pragma unroll
      for (int it = 0; it < 7; ++it) { LAS float* dst = it == 0 ? A5 : it == 1 ? A6 : it == 2 ? A4 : it == 3 ? A0 : it == 4 ? A1 : it == 5 ? A2 : A3;
          const float cf[8] = {bflo(cu[it].x), bfhi(cu[it].x), bflo(cu[it].y), bfhi(cu[it].y), bflo(cu[it].z), bfhi(cu[it].z), bflo(cu[it].w), bfhi(cu[it].w)};
          const float pf[8] = {bflo(pv[it].x), bfhi(pv[it].x), bflo(pv[it].y), bfhi(pv[it].y), bflo(pv[it].z), bfhi(pv[it].z), bflo(pv[it].w), bfhi(pv[it].w)};
          const float mf[8] = {m0[it].x, m0[it].y, m0[it].z, m0[it].w, m1[it].x, m1[it].y, m1[it].z, m1[it].w};
          float v[8];
#pragma unroll
          for (int e = 0; e < 8; ++e) { float x = cf[e] + (pf[e] - cf[e]) * mf[e];
              if (it == 3) { const float ex = __expf(2.0f * x); x = 1.0f - 2.0f * __builtin_amdgcn_rcpf(ex + 1.0f); }
              else if (it >= 5) x = __builtin_amdgcn_rcpf(1.0f + __expf(-x));
              v[e] = t >= 0 ? x : 0.f; }
          *(LAS f32x4*)(dst + j * RL + 8 * p8) = (f32x4){v[0], v[1], v[2], v[3]}; *(LAS f32x4*)(dst + j * RL + 8 * p8 + 4) = (f32x4){v[4], v[5], v[6], v[7]}; } }
    f32x4 kk4[2], ka4[2], rk4[2], w04[2], a04[2];
    { const int cc0 = (tid & 7) * 8; const size_t off = (size_t)l * 256 + h * 64 + cc0;
#pragma unroll
      for (int u = 0; u < 2; ++u) { kk4[u] = *(const GAS f32x4*)(a.in[I_RW_KK] + off + 4 * u); ka4[u] = *(const GAS f32x4*)(a.in[I_RW_KA] + off + 4 * u); rk4[u] = *(const GAS f32x4*)(a.in[I_RW_RK] + off + 4 * u);
          w04[u] = *(const GAS f32x4*)(a.in[I_RW_W0] + off + 4 * u); a04[u] = *(const GAS f32x4*)(a.in[I_RW_A0] + off + 4 * u); } }
    f32x4 wl[2], al[2], gl[2];
    { const float* w_up = a.in[I_RW_WUP] + (size_t)l * 64 * 256 + h * 64; const float* a_up = a.in[I_RW_AUP] + (size_t)l * 64 * 256 + h * 64; const float* g_up = a.in[I_RW_GUP] + (size_t)l * 128 * 256 + h * 64;
      const int wi_ = tid >> 3, wc_ = (tid & 7) * 8;
#define RW_LOAD(src, s0, s1) const f32x4 s0 = *(const GAS f32x4*)((src) + (size_t)wi_ * 256 + wc_), s1 = *(const GAS f32x4*)((src) + (size_t)wi_ * 256 + wc_ + 4)
      RW_LOAD(w_up, q0a, q0b); RW_LOAD(a_up, q1a, q1b); RW_LOAD(g_up, q2a, q2b); RW_LOAD(g_up + 64 * 256, q3a, q3b);
#define RW_STAGE(s0, s1) do { \
        A7[(wc_ + 0) * RL + wi_] = s0.x; A7[(wc_ + 1) * RL + wi_] = s0.y; A7[(wc_ + 2) * RL + wi_] = s0.z; A7[(wc_ + 3) * RL + wi_] = s0.w; \
        A7[(wc_ + 4) * RL + wi_] = s1.x; A7[(wc_ + 5) * RL + wi_] = s1.y; A7[(wc_ + 6) * RL + wi_] = s1.z; A7[(wc_ + 7) * RL + wi_] = s1.w; } while (0)
      RW_STAGE(q0a, q0b); __syncthreads();
      RW_ZERO(wl); rw_mma(wl, A0, A7, lane, wave); __syncthreads();
      RW_STAGE(q1a, q1b); __syncthreads();
      RW_ZERO(al); rw_mma(al, A1, A7, lane, wave); __syncthreads();
      RW_STAGE(q2a, q2b); __syncthreads();
      RW_ZERO(gl); rw_mma(gl, A2, A7, lane, wave); __syncthreads();
      RW_STAGE(q3a, q3b); __syncthreads();
      rw_mma(gl, A3, A7, lane, wave); __syncthreads();
#undef RW_STAGE
#undef RW_LOAD
      RW_FOREACH(wl, rr, cc, vv, A0[rr * RL + cc] = vv;);
      RW_FOREACH(al, rr, cc, vv, A1[rr * RL + cc] = vv;);
      RW_FOREACH(gl, rr, cc, vv, GB[rr * 64 + cc] = (unsigned short)f2bf(vv););
    }
    __syncthreads();
    { const int j = tid >> 3, c0 = (tid & 7) * 8, t = 64 * c - PADT + j;
      const float k_k[8] = {kk4[0].x, kk4[0].y, kk4[0].z, kk4[0].w, kk4[1].x, kk4[1].y, kk4[1].z, kk4[1].w}, k_a[8] = {ka4[0].x, ka4[0].y, ka4[0].z, ka4[0].w, ka4[1].x, ka4[1].y, ka4[1].z, ka4[1].w};
      const float r_k[8] = {rk4[0].x, rk4[0].y, rk4[0].z, rk4[0].w, rk4[1].x, rk4[1].y, rk4[1].z, rk4[1].w}, w0[8] = {w04[0].x, w04[0].y, w04[0].z, w04[0].w, w04[1].x, w04[1].y, w04[1].z, w04[1].w};
      const float a0[8] = {a04[0].x, a04[0].y, a04[0].z, a04[0].w, a04[1].x, a04[1].y, a04[1].z, a04[1].w};
      float kr[8], kp[8], lw[8], av[8], ss = 0.f, bo = 0.f;
#pragma unroll
      for (int e = 0; e < 8; ++e) { const float k = A6[j * RL + c0 + e], r = A5[j * RL + c0 + e];
          av[e] = __builtin_amdgcn_rcpf(1.0f + __expf(-(A1[j * RL + c0 + e] + a0[e])));
          lw[e] = t >= 0 ? -0.6065306597126334f * __builtin_amdgcn_rcpf(1.0f + __expf(-(A0[j * RL + c0 + e] + w0[e]))) : 0.f;
          kp[e] = k * (1.0f + (av[e] - 1.0f) * k_a[e]); kr[e] = k * k_k[e]; ss += kr[e] * kr[e]; bo += r * kp[e] * r_k[e]; }
      ss = sum8(ss); bo = sum8(bo);
      const float inv = 1.0f / fmaxf(sqrtf(ss), 1e-12f);
#pragma unroll
      for (int e = 0; e < 8; ++e) { A0[j * RL + c0 + e] = lw[e]; A1[j * RL + c0 + e] = kr[e] * inv; A2[j * RL + c0 + e] = av[e]; A3[j * RL + c0 + e] = kp[e]; }
      if ((tid & 7) == 0) BON[j] = bo;
    }
    __syncthreads();
    if (tid < 64) { float s = 0.f; for (int jj = 0; jj < 64; ++jj) { s += A0[jj * RL + tid]; A0[jj * RL + tid] = s; } GL[tid] = __expf(s); }
    __syncthreads();
    { float at[8], bt[8], kt[8], vv[8], rt[8];
#pragma unroll
      for (int i = 0; i < 8; ++i) { const int e = tid + NT * i, jj = e >> 6, k = e & 63; const float G = A0[jj * RL + k], Gp = jj > 0 ? A0[(jj - 1) * RL + k] : 0.f, en = __expf(-G);
          const float kk = A1[jj * RL + k]; at[i] = kk * __expf(Gp); bt[i] = kk * A2[jj * RL + k] * en; kt[i] = A3[jj * RL + k] * en; vv[i] = A4[jj * RL + k]; rt[i] = A5[jj * RL + k] * __expf(G); }
      __syncthreads();
#pragma unroll
      for (int i = 0; i < 8; ++i) { const int e = tid + NT * i, jj = e >> 6, k = e & 63;
          A6[k * RL + jj] = at[i]; A7[jj * RL + k] = at[i]; A2[jj * RL + k] = bt[i]; A3[jj * RL + k] = kt[i]; A1[k * RL + jj] = vv[i]; A4[jj * RL + k] = rt[i]; }
    }
    __syncthreads();
    { f32x4 n1[2], n2[2]; RW_ZERO(n1); RW_ZERO(n2);
      rw_mma(n1, A2, A7, lane, wave); rw_mma(n2, A3, A7, lane, wave);
      RW_FOREACH(n1, rr, cc, vv, A0[rr * RL + cc] = rr < cc ? vv : 0.f;);
      RW_FOREACH(n2, rr, cc, vv, A5[rr * RL + cc] = rr < cc ? vv : 0.f;); }
    __syncthreads();
    { const int rho = tid >> 2, q = tid & 3; LAS float* row = rho < 64 ? A6 + rho * RL : A5 + (rho - 64) * RL;
      const LAS float* Nq = A0 + q * RL;
      float xr[16];
#pragma unroll
      for (int m = 0; m < 16; ++m) xr[m] = 0.f;
#pragma unroll
      for (int blk = 0; blk < 16; ++blk) {
          f32x4 nv[16];
#pragma unroll
          for (int m = 0; m <= blk; ++m) nv[m] = *(const LAS f32x4*)(Nq + (4 * m) * RL + 4 * blk);
          const f32x4 rv = *(const LAS f32x4*)(row + 4 * blk);
#pragma unroll
          for (int e = 0; e < 4; ++e) { float s0 = 0.f, s1 = 0.f;
#pragma unroll
              for (int m = 0; m <= blk; ++m) { if (m & 1) s1 += xr[m] * nv[m][e]; else s0 += xr[m] * nv[m][e]; }
              float s = s0 + s1;
              s += dppf<0xB1>(s); s += dppf<0x4E>(s);
              const float xj = rv[e] - s; if (q == e) xr[blk] = xj; } }
      __syncthreads();
#pragma unroll
      for (int m = 0; m < 16; ++m) row[4 * m + q] = xr[m];
    }
    __syncthreads();
}
constexpr size_t RWC_PLANE = (size_t)NBH * NCH * 4096;
static_assert(7 * RWC_PLANE * 2 + (size_t)NBH * NCH * 64 * 4 <= (size_t)BATCH * SEQ * D * 4, "rwkv front-end cache fits the output buffer");
__device__ __forceinline__ void rwkv_cache_put(CArgs& a, int item, LAS unsigned char* lds, int tid) {
    LAS float* A0 = (LAS float*)lds; const int r = tid >> 3, c0 = (tid & 7) * 8;
    bf16* CB = (bf16*)a.out + (size_t)item * 4096 + r * 64 + c0;
#pragma unroll
    for (int p = 0; p < 6; ++p) { const LAS float* src = A0 + (p + 1) * 64 * RL + r * RL + c0;
        const f32x4 x = *(const LAS f32x4*)src, y = *(const LAS f32x4*)(src + 4);
        *(GAS v4u*)(CB + p * RWC_PLANE) = (v4u){pk2(x.x, x.y), pk2(x.z, x.w), pk2(y.x, y.y), pk2(y.z, y.w)}; }
    *(GAS v4u*)(CB + 6 * RWC_PLANE) = *(const LAS v4u*)((LAS unsigned short*)(lds + RW_GB) + r * 64 + c0);
    if (tid < 64) ((float*)((bf16*)a.out + 7 * RWC_PLANE))[(size_t)item * 64 + tid] = ((LAS float*)(lds + RW_GL))[64 + tid];
}
__device__ __forceinline__ void rwkv_cache_get(CArgs& a, int item, LAS unsigned char* lds, int tid) {
    LAS float* A0 = (LAS float*)lds; const int r = tid >> 3, c0 = (tid & 7) * 8;
    const bf16* CB = (const bf16*)a.out + (size_t)item * 4096 + r * 64 + c0;
    v4u w[7];
#pragma unroll
    for (int p = 0; p < 7; ++p) w[p] = *(const GAS v4u*)(CB + p * RWC_PLANE);
    float bo = 0.f; if (tid < 64) bo = ((const float*)((const bf16*)a.out + 7 * RWC_PLANE))[(size_t)item * 64 + tid];
#pragma unroll
    for (int p = 0; p < 6; ++p) { LAS float* dst = A0 + (p + 1) * 64 * RL + r * RL + c0;
        *(LAS f32x4*)dst = (f32x4){bflo(w[p].x), bfhi(w[p].x), bflo(w[p].y), bfhi(w[p].y)}; *(LAS f32x4*)(dst + 4) = (f32x4){bflo(w[p].z), bfhi(w[p].z), bflo(w[p].w), bfhi(w[p].w)}; }
    *(LAS v4u*)((LAS unsigned short*)(lds + RW_GB) + r * 64 + c0) = w[6];
    if (tid < 64) ((LAS float*)(lds + RW_GL))[64 + tid] = bo;
    __syncthreads();
}
__device__ __noinline__ void rwkv_stage1(CArgs& a, int l, int item, LAS unsigned char* lds, int tid) {
    rwkv_front(a, l, item, lds, tid);
    if (RWKV_CACHE) rwkv_cache_put(a, item, lds, tid);
    const int lane = tid & 63, wave = tid >> 6;
    LAS float* A0 = (LAS float*)lds; LAS float* A1 = A0 + 64 * RL; LAS float* A2 = A1 + 64 * RL; LAS float* A3 = A2 + 64 * RL; LAS float* A4 = A3 + 64 * RL; LAS float* A5 = A4 + 64 * RL; LAS float* A6 = A5 + 64 * RL; LAS float* A7 = A6 + 64 * RL;
    LAS float* GL = (LAS float*)(lds + RW_GL);
#pragma unroll
    for (int i = 0; i < 8; ++i) { const int e = tid + NT * i, jj = e >> 6, k = e & 63; A7[k * RL + jj] = A2[jj * RL + k]; }
    __syncthreads();
    f32x4 t1[2], z[2]; RW_ZERO(t1); RW_ZERO(z);
    rw_mma(t1, A6, A7, lane, wave);
    rw_mma(z, A5, A7, lane, wave);
    RW_FOREACH(t1, rr, cc, vv, A4[cc * RL + rr] = ((rr == cc ? 1.0f : 0.0f) - vv) * GL[cc];);
    RW_FOREACH(z, rr, cc, vv, A0[cc * RL + rr] = A3[rr * RL + cc] - vv;);
    __syncthreads();
    f32x4 nc[2]; RW_ZERO(nc);
    rw_mma(nc, A1, A0, lane, wave);
    RW_FOREACH(nc, rr, cc, vv, A2[rr * RL + cc] = vv * GL[cc];);
    __syncthreads();
    { const int r = tid >> 3, c0 = (tid & 7) * 8;
      const f32x4 m0 = *(const LAS f32x4*)(A4 + r * RL + c0), m1 = *(const LAS f32x4*)(A4 + r * RL + c0 + 4), n0 = *(const LAS f32x4*)(A2 + r * RL + c0), n1 = *(const LAS f32x4*)(A2 + r * RL + c0 + 4);
      bf16* MB = (bf16*)(a.ws + WS_R + R_RWM) + (size_t)item * 4096 + r * 64 + c0; bf16* NB = (bf16*)(a.ws + WS_R + R_RWN) + (size_t)item * 4096 + r * 64 + c0;
      *(GAS v4u*)MB = (v4u){pk2(m0.x, m0.y), pk2(m0.z, m0.w), pk2(m1.x, m1.y), pk2(m1.z, m1.w)};
      *(GAS v4u*)NB = (v4u){pk2(n0.x, n0.y), pk2(n0.z, n0.w), pk2(n1.x, n1.y), pk2(n1.z, n1.w)}; }
    __syncthreads();
}
__device__ __noinline__ void rwkv_scan(CArgs& a, int bh, LAS unsigned char* lds, int tid) {
    const int lane = tid & 63, wave = tid >> 6, r = tid >> 3, c0 = (tid & 7) * 8;
    LAS float* BUF = (LAS float*)lds;
    const GAS bf16* MG_ = (const GAS bf16*)(a.ws + WS_R + R_RWM) + (size_t)bh * NCH * 4096 + r * 64 + c0; GAS bf16* NG_ = (GAS bf16*)(a.ws + WS_R + R_RWN) + (size_t)bh * NCH * 4096 + r * 64 + c0;
    v4u mq = *(const GAS v4u*)MG_, nq = *(const GAS v4u*)NG_;
    { LAS float* S0 = BUF + r * RL + c0; *(LAS f32x4*)S0 = (f32x4){0.f, 0.f, 0.f, 0.f}; *(LAS f32x4*)(S0 + 4) = (f32x4){0.f, 0.f, 0.f, 0.f};
      LAS float* M0 = BUF + 64 * RL + r * RL + c0; *(LAS f32x4*)M0 = (f32x4){bflo(mq.x), bfhi(mq.x), bflo(mq.y), bfhi(mq.y)}; *(LAS f32x4*)(M0 + 4) = (f32x4){bflo(mq.z), bfhi(mq.z), bflo(mq.w), bfhi(mq.w)};
      LAS float* N0 = BUF + 128 * RL + r * RL + c0; *(LAS f32x4*)N0 = (f32x4){bflo(nq.x), bfhi(nq.x), bflo(nq.y), bfhi(nq.y)}; *(LAS f32x4*)(N0 + 4) = (f32x4){bflo(nq.z), bfhi(nq.z), bflo(nq.w), bfhi(nq.w)}; }
    if (NCH > 1) { mq = *(const GAS v4u*)(MG_ + 4096); nq = *(const GAS v4u*)(NG_ + 4096); }
    __syncthreads();
    for (int c = 0; c < NCH; ++c) {
        LAS float* SB = BUF + (c & 1) * 192 * RL; LAS float* MT = SB + 64 * RL; LAS float* NB = SB + 128 * RL;
        LAS float* SN = BUF + ((c & 1) ^ 1) * 192 * RL;
        { const f32x4 x = *(const LAS f32x4*)(SB + r * RL + c0), y = *(const LAS f32x4*)(SB + r * RL + c0 + 4);
          *(GAS v4u*)(NG_ + (size_t)c * 4096) = (v4u){pk2(x.x, x.y), pk2(x.z, x.w), pk2(y.x, y.y), pk2(y.z, y.w)}; }
        if (c + 1 < NCH) {
            LAS float* M1 = SN + 64 * RL + r * RL + c0; *(LAS f32x4*)M1 = (f32x4){bflo(mq.x), bfhi(mq.x), bflo(mq.y), bfhi(mq.y)}; *(LAS f32x4*)(M1 + 4) = (f32x4){bflo(mq.z), bfhi(mq.z), bflo(mq.w), bfhi(mq.w)};
            LAS float* N1 = SN + 128 * RL + r * RL + c0; *(LAS f32x4*)N1 = (f32x4){bflo(nq.x), bfhi(nq.x), bflo(nq.y), bfhi(nq.y)}; *(LAS f32x4*)(N1 + 4) = (f32x4){bflo(nq.z), bfhi(nq.z), bflo(nq.w), bfhi(nq.w)};
            if (c + 2 < NCH) { mq = *(const GAS v4u*)(MG_ + (size_t)(c + 2) * 4096); nq = *(const GAS v4u*)(NG_ + (size_t)(c + 2) * 4096); } }
        f32x4 acc[2];
#pragma unroll
        for (int t_ = 0; t_ < 2; ++t_)
#pragma unroll
            for (int r_ = 0; r_ < 4; ++r_) acc[t_][r_] = NB[(16 * (wave >> 1) + 4 * (lane >> 4) + r_) * RL + 16 * ((wave & 1) * 2 + t_) + (lane & 15)];
        rw_mma(acc, SB, MT, lane, wave);
        RW_FOREACH(acc, rr, cc, vv, SN[rr * RL + cc] = vv;);
        __syncthreads();
    }
}
__device__ __noinline__ void rwkv_stage3(CArgs& a, int l, int item, LAS unsigned char* lds, int tid) {
    if (RWKV_CACHE) rwkv_cache_get(a, item, lds, tid); else rwkv_front(a, l, item, lds, tid);
    const int c = item % NCH, bh = item / NCH, b = bh >> 2, h = bh & 3, lane = tid & 63, wave = tid >> 6;
    LAS float* A0 = (LAS float*)lds; LAS float* A1 = A0 + 64 * RL; LAS float* A2 = A1 + 64 * RL; LAS float* A3 = A2 + 64 * RL; LAS float* A4 = A3 + 64 * RL; LAS float* A5 = A4 + 64 * RL; LAS float* A6 = A5 + 64 * RL; LAS float* A7 = A6 + 64 * RL;
    LAS unsigned short* GB = (LAS unsigned short*)(lds + RW_GB); LAS float* BON = (LAS float*)(lds + RW_GL) + 64;
    { f32x4 b1[2], b2[2]; RW_ZERO(b1); RW_ZERO(b2);
      rw_mma(b1, A2, A4, lane, wave); rw_mma(b2, A3, A4, lane, wave);
      RW_FOREACH(b1, rr, cc, vv, A0[cc * RL + rr] = rr <= cc ? vv : 0.f;);
      RW_FOREACH(b2, rr, cc, vv, A7[rr * RL + cc] = rr <= cc ? vv : 0.f;); }
    __syncthreads();
    { f32x4 w1[2], w2[2]; RW_ZERO(w1); RW_ZERO(w2);
      rw_mma(w1, A6, A0, lane, wave); rw_mma(w2, A5, A0, lane, wave);
      RW_FOREACH(w1, rr, cc, vv, A2[cc * RL + rr] = A4[cc * RL + rr] - vv;);
      RW_FOREACH(w2, rr, cc, vv, A3[cc * RL + rr] = A7[rr * RL + cc] - vv;);
      const int r = tid >> 3, c0 = (tid & 7) * 8;
      const v4u sv = *(const GAS v4u*)((const bf16*)(a.ws + WS_R + R_RWN) + (size_t)item * 4096 + r * 64 + c0);
      __syncthreads();
      *(LAS f32x4*)(A0 + r * RL + c0) = (f32x4){bflo(sv.x), bfhi(sv.x), bflo(sv.y), bfhi(sv.y)}; *(LAS f32x4*)(A0 + r * RL + c0 + 4) = (f32x4){bflo(sv.z), bfhi(sv.z), bflo(sv.w), bfhi(sv.w)}; }
    __syncthreads();
    { f32x4 y[2]; RW_ZERO(y);
      rw_mma(y, A0, A2, lane, wave); rw_mma(y, A1, A3, lane, wave);
      RW_FOREACH(y, rr, cc, vv, A6[cc * RL + rr] = vv;); }
    __syncthreads();
    { const float* gn_g = a.in[I_RW_GNG] + (size_t)l * 256 + h * 64; const float* gn_b = a.in[I_RW_GNB] + (size_t)l * 256 + h * 64; bf16* Y = (bf16*)(a.ws + WS_Y);
      for (int jj = wave; jj < 64; jj += NWAVES) { const int t = 64 * c - PADT + jj; if (t < 0) continue;
          const float y = A6[jj * RL + lane]; const float mean = wave_sum_fast(y) * (1.0f / 64.0f); const float dlt = y - mean; const float var = wave_sum_fast(dlt * dlt) * (1.0f / 64.0f);
          const float yn = dlt * __builtin_amdgcn_rsqf(var + 64e-5f) * gn_g[lane] + gn_b[lane];
          const float o = (yn + BON[jj] * A1[lane * RL + jj]) * bf2f(GB[jj * 64 + lane]);
          *(bf16*)((unsigned char*)Y + pg8::aimg_off(b * T + t, h * 64 + lane, 256)) = (bf16)f2bf(o); } }
    __syncthreads();
}

constexpr int DH_SMALL = 131072, DH_STRIDE = 14464;
constexpr int DH_HIST = 0, DH_IDX = 2048, DH_QV = 4096, DH_PR = 6144, DH_SEL = 14336;
constexpr int DH_BT = DH_SMALL + 2 * DH_STRIDE, DH_BAR = DH_BT + 2112, DH_END = DH_BAR + 64;
static_assert(DH_PR + 8192 <= DH_SEL && DH_END <= MISC_OFF, "DSA half LDS map");
constexpr unsigned DH_SPIN_CAP = 1u << 24;

__device__ __forceinline__ void half_bar(LAS unsigned* ctr, unsigned& target, int lane) {
    asm volatile("s_waitcnt vmcnt(0) lgkmcnt(0)" ::: "memory");
    __builtin_amdgcn_fence(__ATOMIC_RELEASE, "workgroup");
    target += 4u;
    if (lane == 0) { const unsigned old = __hip_atomic_fetch_add(ctr, 1u, __ATOMIC_ACQ_REL, __HIP_MEMORY_SCOPE_WORKGROUP);
        unsigned sp = 0u; if (old + 1u < target) while (__hip_atomic_load(ctr, __ATOMIC_ACQUIRE, __HIP_MEMORY_SCOPE_WORKGROUP) < target) { __builtin_amdgcn_s_sleep(1); if (++sp > DH_SPIN_CAP) break; } }
    __builtin_amdgcn_fence(__ATOMIC_ACQUIRE, "workgroup");
    asm volatile("s_waitcnt vmcnt(0) lgkmcnt(0)" ::: "memory");
}
__device__ __noinline__ void dsa_half_init(CArgs& a, LAS unsigned char* lds, int tid) {
    LAS float* BT = (LAS float*)(lds + DH_BT); const float* rb = a.in[I_RELB];
    for (int i = tid; i < 129 * 4; i += NT) { const int n = i >> 2, hh = i & 3; int bk;
        if (n < 16) bk = n; else if (n >= 128) bk = 31; else { bk = 16 + (n >= 19) + (n >= 21) + (n >= 24) + (n >= 27) + (n >= 31) + (n >= 35) + (n >= 40) + (n >= 46) + (n >= 52) + (n >= 59) + (n >= 67) + (n >= 77) + (n >= 87) + (n >= 99) + (n >= 113); }
        BT[i] = rb[bk * 4 + hh]; }
    for (int i = tid; i < 2 * DH_STRIDE / 4; i += NT) ((LAS unsigned*)(lds + DH_SMALL))[i] = 0u;
    if (tid < 16) ((LAS unsigned*)(lds + DH_BAR))[tid] = 0u;
    __syncthreads();
}
__device__ __forceinline__ void dsa_half_loop(CArgs& a, unsigned* qctr, LAS unsigned char* lds, int tid) {
    const int lane = tid & 63, wave = tid >> 6, hb = wave >> 2, w4 = wave & 3, q = w4 >> 1, part = w4 & 1, ht = tid & 255;
    LAS unsigned char* SB = lds + DH_SMALL + hb * DH_STRIDE;
    LAS float* SC = (LAS float*)(lds + hb * 65536);
    LAS unsigned* HIST = (LAS unsigned*)(SB + DH_HIST); LAS int* IDX = (LAS int*)(SB + DH_IDX); LAS float* QV = (LAS float*)(SB + DH_QV); LAS float* PR = (LAS float*)(SB + DH_PR);
    LAS unsigned* SEL = (LAS unsigned*)(SB + DH_SEL); LAS float* BT = (LAS float*)(lds + DH_BT);
    LAS unsigned* CAND = (LAS unsigned*)PR; LAS unsigned* CANDI = CAND + 512; LAS unsigned* HISTB = CAND + 1024;
    LAS unsigned* BARC = (LAS unsigned*)(lds + DH_BAR) + hb; volatile LAS int* SLOT = (volatile LAS int*)(lds + DH_BAR) + 4 + hb;
    const bf16* P = (const bf16*)(a.ws + WS_R + R_P);
    const bf16* KB = (const bf16*)(a.ws + WS_MG + MI_K); const bf16* VB = (const bf16*)(a.ws + WS_MG + MI_V); const bf16* KI = (const bf16*)(a.ws + WS_MG + MI_KI);
    constexpr int NQ2 = M / 2;
    unsigned bt = 0u;
#ifdef DSA_ONEHALF
    if (hb == DSA_ONEHALF - 1) return;
#endif
    int nxt = 0; if (ht == 0) nxt = (int)__hip_atomic_fetch_add(qctr, 1u, __ATOMIC_RELAXED, __HIP_MEMORY_SCOPE_AGENT);
    for (;;) {
        if (ht == 0) { SLOT[0] = nxt; nxt = (int)__hip_atomic_fetch_add(qctr, 1u, __ATOMIC_RELAXED, __HIP_MEMORY_SCOPE_AGENT); }
        half_bar(BARC, bt, lane);
        const int kq_ = SLOT[0];
        if (kq_ >= NQ2) break;
        const int b = kq_ & 3, t0 = 2 * (T / 2 - 1 - (kq_ >> 2)), m0 = b * T + t0;
        for (int i = ht; i < 512; i += 256) { const int qq = i >> 8, cc = i & 255; QV[i] = bf2f(P[(size_t)(m0 + qq) * PW + C_DSA + cc]) * 0.125f; }
        if (t0 < 256) {
            for (int i = ht; i < 512; i += 256) IDX[i] = i & 255;
        } else {
            for (int i = ht; i < 512; i += 256) HISTB[i] = 0u;
            { const int r16 = lane & 15, g = lane >> 4, qa = r16 >> 3, ha = r16 & 7;
              const bf16x8 af = *(const GAS bf16x8*)(P + (size_t)(m0 + qa) * PW + C_DSA + 384 + ha * 32 + 8 * g);
              const int qg = g >> 1;
              float wq[4];
#pragma unroll
              for (int i = 0; i < 4; ++i) wq[i] = bf2f(P[(size_t)(m0 + qg) * PW + C_DSA + 672 + 4 * (g & 1) + i]) * 0.0625f;
              const int ntile = (t0 + 2 - 16 + 15) >> 4;
              const GAS bf16* kbase = (const GAS bf16*)KI + (size_t)(b * T + 16 + r16) * 32 + 8 * g;
              for (int kt = w4; kt < ntile; kt += 16) {
                  bf16x8 bf[4];
#pragma unroll
                  for (int u = 0; u < 4; ++u) { const int k2 = kt + 4 * u < ntile ? kt + 4 * u : kt; bf[u] = *(const GAS bf16x8*)(kbase + (size_t)k2 * 512); }
#pragma unroll
                  for (int u = 0; u < 4; ++u) { if (kt + 4 * u >= ntile) break;
                      const int s = 16 + 16 * (kt + 4 * u) + r16;
                      f32x4 acc = (f32x4){0.f, 0.f, 0.f, 0.f};
                      acc = __builtin_amdgcn_mfma_f32_16x16x32_bf16(af, bf[u], acc, 0, 0, 0);
                      float p = wq[0] * fmaxf(acc[0], 0.f) + wq[1] * fmaxf(acc[1], 0.f) + wq[2] * fmaxf(acc[2], 0.f) + wq[3] * fmaxf(acc[3], 0.f);
                      p += __shfl_xor(p, 16);
                      if ((g & 1) == 0) { const bool ok = s <= t0 + qg; SC[qg * 8192 + (s - 16)] = ok ? p : -INFINITY;
                          if (ok) __hip_atomic_fetch_add(&HIST[qg * 256 + (f2key(p) >> 24)], 1u, __ATOMIC_RELAXED, __HIP_MEMORY_SCOPE_WORKGROUP); } }
              } }
        }
        half_bar(BARC, bt, lane);
        if (t0 >= 256) {
            const int n = t0 + q - 15, n4 = (n + 3) >> 2;
            unsigned rem = 240u;
            unsigned prefix = dsa_find_bin(HIST + q * 256, rem, 0u, 24, lane);
            for (int g = part * 64 + lane; g < n4; g += 128) { const f32x4 v = *(const LAS f32x4*)(SC + q * 8192 + 4 * g);
#pragma unroll
                for (int e = 0; e < 4; ++e) { const unsigned key = f2key(v[e]); if (4 * g + e < n && (key & 0xff000000u) == prefix) __hip_atomic_fetch_add(&HISTB[q * 256 + ((key >> 16) & 255u)], 1u, __ATOMIC_RELAXED, __HIP_MEMORY_SCOPE_WORKGROUP); } }
            half_bar(BARC, bt, lane);
            prefix = dsa_find_bin(HISTB + q * 256, rem, prefix, 16, lane);
            const int D = 240 - (int)rem;
            { const int gh = (n4 + 1) >> 1, gbeg = part * gh, gend = (gbeg + gh < n4) ? gbeg + gh : n4;
              int cnt = 0; const unsigned long long below = (1ull << lane) - 1ull;
              if (part == 0 && lane < 16) IDX[q * 256 + lane] = lane;
              for (int g0 = gbeg; g0 < gend; g0 += 64) { const int g = g0 + lane; const bool gv = g < gend;
                  f32x4 v = (f32x4){0.f, 0.f, 0.f, 0.f}; if (gv) v = *(const LAS f32x4*)(SC + q * 8192 + 4 * g);
                  unsigned key[4]; bool gt[4], eq[4];
#pragma unroll
                  for (int e = 0; e < 4; ++e) { key[e] = f2key(v[e]); const unsigned k16 = key[e] & 0xffff0000u; const bool ok = gv && (4 * g + e < n); gt[e] = ok && k16 > prefix; eq[e] = ok && k16 == prefix; }
                  const unsigned long long m0_ = __ballot(gt[0]), m1_ = __ballot(gt[1]), m2_ = __ballot(gt[2]), m3_ = __ballot(gt[3]);
                  int run = cnt + __popcll(m0_ & below) + __popcll(m1_ & below) + __popcll(m2_ & below) + __popcll(m3_ & below);
#pragma unroll
                  for (int e = 0; e < 4; ++e) if (gt[e]) { int pos = part == 0 ? 16 + run : 16 + D - 1 - run; pos = pos < 16 ? 16 : (pos > 255 ? 255 : pos); IDX[q * 256 + pos] = 16 + 4 * g + e; ++run; }
                  cnt += __popcll(m0_) + __popcll(m1_) + __popcll(m2_) + __popcll(m3_);
#pragma unroll
                  for (int e = 0; e < 4; ++e) if (eq[e]) { const unsigned pp = __hip_atomic_fetch_add(&SEL[q * 4 + 3], 1u, __ATOMIC_RELAXED, __HIP_MEMORY_SCOPE_WORKGROUP); if (pp < 256u) { CAND[q * 256 + pp] = key[e]; CANDI[q * 256 + pp] = 16u + 4u * g + e; } }
              } }
            half_bar(BARC, bt, lane);
            const bool ovf = SEL[3] > 256u || SEL[7] > 256u;
            if (!ovf) {
                const unsigned nc = SEL[q * 4 + 3];
                for (unsigned ci = lane; ci < nc; ci += 64) { const unsigned kv = CAND[q * 256 + ci], iv = CANDI[q * 256 + ci]; unsigned rank = 0u;
                    for (unsigned cj = 0; cj < nc; ++cj) { const unsigned ko = CAND[q * 256 + cj], io = CANDI[q * 256 + cj]; rank += (ko > kv || (ko == kv && io < iv)) ? 1u : 0u; }
                    if (rank < rem) IDX[q * 256 + 16 + D + (int)rank] = (int)iv; }
            } else {
                unsigned mask = 0xffff0000u;
                for (int pass = 2; pass < 4; ++pass) { const int shift = 24 - 8 * pass;
                    half_bar(BARC, bt, lane);
                    for (int i = ht; i < 512; i += 256) HISTB[i] = 0u;
                    half_bar(BARC, bt, lane);
                    for (int i = part * 64 + lane; i < n; i += 128) { const unsigned key = f2key(SC[q * 8192 + i]); if ((key & mask) == prefix) __hip_atomic_fetch_add(&HISTB[q * 256 + ((key >> shift) & 255u)], 1u, __ATOMIC_RELAXED, __HIP_MEMORY_SCOPE_WORKGROUP); }
                    half_bar(BARC, bt, lane);
                    prefix = dsa_find_bin(HISTB + q * 256, rem, prefix, shift, lane); mask |= 255u << shift; }
                half_bar(BARC, bt, lane);
                if (part == 0) { const unsigned thr = prefix;
                    if (lane < 16) IDX[q * 256 + lane] = lane;
                    int base = 16; unsigned eqtaken = 0u; const unsigned long long below = (1ull << lane) - 1ull;
                    for (int i0 = 0; i0 < n; i0 += 64) { const int i = i0 + lane; const bool valid = i < n;
                        const unsigned key = valid ? f2key(SC[q * 8192 + i]) : 0u; const bool gt = valid && key > thr, eq = valid && key == thr;
                        const unsigned long long eqm = __ballot(eq);
                        const bool sel = gt || (eq && (eqtaken + (unsigned)__popcll(eqm & below)) < rem);
                        const unsigned long long sm = __ballot(sel);
                        if (sel) { const int pos = base + __popcll(sm & below); if (pos < 256) IDX[q * 256 + pos] = 16 + i; }
                        base += __popcll(sm); eqtaken += (unsigned)__popcll(eqm); } }
                half_bar(BARC, bt, lane);
            }
            for (int i = ht; i < 512; i += 256) HIST[i] = 0u;
        }
        { const int hp = part, t = t0 + q; const int L = t0 < 256 ? t + 1 : 256;
          LAS unsigned char* KS = (LAS unsigned char*)SC + q * 32768;
          const GAS v4u* KG = (const GAS v4u*)KB; const GAS v4u* VG = (const GAS v4u*)VB;
          if (t0 < 256) half_bar(BARC, bt, lane);
          v4u gv[16];
#define DSA_LOAD(SRC) do { _Pragma("unroll") for (int i = 0; i < 16; ++i) { const int p = lane + 64 * i, row = hp * 128 + (p >> 3), part_ = p & 7; \
              gv[i] = (v4u){0u, 0u, 0u, 0u}; if (row < L) gv[i] = (SRC)[(size_t)(b * T + IDX[q * 256 + row]) * 8 + part_]; } } while (0)
#define DSA_PUT() do { _Pragma("unroll") for (int i = 0; i < 16; ++i) { const int p = lane + 64 * i, row = hp * 128 + (p >> 3), part_ = p & 7; \
              *(LAS v4u*)(KS + row * 128 + ((part_ ^ ((row >> 1) & 7)) << 4)) = gv[i]; } } while (0)
          DSA_LOAD(KG); DSA_PUT();
          half_bar(BARC, bt, lane);
          if (ht < 2) SEL[ht * 4 + 3] = 0u;
          float lg0[4], lg1[4];
#pragma unroll
          for (int r = 0; r < 4; ++r) { const int jj = lane + 64 * r; lg0[r] = -INFINITY; lg1[r] = -INFINITY;
              if (jj < L) { const int idx = IDX[q * 256 + jj];
                  float d0 = 0.f, d1 = 0.f;
#pragma unroll 2
                  for (int dc = 0; dc < 8; ++dc) { const v4u kv = *(const LAS v4u*)(KS + jj * 128 + ((dc ^ ((jj >> 1) & 7)) << 4));
                      const LAS float* q0 = QV + q * 256 + (2 * hp) * 64 + 8 * dc; const LAS float* q1 = q0 + 64;
                      const f32x4 qa = *(const LAS f32x4*)q0, qb = *(const LAS f32x4*)(q0 + 4), qc = *(const LAS f32x4*)q1, qd = *(const LAS f32x4*)(q1 + 4);
                      const float k0 = bflo(kv.x), k1 = bfhi(kv.x), k2 = bflo(kv.y), k3 = bfhi(kv.y), k4 = bflo(kv.z), k5 = bfhi(kv.z), k6 = bflo(kv.w), k7 = bfhi(kv.w);
                      d0 += (k0 * qa.x + k1 * qa.y) + (k2 * qa.z + k3 * qa.w) + (k4 * qb.x + k5 * qb.y) + (k6 * qb.z + k7 * qb.w);
                      d1 += (k0 * qc.x + k1 * qc.y) + (k2 * qc.z + k3 * qc.w) + (k4 * qd.x + k5 * qd.y) + (k6 * qd.z + k7 * qd.w); }
                  int dist = t - idx; dist = dist > 128 ? 128 : dist;
                  lg0[r] = d0 + BT[dist * 4 + 2 * hp]; lg1[r] = d1 + BT[dist * 4 + 2 * hp + 1]; }
              asm volatile("" ::: "memory"); }
          const float m0x = wave_max(fmaxf(fmaxf(lg0[0], lg0[1]), fmaxf(lg0[2], lg0[3]))), m1x = wave_max(fmaxf(fmaxf(lg1[0], lg1[1]), fmaxf(lg1[2], lg1[3])));
          float e0[4], e1[4], s0 = 0.f, s1 = 0.f;
#pragma unroll
          for (int r = 0; r < 4; ++r) { e0[r] = __expf(lg0[r] - m0x); e1[r] = __expf(lg1[r] - m1x); s0 += e0[r]; s1 += e1[r]; }
          DSA_LOAD(VG);
          const float i0 = 1.0f / wave_sum(s0), i1 = 1.0f / wave_sum(s1);
          half_bar(BARC, bt, lane);
#pragma unroll
          for (int r = 0; r < 4; ++r) { const int jj = lane + 64 * r; PR[(q * 4 + 2 * hp) * 256 + jj] = e0[r] * i0; PR[(q * 4 + 2 * hp + 1) * 256 + jj] = e1[r] * i1; }
          DSA_PUT();
          half_bar(BARC, bt, lane);
#undef DSA_LOAD
#undef DSA_PUT
          { const LAS float* p0 = PR + (q * 4 + 2 * hp) * 256; const LAS float* p1 = p0 + 256;
            const int rg = lane >> 3, dp = lane & 7;
            float o0[8], o1[8];
#pragma unroll
            for (int e = 0; e < 8; ++e) { o0[e] = 0.f; o1[e] = 0.f; }
#pragma unroll 4
            for (int jb = 0; jb < 256; jb += 8) { const int row = jb + rg; const v4u kv = *(const LAS v4u*)(KS + row * 128 + ((dp ^ ((row >> 1) & 7)) << 4)); const float pa = p0[row], pb = p1[row];
                const float v0 = bflo(kv.x), v1 = bfhi(kv.x), v2 = bflo(kv.y), v3 = bfhi(kv.y), v4 = bflo(kv.z), v5 = bfhi(kv.z), v6 = bflo(kv.w), v7 = bfhi(kv.w);
                o0[0] += pa * v0; o0[1] += pa * v1; o0[2] += pa * v2; o0[3] += pa * v3; o0[4] += pa * v4; o0[5] += pa * v5; o0[6] += pa * v6; o0[7] += pa * v7;
                o1[0] += pb * v0; o1[1] += pb * v1; o1[2] += pb * v2; o1[3] += pb * v3; o1[4] += pb * v4; o1[5] += pb * v5; o1[6] += pb * v6; o1[7] += pb * v7; }
#pragma unroll
            for (int e = 0; e < 8; ++e) { o0[e] += dppf<0x128>(o0[e]); o1[e] += dppf<0x128>(o1[e]);
                o0[e] += __shfl_xor(o0[e], 16); o1[e] += __shfl_xor(o1[e], 16); o0[e] += __shfl_xor(o0[e], 32); o1[e] += __shfl_xor(o1[e], 32); }
            if (rg == 0) { bf16* Y = (bf16*)(a.ws + WS_Y) + (size_t)2 * MP * 256 + (size_t)(m0 + q) * 256;
                *(GAS v4u*)(Y + (2 * hp) * 64 + 8 * dp) = (v4u){pk2(o0[0], o0[1]), pk2(o0[2], o0[3]), pk2(o0[4], o0[5]), pk2(o0[6], o0[7])};
                *(GAS v4u*)(Y + (2 * hp + 1) * 64 + 8 * dp) = (v4u){pk2(o1[0], o1[1]), pk2(o1[2], o1[3]), pk2(o1[4], o1[5]), pk2(o1[6], o1[7])}; } }
        }
    }
}

namespace pg8 {
template <int ACT  > struct EpiStoreBf16 {
    static constexpr bool PERM = true, AFTER_DRAIN = false;
    bf16_t* O; int ldc;
    __device__ __forceinline__ void operator()(const f32x4 (&acc)[2][2][4][2], const Unit& u, int wr, int wc, int fr, int fq) const {
        const int row0 = u.pm * BM + wr * 64 + fr, col0 = u.pn * BM + wc * 32 + 8 * fq;
#pragma unroll
        for (int ai = 0; ai < 2; ++ai)
#pragma unroll
            for (int m = 0; m < 4; ++m) { bf16_t* rowp = O + (size_t)(row0 + ai * HALF + m * 16) * ldc + col0;
#pragma unroll
                for (int bj = 0; bj < 2; ++bj) { f32x4 v0 = acc[ai][bj][m][0], v1 = acc[ai][bj][m][1];
                    if (ACT == 1) {
#pragma unroll
                        for (int j = 0; j < 4; ++j) { v0[j] = __builtin_amdgcn_rcpf(1.0f + __expf(-v0[j])); v1[j] = __builtin_amdgcn_rcpf(1.0f + __expf(-v1[j])); } }
                    u32x4 w; w.x = cvt_pk_bf16(v0[0], v0[1]); w.y = cvt_pk_bf16(v0[2], v0[3]); w.z = cvt_pk_bf16(v1[0], v1[1]); w.w = cvt_pk_bf16(v1[2], v1[3]);
                    *(u32x4*)(rowp + bj * HALF) = w; } }
    }
};
struct EpiGateU8 {
    static constexpr bool PERM = true, AFTER_DRAIN = false;
    unsigned char* O; int ldc;
    __device__ __forceinline__ void operator()(const f32x4 (&acc)[2][2][4][2], const Unit& u, int wr, int wc, int fr, int fq) const {
        unsigned char* tp_ = O + ((size_t)(u.pm * 16 + u.pn) << 16) + ((wr * 4 + wc) << 9) + ((fq * 16 + fr) << 3);
#pragma unroll
        for (int ai = 0; ai < 2; ++ai)
#pragma unroll
            for (int m = 0; m < 4; ++m) {
#pragma unroll
                for (int bj = 0; bj < 2; ++bj) { const f32x4 v0 = acc[ai][bj][m][0], v1 = acc[ai][bj][m][1]; unsigned q0[4], q1[4];
#pragma unroll
                    for (int j = 0; j < 4; ++j) { q0[j] = (unsigned)(__builtin_amdgcn_rcpf(fmaf(__expf(-v0[j]), 1.0f / 255.0f, 1.0f / 255.0f)) + 0.5f); q1[j] = (unsigned)(__builtin_amdgcn_rcpf(fmaf(__expf(-v1[j]), 1.0f / 255.0f, 1.0f / 255.0f)) + 0.5f);        }
                    *(uint2*)(tp_ + ((((ai * 4 + m) * 2 + bj)) << 12)) = make_uint2(q0[0] | (q0[1] << 8) | (q0[2] << 16) | (q0[3] << 24), q1[0] | (q1[1] << 8) | (q1[2] << 16) | (q1[3] << 24)); } }
    }
};
__device__ __forceinline__ float bf_lo(unsigned w) { return __builtin_bit_cast(float, w << 16); }
__device__ __forceinline__ float bf_hi(unsigned w) { return __builtin_bit_cast(float, w & 0xffff0000u); }
struct EpiMerge {
    static constexpr bool PERM = true, AFTER_DRAIN = false;
    const unsigned char* G; bf16_t* MG; unsigned char* MGP;
    __device__ __forceinline__ void operator()(const f32x4 (&acc)[2][2][4][2], const Unit& u, int wr, int wc, int fr, int fq) const {
        const int br = u.x0, row0 = u.x1 * BM + wr * 64 + fr, col0 = (u.pn & 3) * BM + wc * 32 + 8 * fq;
        const unsigned char* gt_ = G + ((size_t)(u.x1 * 16 + u.pn) << 16) + ((wr * 4 + wc) << 9) + ((fq * 16 + fr) << 3);
        unsigned char* pt_ = MGP + ((size_t)(u.x1 * 4 + (u.pn & 3)) << 17) + ((wr * 4 + wc) << 10) + ((fq * 16 + fr) << 4);
        uint2 g[2][4][2];
#pragma unroll
        for (int ai = 0; ai < 2; ++ai)
#pragma unroll
            for (int m = 0; m < 4; ++m)
#pragma unroll
                for (int bj = 0; bj < 2; ++bj) g[ai][m][bj] = *(const uint2*)(gt_ + (((ai * 4 + m) * 2 + bj) << 12));
#pragma unroll
        for (int ai = 0; ai < 2; ++ai) {
            u32x4 o[4][2];
#pragma unroll
            for (int m = 0; m < 4; ++m)
#pragma unroll
                for (int bj = 0; bj < 2; ++bj) { const size_t r = (size_t)(row0 + ai * HALF + m * 16);
                    o[m][bj] = (u32x4){0u, 0u, 0u, 0u};
                    if (br > 0) o[m][bj] = __builtin_nontemporal_load((const u32x4*)(pt_ + (((ai * 4 + m) * 2 + bj) << 13))); (void)r; }
#pragma unroll
            for (int m = 0; m < 4; ++m)
#pragma unroll
                for (int bj = 0; bj < 2; ++bj) { const size_t r = (size_t)(row0 + ai * HALF + m * 16);
                    f32x4 v0 = acc[ai][bj][m][0] * (1.0f / 255.0f), v1 = acc[ai][bj][m][1] * (1.0f / 255.0f); const uint2 gg = g[ai][m][bj]; const u32x4 oo = o[m][bj];
                    v0[0] = v0[0] * (float)(gg.x & 255u) + bf_lo(oo.x); v0[1] = v0[1] * (float)((gg.x >> 8) & 255u) + bf_hi(oo.x); v0[2] = v0[2] * (float)((gg.x >> 16) & 255u) + bf_lo(oo.y); v0[3] = v0[3] * (float)(gg.x >> 24) + bf_hi(oo.y);
                    v1[0] = v1[0] * (float)(gg.y & 255u) + bf_lo(oo.z); v1[1] = v1[1] * (float)((gg.y >> 8) & 255u) + bf_hi(oo.z); v1[2] = v1[2] * (float)((gg.y >> 16) & 255u) + bf_lo(oo.w); v1[3] = v1[3] * (float)(gg.y >> 24) + bf_hi(oo.w);
                    u32x4 w; w.x = cvt_pk_bf16(v0[0], v0[1]); w.y = cvt_pk_bf16(v0[2], v0[3]); w.z = cvt_pk_bf16(v1[0], v1[1]); w.w = cvt_pk_bf16(v1[2], v1[3]);
                    if (br == 3) *(u32x4*)((unsigned char*)MG + ((size_t)((u.x1 * 16 + (u.pn & 3) * 4 + bj * 2 + (wc >> 1)) * 2 + ai) << 14) + lds_byte(wr * 64 + m * 16 + fr, (wc & 1) * 32 + 8 * fq)) = w;        else *(u32x4*)(pt_ + (((ai * 4 + m) * 2 + bj) << 13)) = w; }
            asm volatile("" ::: "memory"); }
    }
};
struct EpiResid {
    static constexpr bool PERM = true, AFTER_DRAIN = false;
    const bf16_t* H; bf16_t* X1; float alpha;
    __device__ __forceinline__ void operator()(const f32x4 (&acc)[2][2][4][2], const Unit& u, int wr, int wc, int fr, int fq) const {
        const int row0 = u.pm * BM + wr * 64 + fr, col0 = u.pn * BM + wc * 32 + 8 * fq;
#pragma unroll
        for (int ai = 0; ai < 2; ++ai) {
            u32x4 hv[4][2];
#pragma unroll
            for (int m = 0; m < 4; ++m)
#pragma unroll
                for (int bj = 0; bj < 2; ++bj) hv[m][bj] = *(const u32x4*)(H + (size_t)(row0 + ai * HALF + m * 16) * 1024 + col0 + bj * HALF);
#pragma unroll
            for (int m = 0; m < 4; ++m)
#pragma unroll
                for (int bj = 0; bj < 2; ++bj) { const size_t off = (size_t)(row0 + ai * HALF + m * 16) * 1024 + col0 + bj * HALF; const u32x4 h4 = hv[m][bj];
                    f32x4 o0 = acc[ai][bj][m][0], o1 = acc[ai][bj][m][1];
                    o0[0] += alpha * bf_lo(h4.x); o0[1] += alpha * bf_hi(h4.x); o0[2] += alpha * bf_lo(h4.y); o0[3] += alpha * bf_hi(h4.y);
                    o1[0] += alpha * bf_lo(h4.z); o1[1] += alpha * bf_hi(h4.z); o1[2] += alpha * bf_lo(h4.w); o1[3] += alpha * bf_hi(h4.w);
                    u32x4 w; w.x = cvt_pk_bf16(o0[0], o0[1]); w.y = cvt_pk_bf16(o0[2], o0[3]); w.z = cvt_pk_bf16(o1[0], o1[1]); w.w = cvt_pk_bf16(o1[2], o1[3]);
                    *(u32x4*)(X1 + off) = w; }
            asm volatile("" ::: "memory"); }
    }
};
struct EpiSwiglu {
    static constexpr bool PERM = true, AFTER_DRAIN = false;
    bf16_t* HID;
    __device__ __forceinline__ void operator()(const f32x4 (&acc)[2][2][4][2], const Unit& u, int wr, int wc, int fr, int fq) const {
        const int row0 = u.pm * BM + wr * 64 + fr, col0 = u.x0 * 128 + wc * 32 + 8 * fq;
#pragma unroll
        for (int ai = 0; ai < 2; ++ai)
#pragma unroll
            for (int m = 0; m < 4; ++m) { f32x4 v0, v1;
#pragma unroll
                for (int j = 0; j < 4; ++j) { const float g0 = acc[ai][0][m][0][j], g1 = acc[ai][0][m][1][j];
                    v0[j] = g0 * __builtin_amdgcn_rcpf(1.0f + __expf(-g0)) * acc[ai][1][m][0][j]; v1[j] = g1 * __builtin_amdgcn_rcpf(1.0f + __expf(-g1)) * acc[ai][1][m][1][j]; }
                u32x4 w; w.x = cvt_pk_bf16(v0[0], v0[1]); w.y = cvt_pk_bf16(v0[2], v0[3]); w.z = cvt_pk_bf16(v1[0], v1[1]); w.w = cvt_pk_bf16(v1[2], v1[3]);
                *(u32x4*)((unsigned char*)HID + ((size_t)((u.pm * 4 + 2 * u.x0 + (wc >> 1)) * 2 + ai) << 14) + lds_byte(wr * 64 + m * 16 + fr, (wc & 1) * 32 + 8 * fq)) = w; }
    }
};
struct EpiDown {
    static constexpr bool PERM = true, AFTER_DRAIN = false;
    const int* ROWTOK; const float* ROWW; bf16_t* O2; size_t slot_stride;
    __device__ __forceinline__ void operator()(const f32x4 (&acc)[2][2][4][2], const Unit& u, int wr, int wc, int fr, int fq) const {
        const int row0 = u.pm * BM + wr * 64 + fr, col0 = u.x0 * BM + wc * 32 + 8 * fq;
        int tkv[2][4]; float wgv[2][4];
#pragma unroll
        for (int ai = 0; ai < 2; ++ai)
#pragma unroll
            for (int m = 0; m < 4; ++m) { const int rl = wr * 64 + fr + ai * HALF + m * 16, ix = u.rb + (rl < u.nv ? rl : 0); tkv[ai][m] = ROWTOK[ix]; wgv[ai][m] = ROWW[ix]; }
#pragma unroll
        for (int ai = 0; ai < 2; ++ai)
#pragma unroll
            for (int m = 0; m < 4; ++m) { const int rl = wr * 64 + fr + ai * HALF + m * 16;
                if (rl < u.nv) { const int tk = tkv[ai][m]; const float wgt = wgv[ai][m]; bf16_t* dst = O2 + (size_t)(tk & 1) * slot_stride + (size_t)(tk >> 1) * 1024 + col0;
#pragma unroll
                    for (int bj = 0; bj < 2; ++bj) { const f32x4 v0 = acc[ai][bj][m][0] * wgt, v1 = acc[ai][bj][m][1] * wgt;
                        u32x4 w; w.x = cvt_pk_bf16(v0[0], v0[1]); w.y = cvt_pk_bf16(v0[2], v0[3]); w.z = cvt_pk_bf16(v1[0], v1[1]); w.w = cvt_pk_bf16(v1[2], v1[3]);
                        *(u32x4*)(dst + bj * HALF) = w; } } }
    }
};
struct OrderMerge {
    int G, c;
    __device__ bool next(int i, Unit& u) const { const int tile = (i >> 2) * G + c; if (tile >= 128 * 4) return false; const int br = i & 3, pm = tile >> 2, pn = tile & 3;
        u.pm = br * 129 + pm; u.pn = br * 4 + pn; u.x0 = br; u.x1 = pm; return true; }
    __device__ __forceinline__ void a_ready(const Unit&) const {}
    __device__ __forceinline__ void done(const Unit&) const {}
};
struct OrderGatesF {
    StaticOrder base;
    __device__ bool next(int i, Unit& u) const { Unit t; if (!base.next(i >> 2, t)) return false; const int br = i & 3; u.pm = t.pm; u.pn = br * 4 + t.pn; u.x0 = br; u.x1 = t.pm; return true; }
    __device__ __forceinline__ void a_ready(const Unit&) const {}
    __device__ __forceinline__ void done(const Unit&) const {}
};
struct OrderMergeF {
    StaticOrder base;
    __device__ bool next(int i, Unit& u) const { Unit t; if (!base.next(i >> 2, t)) return false; const int br = i & 3; u.pm = br * 129 + t.pm; u.pn = br * 4 + t.pn; u.x0 = br; u.x1 = t.pm; return true; }
    __device__ __forceinline__ void a_ready(const Unit&) const {}
    __device__ __forceinline__ void done(const Unit&) const {}
};
struct OrderExpert {
    int G, c, nsub, ntiles; const PG8_LAS int* offs;
    __device__ bool next(int i, Unit& u) const { const int L = i * G + c; if (L >= ntiles * nsub) return false; const int tile = L / nsub, sub = L % nsub;
        int e = 0;
#pragma unroll
        for (int k = 1; k < 16; ++k) e += (offs[k] <= tile) ? 1 : 0;
        e = __builtin_amdgcn_readfirstlane(e); u.pm = tile; u.pn = e * nsub + sub; u.x0 = sub; u.x1 = e;
        const int j = tile - offs[e]; u.rb = e * XCAP + j * 256; u.nv = offs[48 + e] - j * 256; return true; }
    __device__ __forceinline__ void a_ready(const Unit&) const {}
    __device__ __forceinline__ void done(const Unit&) const {}
};
}

__device__ __forceinline__ f32x4 skinny_tile_aimg(const unsigned char* Aimg, int m0, const bf16* Wimg, int w0, int K, int lane) {
    const GAS unsigned char* ap = (const GAS unsigned char*)Aimg; const GAS unsigned char* wp = (const GAS unsigned char*)Wimg;
    const int w = w0 + (lane & 15), m = m0 + (lane & 15);
    f32x4 acc = (f32x4){0.f, 0.f, 0.f, 0.f};
    for (int k = 0; k < K; k += 128) {
        bf16x8 af[4], bf[4];
#pragma unroll
        for (int u = 0; u < 4; ++u) { const int kk = k + 32 * u + 8 * (lane >> 4); af[u] = *(const GAS bf16x8*)(ap + pg8::aimg_off(m, kk, K)); bf[u] = *(const GAS bf16x8*)(wp + pg8::wimg_off(w, kk, K)); }
#pragma unroll
        for (int u = 0; u < 4; ++u) acc = __builtin_amdgcn_mfma_f32_16x16x32_bf16(af[u], bf[u], acc, 0, 0, 0);
    }
    return acc;
}
__device__ __forceinline__ f32x4 skinny_tile(const bf16* A, int lda, const bf16* Wimg, int w0, int K, int lane) {
    const GAS bf16* ap = (const GAS bf16*)A + (size_t)(lane & 15) * lda + 8 * (lane >> 4);
    const GAS unsigned char* wp = (const GAS unsigned char*)Wimg;
    const int w = w0 + (lane & 15);
    f32x4 acc = (f32x4){0.f, 0.f, 0.f, 0.f};
    for (int k = 0; k < K; k += 128) {
        bf16x8 af[4], bf[4];
#pragma unroll
        for (int u = 0; u < 4; ++u) { af[u] = *(const GAS bf16x8*)(ap + k + 32 * u); bf[u] = *(const GAS bf16x8*)(wp + pg8::wimg_off(w, k + 32 * u + 8 * (lane >> 4), K)); }
#pragma unroll
        for (int u = 0; u < 4; ++u) acc = __builtin_amdgcn_mfma_f32_16x16x32_bf16(af[u], bf[u], acc, 0, 0, 0);
    }
    return acc;
}
constexpr int TAIL0 = 32768;
__device__ __forceinline__ void tail_inproj(CArgs& a, int gw, int ngw, int lane) {
    const bf16* HB = (const bf16*)(a.ws + WS_HB); const bf16* W = (const bf16*)(a.ws + WS_W + W_IN); bf16* P = (bf16*)(a.ws + WS_R + R_P);
    for (int tk = gw; tk < 4 * (PW / 16); tk += ngw) { const int rg = tk & 3, ct = tk >> 2;
        const f32x4 acc = skinny_tile(HB + (size_t)(TAIL0 + 16 * rg) * D, D, W, 16 * ct, D, lane);
#pragma unroll
        for (int r = 0; r < 4; ++r) P[(size_t)(TAIL0 + 16 * rg + 4 * (lane >> 4) + r) * PW + 16 * ct + (lane & 15)] = (bf16)f2bf(acc[r]); }
}
__device__ __forceinline__ void tail_gates(CArgs& a, int gw, int ngw, int lane) {
    const bf16* HB = (const bf16*)(a.ws + WS_HB); const bf16* W = (const bf16*)(a.ws + WS_W + W_G); unsigned char* G = a.ws + WS_R + R_G;
    for (int tk = gw; tk < 4 * 256; tk += ngw) { const int rg = tk & 3, ct = tk >> 2;
        const f32x4 acc = skinny_tile(HB + (size_t)(TAIL0 + 16 * rg) * D, D, W, 16 * ct, D, lane);
#pragma unroll
        for (int r = 0; r < 4; ++r) G[(size_t)(TAIL0 + 16 * rg + 4 * (lane >> 4) + r) * 4096 + 16 * ct + (lane & 15)] = (unsigned char)(unsigned)(255.0f / (1.0f + __expf(-acc[r])) + 0.5f); }
}
__device__ __forceinline__ void tail_merge(CArgs& a, int gw, int ngw, int lane) {
    const bf16* Y = (const bf16*)(a.ws + WS_Y); const bf16* W = (const bf16*)(a.ws + WS_W + W_B); const unsigned char* G = a.ws + WS_R + R_G; bf16* MG = (bf16*)(a.ws + WS_MG);
    for (int tk = gw; tk < 4 * 64; tk += ngw) { const int rg = tk & 3, ct = tk >> 2; float m[4] = {0.f, 0.f, 0.f, 0.f};
#pragma unroll
        for (int br = 0; br < 4; ++br) { const f32x4 acc = skinny_tile_aimg((const unsigned char*)Y + (size_t)br * MP * 512, TAIL0 + 16 * rg, W, br * D + 16 * ct, 256, lane);
#pragma unroll
            for (int r = 0; r < 4; ++r) m[r] += acc[r] * ((float)G[(size_t)(TAIL0 + 16 * rg + 4 * (lane >> 4) + r) * 4096 + br * 1024 + 16 * ct + (lane & 15)] * (1.0f / 255.0f)); }
#pragma unroll
        for (int r = 0; r < 4; ++r) MG[(size_t)(TAIL0 + 16 * rg + 4 * (lane >> 4) + r) * D + 16 * ct + (lane & 15)] = (bf16)f2bf(m[r]); }
}
__device__ __forceinline__ void tail_outproj(CArgs& a, int gw, int ngw, int lane) {
    const bf16* MG = (const bf16*)(a.ws + WS_MG); const bf16* W = (const bf16*)(a.ws + WS_W + W_O); const bf16* HB = (const bf16*)(a.ws + WS_HB); bf16* X1 = (bf16*)(a.ws + WS_R + R_X1);
    for (int tk = gw; tk < 4 * 64; tk += ngw) { const int rg = tk & 3, ct = tk >> 2;
        const f32x4 acc = skinny_tile(MG + (size_t)(TAIL0 + 16 * rg) * D, D, W, 16 * ct, D, lane);
#pragma unroll
        for (int r = 0; r < 4; ++r) { const size_t o = (size_t)(TAIL0 + 16 * rg + 4 * (lane >> 4) + r) * D + 16 * ct + (lane & 15); X1[o] = (bf16)f2bf(DN_ALPHA * bf2f(HB[o]) + acc[r]); } }
}
__device__ __forceinline__ void route_row(const float (&lg)[20], const float* bg, const float* br, LAS int* REC, LAS float* RECW, LAS int* LCNT, int lr) {
    const float q0 = lg[0] + bg[0], q1 = lg[1] + bg[1], q2 = lg[2] + bg[2], q3 = lg[3] + bg[3];
    int gs = 0; float gm = q0; if (q1 > gm) { gm = q1; gs = 1; } if (q2 > gm) { gm = q2; gs = 2; } if (q3 > gm) { gm = q3; gs = 3; }
    const float pg = 1.0f / (expf(q0 - gm) + expf(q1 - gm) + expf(q2 - gm) + expf(q3 - gm));
    float e0 = 0.f, e1 = 0.f, e2 = 0.f, e3 = 0.f;
    if (gs == 0) { e0 = lg[4]; e1 = lg[5]; e2 = lg[6]; e3 = lg[7]; } else if (gs == 1) { e0 = lg[8]; e1 = lg[9]; e2 = lg[10]; e3 = lg[11]; }
    else if (gs == 2) { e0 = lg[12]; e1 = lg[13]; e2 = lg[14]; e3 = lg[15]; } else { e0 = lg[16]; e1 = lg[17]; e2 = lg[18]; e3 = lg[19]; }
    e0 += br[gs * 4 + 0]; e1 += br[gs * 4 + 1]; e2 += br[gs * 4 + 2]; e3 += br[gs * 4 + 3];
    int i1 = 0; float v1 = e0; if (e1 > v1) { v1 = e1; i1 = 1; } if (e2 > v1) { v1 = e2; i1 = 2; } if (e3 > v1) { v1 = e3; i1 = 3; }
    int i2 = -1; float v2 = -INFINITY;
    if (i1 != 0 && e0 > v2) { v2 = e0; i2 = 0; } if (i1 != 1 && e1 > v2) { v2 = e1; i2 = 1; } if (i1 != 2 && e2 > v2) { v2 = e2; i2 = 2; } if (i1 != 3 && e3 > v2) { v2 = e3; i2 = 3; }
    const float x2 = expf(v2 - v1), w1 = pg / (1.0f + x2), w2 = pg * x2 / (1.0f + x2);
    const int ex1 = gs * 4 + i1, ex2 = gs * 4 + i2;
    REC[lr * 4 + 0] = ex1; REC[lr * 4 + 1] = ex2;
    REC[lr * 4 + 2] = __hip_atomic_fetch_add(&LCNT[ex1], 1, __ATOMIC_RELAXED, __HIP_MEMORY_SCOPE_WORKGROUP); REC[lr * 4 + 3] = __hip_atomic_fetch_add(&LCNT[ex2], 1, __ATOMIC_RELAXED, __HIP_MEMORY_SCOPE_WORKGROUP);
    RECW[lr * 2 + 0] = w1; RECW[lr * 2 + 1] = w2;
}
__device__ __noinline__ void ln1_router_phase(CArgs& a, int l, LAS unsigned char* lds, int tid, int G, int cslot) {
    const int lane = tid & 63, wave = tid >> 6;
    constexpr int WP = 1032;
    LAS bf16* WH = (LAS bf16*)lds; LAS bf16* WL = WH + 20 * WP;
    LAS float* GC = (LAS float*)(WL + 20 * WP);
    LAS float* STAT = GC + 64;
    LAS float* LG = STAT + 2 * 160;
    LAS int* LCNT = (LAS int*)(LG + 20 * 160);
    LAS int* REC = LCNT + 64;
    LAS float* RECW = (LAS float*)(REC + 4 * 160);
    const float* wg = a.in[I_MOE_WGRP] + (size_t)l * D * 4; const float* wr_ = a.in[I_MOE_WRT] + (size_t)l * D * 16;
    const float* g1 = a.in[I_LN1G] + (size_t)l * D; const float* b1 = a.in[I_LN1B] + (size_t)l * D;
    const float* bg = a.in[I_MOE_BGRP] + l * 4; const float* br = a.in[I_MOE_BRT] + l * 16;
    {
      LAS float* PART = LG;
      float sg[20], sc[20];
#pragma unroll
      for (int k = 0; k < 20; ++k) { sg[k] = 0.f; sc[k] = 0.f; }
#pragma unroll
      for (int u = 0; u < 2; ++u) { const int c = tid + NT * u;
          const f32x4 q0 = *(const GAS f32x4*)(wg + (size_t)c * 4), q1 = *(const GAS f32x4*)(wr_ + (size_t)c * 16), q2 = *(const GAS f32x4*)(wr_ + (size_t)c * 16 + 4),
                      q3 = *(const GAS f32x4*)(wr_ + (size_t)c * 16 + 8), q4 = *(const GAS f32x4*)(wr_ + (size_t)c * 16 + 12);
          const float gc = g1[c], bc = b1[c];
          const float w0[20] = {q0.x, q0.y, q0.z, q0.w, q1.x, q1.y, q1.z, q1.w, q2.x, q2.y, q2.z, q2.w, q3.x, q3.y, q3.z, q3.w, q4.x, q4.y, q4.z, q4.w};
#pragma unroll
          for (int k = 0; k < 20; ++k) { const float w = gc * w0[k]; const unsigned hb_ = f2bf(w); const float hf = __builtin_bit_cast(float, hb_ << 16);
              WH[k * WP + c] = (bf16)hb_; WL[k * WP + c] = (bf16)f2bf(w - hf); sg[k] += w; sc[k] += bc * w0[k]; } }
#pragma unroll
      for (int k = 0; k < 20; ++k) { const float a_ = wave_sum_fast(sg[k]), b_ = wave_sum_fast(sc[k]); if (lane == 0) { PART[wave * 40 + k] = a_; PART[wave * 40 + 20 + k] = b_; } }
      __syncthreads();
      if (tid < 40) { float t_ = 0.f;
#pragma unroll
          for (int w8 = 0; w8 < 8; ++w8) t_ += PART[w8 * 40 + tid];
          GC[tid] = t_; }
    }
    if (tid < 32) LCNT[tid] = 0;
    const int rpb = (M + G - 1) / G, r_begin = blockIdx.x * rpb, r_end = min(M, r_begin + rpb);
    const bf16* X1 = (const bf16*)(a.ws + WS_R + R_X1); bf16* HB = (bf16*)(a.ws + WS_HB);
    for (int m = r_begin + wave; m < r_end; m += 2 * NWAVES) {
        const int m2 = m + NWAVES; const bool has2 = m2 < r_end;
        f32x4 va[4], vb[4];
#pragma unroll
        for (int p_ = 0; p_ < 2; ++p_) { const v4u ra = *(const v4u*)(X1 + (size_t)m * D + 8 * lane + 512 * p_); v4u rb = (v4u){0u, 0u, 0u, 0u}; if (has2) rb = *(const v4u*)(X1 + (size_t)m2 * D + 8 * lane + 512 * p_);
            va[2 * p_] = (f32x4){bflo(ra.x), bfhi(ra.x), bflo(ra.y), bfhi(ra.y)}; va[2 * p_ + 1] = (f32x4){bflo(ra.z), bfhi(ra.z), bflo(ra.w), bfhi(ra.w)};
            vb[2 * p_] = (f32x4){bflo(rb.x), bfhi(rb.x), bflo(rb.y), bfhi(rb.y)}; vb[2 * p_ + 1] = (f32x4){bflo(rb.z), bfhi(rb.z), bflo(rb.w), bfhi(rb.w)}; }
        float meana, rstda, meanb, rstdb; ln_row_stats(va, meana, rstda); ln_row_stats(vb, meanb, rstdb);
#pragma unroll
        for (int p_ = 0; p_ < 2; ++p_) { const int c0 = 8 * lane + 512 * p_; const f32x4 g0 = *(const f32x4*)(g1 + c0), g4 = *(const f32x4*)(g1 + c0 + 4), b0 = *(const f32x4*)(b1 + c0), b4 = *(const f32x4*)(b1 + c0 + 4);
            const f32x4 ya0 = (va[2 * p_] - meana) * rstda * g0 + b0, ya1 = (va[2 * p_ + 1] - meana) * rstda * g4 + b4, yb0 = (vb[2 * p_] - meanb) * rstdb * g0 + b0, yb1 = (vb[2 * p_ + 1] - meanb) * rstdb * g4 + b4;
            *(v4u*)(HB + (size_t)m * D + c0) = (v4u){pk2(ya0.x, ya0.y), pk2(ya0.z, ya0.w), pk2(ya1.x, ya1.y), pk2(ya1.z, ya1.w)};
            if (has2) *(v4u*)(HB + (size_t)m2 * D + c0) = (v4u){pk2(yb0.x, yb0.y), pk2(yb0.z, yb0.w), pk2(yb1.x, yb1.y), pk2(yb1.z, yb1.w)}; }
        if (lane == 0) { STAT[2 * (m - r_begin)] = meana; STAT[2 * (m - r_begin) + 1] = rstda; if (has2) { STAT[2 * (m2 - r_begin)] = meanb; STAT[2 * (m2 - r_begin) + 1] = rstdb; } }
    }
    __syncthreads();
    { const int nrow = r_end - r_begin, l15 = lane & 15, kq = lane >> 4;
      for (int tile = wave; tile * 16 < nrow; tile += NWAVES) {
          int rl = tile * 16 + l15; if (rl >= nrow) rl = nrow - 1;
          const GAS bf16* xr = (const GAS bf16*)X1 + (size_t)(r_begin + rl) * D + 8 * kq;
          const LAS bf16* h0 = WH + l15 * WP + 8 * kq; const LAS bf16* l0 = WL + l15 * WP + 8 * kq;
          const int n1 = l15 < 4 ? 16 + l15 : 19;
          const LAS bf16* h1 = WH + n1 * WP + 8 * kq; const LAS bf16* l1 = WL + n1 * WP + 8 * kq;
          f32x4 s0 = (f32x4){0.f, 0.f, 0.f, 0.f}, s1 = (f32x4){0.f, 0.f, 0.f, 0.f};
          for (int kb = 0; kb < 32; kb += 8) {
              bf16x8 af[8];
#pragma unroll
              for (int u = 0; u < 8; ++u) af[u] = *(const GAS bf16x8*)(xr + 32 * (kb + u));
#pragma unroll
              for (int u = 0; u < 8; ++u) { const int ko = 32 * (kb + u);
                  s0 = __builtin_amdgcn_mfma_f32_16x16x32_bf16(af[u], *(const LAS bf16x8*)(h0 + ko), s0, 0, 0, 0);
                  s1 = __builtin_amdgcn_mfma_f32_16x16x32_bf16(af[u], *(const LAS bf16x8*)(h1 + ko), s1, 0, 0, 0);
                  s0 = __builtin_amdgcn_mfma_f32_16x16x32_bf16(af[u], *(const LAS bf16x8*)(l0 + ko), s0, 0, 0, 0);
                  s1 = __builtin_amdgcn_mfma_f32_16x16x32_bf16(af[u], *(const LAS bf16x8*)(l1 + ko), s1, 0, 0, 0); } }
#pragma unroll
          for (int r = 0; r < 4; ++r) { const int row = tile * 16 + 4 * kq + r;
              if (row < nrow) { const float mean = STAT[2 * row], rstd = STAT[2 * row + 1];
                  LG[row * 20 + l15] = rstd * (s0[r] - mean * GC[l15]) + GC[20 + l15];
                  if (l15 < 4) LG[row * 20 + 16 + l15] = rstd * (s1[r] - mean * GC[16 + l15]) + GC[36 + l15]; } } } }
    __syncthreads();
    for (int lr = tid; lr < r_end - r_begin; lr += NT) { float lg[20];
#pragma unroll
        for (int k4 = 0; k4 < 5; ++k4) { const f32x4 t4 = *(const LAS f32x4*)(LG + lr * 20 + 4 * k4); lg[4 * k4] = t4.x; lg[4 * k4 + 1] = t4.y; lg[4 * k4 + 2] = t4.z; lg[4 * k4 + 3] = t4.w; }
        route_row(lg, bg, br, REC, RECW, LCNT, lr); }
    __syncthreads();
    unsigned* ecnt = (unsigned*)(a.ws + WS_CTL) + CW_ECNT + 64 * cslot;
    if (tid < 16) LCNT[16 + tid] = (int)atomicAdd(&ecnt[tid], (unsigned)LCNT[tid]);
    __syncthreads();
    int* RT2 = (int*)(a.ws + WS_R + R_RT2); float* RW2 = (float*)(a.ws + WS_R + R_RW2);
    for (int lr = tid; lr < r_end - r_begin; lr += NT) { const int ex1 = REC[lr * 4], ex2 = REC[lr * 4 + 1], m = r_begin + lr;
        const int i1 = ex1 * XCAP + LCNT[16 + ex1] + REC[lr * 4 + 2], i2 = ex2 * XCAP + LCNT[16 + ex2] + REC[lr * 4 + 3];
        RT2[i1] = m * 2; RW2[i1] = RECW[lr * 2]; RT2[i2] = m * 2 + 1; RW2[i2] = RECW[lr * 2 + 1]; }
}
__device__ __forceinline__ void expert_offsets(CArgs& a, int l, volatile LAS int* OFFS, int tid) {
    if (tid == 0) { const unsigned* ecnt = (const unsigned*)(a.ws + WS_CTL) + CW_ECNT + 64 * l; int o = 0;
        for (int e = 0; e < 16; ++e) { const unsigned ce = ecnt[e]; OFFS[e] = o; OFFS[48 + e] = (int)ce; o += (int)((ce + 255u) >> 8); } OFFS[16] = o; }
    __syncthreads();
}
__device__ __noinline__ void ln2_phase(CArgs& a, int l, int tid, int G) {
    const int lane = tid & 63, wave = tid >> 6;
    bf16* HB = (bf16*)(a.ws + WS_HB); const bf16* O2 = (const bf16*)(a.ws + WS_O2);
    const float* g2 = a.in[I_LN2G] + (size_t)l * D; const float* b2 = a.in[I_LN2B] + (size_t)l * D;
    const int stride = G * NWAVES;
    if (l == DEPTH - 1) {
    uint2 nh[4], na[4], nb[4];
#define LN2_LOADF(mm) do { _Pragma("unroll") for (int j = 0; j < 4; ++j) { const size_t off = (size_t)(mm) * D + 4 * lane + 256 * j; \
        nh[j] = *(const uint2*)(HB + off); na[j] = *(const uint2*)(O2 + off); nb[j] = *(const uint2*)(O2 + (size_t)MP * D + off); } } while (0)
    { const int m0_ = blockIdx.x * NWAVES + wave; if (m0_ < M) LN2_LOADF(m0_); }
    for (int m = blockIdx.x * NWAVES + wave; m < M; m += stride) {
        f32x4 v[4];
#pragma unroll
        for (int j = 0; j < 4; ++j) { const uint2 hv = nh[j]; uint2 oa = na[j], ob = nb[j];
#if defined(ABL) && (ABL & 2)
            oa = make_uint2(0u, 0u); ob = make_uint2(0u, 0u);
#endif
            v[j].x = DN_ALPHA * bflo(hv.x) + bflo(oa.x) + bflo(ob.x); v[j].y = DN_ALPHA * bfhi(hv.x) + bfhi(oa.x) + bfhi(ob.x);
            v[j].z = DN_ALPHA * bflo(hv.y) + bflo(oa.y) + bflo(ob.y); v[j].w = DN_ALPHA * bfhi(hv.y) + bfhi(oa.y) + bfhi(ob.y); }
        if (m + stride < M) LN2_LOADF(m + stride);
        float mean, rstd; ln_row_stats(v, mean, rstd);
        const int bb = m / T, t = m % T;
#pragma unroll
        for (int j = 0; j < 4; ++j) { const int c0 = 4 * lane + 256 * j; const f32x4 gg = *(const f32x4*)(g2 + c0), be = *(const f32x4*)(b2 + c0);
            const f32x4 y = (v[j] - mean) * rstd * gg + be;
            if (l == DEPTH - 1) { if (t >= NMETA) *(f32x4*)(a.out + ((size_t)bb * SEQ + (t - NMETA)) * D + c0) = y; }
            else *(uint2*)(HB + (size_t)m * D + c0) = make_uint2(pk2(y.x, y.y), pk2(y.z, y.w)); }
    }
#undef LN2_LOADF
    } else {
    v4u nh[2], na[2], nb[2];
#define LN2_LOAD(mm) do { _Pragma("unroll") for (int p_ = 0; p_ < 2; ++p_) { const size_t off = (size_t)(mm) * D + 8 * lane + 512 * p_; \
        nh[p_] = *(const v4u*)(HB + off); na[p_] = *(const v4u*)(O2 + off); nb[p_] = *(const v4u*)(O2 + (size_t)MP * D + off); } } while (0)
    { const int m0_ = blockIdx.x * NWAVES + wave; if (m0_ < M) LN2_LOAD(m0_); }
    for (int m = blockIdx.x * NWAVES + wave; m < M; m += stride) {
        f32x4 v[4];
#pragma unroll
        for (int p_ = 0; p_ < 2; ++p_) { const v4u hv = nh[p_]; v4u oa = na[p_], ob = nb[p_];
#if defined(ABL) && (ABL & 2)
            oa = (v4u){0u, 0u, 0u, 0u}; ob = (v4u){0u, 0u, 0u, 0u};
#endif
            v[2 * p_].x = DN_ALPHA * bflo(hv.x) + bflo(oa.x) + bflo(ob.x); v[2 * p_].y = DN_ALPHA * bfhi(hv.x) + bfhi(oa.x) + bfhi(ob.x);
            v[2 * p_].z = DN_ALPHA * bflo(hv.y) + bflo(oa.y) + bflo(ob.y); v[2 * p_].w = DN_ALPHA * bfhi(hv.y) + bfhi(oa.y) + bfhi(ob.y);
            v[2 * p_ + 1].x = DN_ALPHA * bflo(hv.z) + bflo(oa.z) + bflo(ob.z); v[2 * p_ + 1].y = DN_ALPHA * bfhi(hv.z) + bfhi(oa.z) + bfhi(ob.z);
            v[2 * p_ + 1].z = DN_ALPHA * bflo(hv.w) + bflo(oa.w) + bflo(ob.w); v[2 * p_ + 1].w = DN_ALPHA * bfhi(hv.w) + bfhi(oa.w) + bfhi(ob.w); }
        if (m + stride < M) LN2_LOAD(m + stride);
        float mean, rstd; ln_row_stats(v, mean, rstd);
        const int bb = m / T, t = m % T;
#pragma unroll
        for (int p_ = 0; p_ < 2; ++p_) { const int c0 = 8 * lane + 512 * p_; const f32x4 g0 = *(const f32x4*)(g2 + c0), g4 = *(const f32x4*)(g2 + c0 + 4), e0 = *(const f32x4*)(b2 + c0), e4 = *(const f32x4*)(b2 + c0 + 4);
            const f32x4 y0 = (v[2 * p_] - mean) * rstd * g0 + e0, y1 = (v[2 * p_ + 1] - mean) * rstd * g4 + e4;
            if (l == DEPTH - 1) { if (t >= NMETA) { float* op = a.out + ((size_t)bb * SEQ + (t - NMETA)) * D + c0; *(f32x4*)op = y0; *(f32x4*)(op + 4) = y1; } }
            else *(v4u*)(HB + (size_t)m * D + c0) = (v4u){pk2(y0.x, y0.y), pk2(y0.z, y0.w), pk2(y1.x, y1.y), pk2(y1.z, y1.w)}; }
    }
    }
}

#ifndef RWKV_CHUNKED
#define RWKV_CHUNKED 1
#endif
#ifndef MK_MULTI
#define MK_MULTI 0
#endif
__global__ void __launch_bounds__(NT, 2) hybrid_fwd(Args a_unused) {
    extern __shared__ __attribute__((aligned(16))) unsigned char lds_raw[];
    LAS unsigned char* lds = (LAS unsigned char*)lds_raw;
    volatile LAS unsigned* MISC = (volatile LAS unsigned*)(lds + MISC_OFF);
    const int tid = threadIdx.x;
    const int G = gridDim.x;
    for (int u = tid; u < 128; u += NT) MISC[u] = 0u;
    __syncthreads();
    int lo, hi; unsigned* ctl; { CArgs& a = *opaque_args(); lo = a.ph_lo; hi = a.ph_hi; ctl = (unsigned*)(a.ws + WS_CTL); }
    XcdBarrier bar; bar.bar = ctl + CW_BAR; bar.x = 0; bar.st = nullptr;
    if (hi - lo > 1) bar = xcd_barrier_post(ctl + CW_BAR, MISC + 0);
#ifndef PHMASK
#define PHMASK 0x1fff
#endif
#define EN(j) (((PHMASK) >> (j)) & 1)
#ifndef DUPMASK
#define DUPMASK 0
#endif
#define NREP(j) ((((DUPMASK) >> (j)) & 1) ? 2 : 1)
#ifndef DUPITEM
#define DUPITEM 0
#endif
#define IREP(k) for (int ir_ = 0; ir_ < (((DUPITEM) >> (k)) & 1 ? 2 : 1); ++ir_)
#define IN(k) (lo <= (k) && (k) < hi)
#define OPQ() CArgs& a = *opaque_args(); bf16* HB = (bf16*)(a.ws + WS_HB); unsigned char* wb = a.ws + WS_W; (void)HB; (void)wb; int tp = threadIdx.x; asm volatile("" : "+v"(tp)); const int lane = tp & 63, wave = __builtin_amdgcn_readfirstlane(tp >> 6), gw = blockIdx.x * NWAVES + wave, ngw = G * NWAVES; (void)lane; (void)gw; (void)ngw
#define SEAM(k) do { if (IN(k) && IN((k) + 1)) xcd_barrier(bar); } while (0)

    if (EN(0) && IN(0)) for (int rep = 0; rep < NREP(0); ++rep) { OPQ();
        convert_weights(a, 0, lds, gw, ngw, wave, lane);
        const float* gi = a.in[I_LNIN_G]; const float* bi = a.in[I_LNIN_B];
        f32x4 nv[4];
#define PRO_LOAD(mm) do { const int bb_ = (mm) / T, t_ = (mm) % T; const float* src_ = t_ < NMETA ? a.in[I_META] + (size_t)t_ * D : a.in[I_X] + ((size_t)bb_ * SEQ + (t_ - NMETA)) * D; \
            _Pragma("unroll") for (int j = 0; j < 4; ++j) nv[j] = *(const f32x4*)(src_ + 4 * lane + 256 * j); } while (0)
        if (gw < M) PRO_LOAD(gw);
        for (int m = gw; m < MP; m += ngw) {
            if (m >= M) { *(v4u*)(HB + (size_t)m * D + 8 * lane) = (v4u){0u, 0u, 0u, 0u}; *(v4u*)(HB + (size_t)m * D + 512 + 8 * lane) = (v4u){0u, 0u, 0u, 0u}; continue; }
            f32x4 v[4];
#pragma unroll
            for (int j = 0; j < 4; ++j) v[j] = nv[j];
            if (m + ngw < M) PRO_LOAD(m + ngw);
            float mean, rstd; ln_row_stats(v, mean, rstd);
#pragma unroll
            for (int j = 0; j < 4; ++j) { const int c0 = 4 * lane + 256 * j; const f32x4 gg = *(const f32x4*)(gi + c0), be = *(const f32x4*)(bi + c0);
                const f32x4 y = (v[j] - mean) * rstd * gg + be; *(uint2*)(HB + (size_t)m * D + c0) = make_uint2(pk2(y.x, y.y), pk2(y.z, y.w)); }
        }
        __syncthreads();
    }
    SEAM(0);

    for (int l = 0; l < DEPTH; ++l) {
        const int pb = 1 + 12 * l;
        if (EN(1) && IN(pb + 0)) for (int rep = 0; rep < NREP(1); ++rep) { OPQ();
            pg8::Gemm g{(const pg8::bf16_t*)HB, (const pg8::bf16_t*)(wb + W_IN), MP, PW, D}; pg8::StaticOrder S; S.init(TAIL0, PW, G, (int)blockIdx.x);
            pg8::EpiStoreBf16<0> E{(pg8::bf16_t*)(a.ws + WS_R + R_P), PW};
            pg8::gemm_phase<pg8::EpiStoreBf16<0>, pg8::StaticOrder, true, true>(lds, g, S, E);
            tail_inproj(a, gw, ngw, lane);
        }
        SEAM(pb + 0);
        if (EN(2) && IN(pb + 1)) for (int rep = 0; rep < NREP(2); ++rep) { OPQ();
            constexpr int N1 = NBH * NCH, NALL = 2 * N1 + M / 64;
#ifndef ABL
#define ABL 0
#endif
            if (ABL & (8 | 16 | 32 | 64)) { v4u* z = (v4u*)(a.ws + WS_Y); const size_t n16 = (size_t)4 * MP * 256 * 2 / 16; for (size_t i = (size_t)blockIdx.x * NT + tp; i < n16; i += (size_t)G * NT) z[i] = (v4u){0u, 0u, 0u, 0u}; }
            { GAS unsigned* mq = (GAS unsigned*)((unsigned*)(a.ws + WS_CTL) + CW_MIXQ + 64 * (4 * l + rep));
              asm volatile("" : "+v"(mq));
              volatile LAS int* MSLOT = (volatile LAS int*)(lds + MISC_OFF) + 44;
              int nx = 0; if (tp == 0) nx = (int)__hip_atomic_fetch_add(mq, 1u, __ATOMIC_RELAXED, __HIP_MEMORY_SCOPE_AGENT);
              for (int par = 0;; par ^= 1) {
                  if (tp == 0) { MSLOT[par] = nx; nx = (int)__hip_atomic_fetch_add(mq, 1u, __ATOMIC_RELAXED, __HIP_MEMORY_SCOPE_AGENT); }
                  __syncthreads();
                  const int it = MSLOT[par];
                  if (it >= NALL + N1) break;
                  if (it < N1) { if (RWKV_CHUNKED) IREP(3) rwkv_stage1(a, l, it, lds, tp); }
                  else if (it < N1 + M / 64) { if (!(ABL & 32)) IREP(2) dsa_stage1(a, l, it - N1, lds, tp); }
                  else if (it < 2 * N1 + M / 64) { if (!(ABL & 64)) IREP(1) ml_stage1(a, l, it - N1 - M / 64, lds, tp); }
                  else { if (!(ABL & 16)) IREP(0) gla_stage1(a, l, it - 2 * N1 - M / 64, lds, tp); }
              } }
        }
        SEAM(pb + 1);
        if (EN(3) && IN(pb + 2)) for (int rep = 0; rep < NREP(3); ++rep) { OPQ();
            constexpr int NS1 = NBH * 4, NS2 = NBH * 8, NQ = M / 4;
            if (blockIdx.x < NBH) { if (!(ABL & 8) && rep == 0) { if (RWKV_CHUNKED) rwkv_scan(a, blockIdx.x, lds, tp); else rwkv_chain(a, l, blockIdx.x, lds, tp); } }
            else { const int G2 = G - NBH, c2 = blockIdx.x - NBH;
                for (int it = c2; it < NS1 + NS2; it += G2) {
                    if (it < NS1) { if (!(ABL & 16) && rep == 0) gla_scan(a, it, tp); }
                    else { if (!(ABL & 64) && rep == 0) ml_scan(a, it - NS1, tp); } } }
            if (!(ABL & 32) && DSA_HALVES) {
                __syncthreads();
                dsa_half_init(a, lds, tp);
                dsa_half_loop(a, (unsigned*)(a.ws + WS_CTL) + CW_DSAQ + 64 * (2 * l + rep), lds, tp);
                __syncthreads();
            } else if (!(ABL & 32)) {
                __syncthreads();
                dsa_bias_table(a, lds, tp);
                GAS unsigned* qb = (GAS unsigned*)((unsigned*)(a.ws + WS_CTL) + CW_DSAQ4 + 256 * (2 * l + rep));
                asm volatile("" : "+v"(qb));
                volatile LAS int* SLOT = (volatile LAS int*)(lds + MISC_OFF) + 40;
                const int hb = (int)(blockIdx.x & 3); int cb = 0, nxt = 0;
                if (tp == 0) { int kk[2];
#pragma unroll
                    for (int u = 0; u < 2; ++u) { kk[u] = NQ;
                        for (;;) { if (cb >= 4) break; const int t_ = (int)__hip_atomic_fetch_add(qb + 64 * ((hb + cb) & 3), 1u, __ATOMIC_RELAXED, __HIP_MEMORY_SCOPE_AGENT);
                            if (t_ < T / 4) { kk[u] = t_ * 4 + ((hb + cb) & 3); break; } ++cb; } }
                    SLOT[0] = kk[0]; SLOT[1] = kk[1]; }
                __syncthreads();
                DsaPre pre;
                { const int k = SLOT[0]; const int kc = k < NQ ? k : NQ - 1; dsa_prefetch(a, (kc & 3) * (T / 4) + (T / 4 - 1 - (kc >> 2)), tp, pre); }
                for (;;) {
                    const int k = SLOT[0], kn = SLOT[1];
                    if (k >= NQ) break;
                    const int kc = kn < NQ ? kn : NQ - 1;
                    dsa_stage2(a, (k & 3) * (T / 4) + (T / 4 - 1 - (k >> 2)), (kc & 3) * (T / 4) + (T / 4 - 1 - (kc >> 2)), lds, tp, qb, hb, cb, nxt, pre, SLOT, kn);
                }
            }
        }
        SEAM(pb + 2);
        if (EN(4) && IN(pb + 3)) for (int rep = 0; rep < NREP(4); ++rep) { OPQ();
            constexpr int N1 = NBH * NCH;
            if (ABL & 128) { const bf16* P = (const bf16*)(a.ws + WS_R + R_P); bf16* Y = (bf16*)(a.ws + WS_Y);
                for (size_t i = (size_t)blockIdx.x * NT + tp; i < (size_t)M * 1024; i += (size_t)G * NT) { const size_t m = i >> 10; const int c = (int)(i & 1023); Y[(size_t)(c >> 8) * MP * 256 + m * 256 + (c & 255)] = P[m * PW + c]; } }
            { GAS unsigned* mq = (GAS unsigned*)((unsigned*)(a.ws + WS_CTL) + CW_MIXQ + 64 * (4 * l + 2 + rep));
              asm volatile("" : "+v"(mq));
              volatile LAS int* MSLOT = (volatile LAS int*)(lds + MISC_OFF) + 44;
              int nx = 0; if (tp == 0) nx = (int)__hip_atomic_fetch_add(mq, 1u, __ATOMIC_RELAXED, __HIP_MEMORY_SCOPE_AGENT);
              for (int par = 0;; par ^= 1) {
                  if (tp == 0) { MSLOT[par] = nx; nx = (int)__hip_atomic_fetch_add(mq, 1u, __ATOMIC_RELAXED, __HIP_MEMORY_SCOPE_AGENT); }
                  __syncthreads();
                  const int it = MSLOT[par];
                  if (it >= 3 * N1) break;
                  if (it < N1) { if (!(ABL & 64)) IREP(5) ml_stage2(a, l, it, lds, tp); }
                  else if (it < 2 * N1) { if (!(ABL & 16)) IREP(4) gla_stage2(a, l, it - N1, lds, tp); }
                  else IREP(6) rwkv_stage3(a, l, it - 2 * N1, lds, tp);
              } }
            tail_gates(a, gw, ngw, lane);
        }
        SEAM(pb + 3);
        if (EN(5) && IN(pb + 4)) for (int rep = 0; rep < NREP(5); ++rep) { OPQ();
            { pg8::Gemm g{(const pg8::bf16_t*)HB, (const pg8::bf16_t*)(wb + W_G), MP, 4096, D}; pg8::OrderGatesF S; S.base.init(TAIL0, 4 * pg8::BM, G, (int)blockIdx.x);
              pg8::EpiGateU8 E{a.ws + WS_R + R_G, 4096};
              pg8::gemm_phase<pg8::EpiGateU8, pg8::OrderGatesF, true, true>(lds, g, S, E); }
            __builtin_amdgcn_fence(__ATOMIC_ACQUIRE, "agent");
            __syncthreads();
            { pg8::Gemm g{(const pg8::bf16_t*)(a.ws + WS_Y), (const pg8::bf16_t*)(wb + W_B), 4 * MP, 4 * D, 256}; pg8::OrderMergeF S; S.base.init(TAIL0, 4 * pg8::BM, G, (int)blockIdx.x);
              pg8::EpiMerge E{a.ws + WS_R + R_G, (pg8::bf16_t*)(a.ws + WS_MG), a.ws + WS_R + R_MGP};
              pg8::gemm_phase<pg8::EpiMerge, pg8::OrderMergeF, true, true, false, true>(lds, g, S, E); }
            tail_merge(a, gw, ngw, lane);
        }
        SEAM(pb + 5);
        if (EN(7) && IN(pb + 6)) for (int rep = 0; rep < NREP(7); ++rep) { OPQ();
            pg8::Gemm g{(const pg8::bf16_t*)(a.ws + WS_MG), (const pg8::bf16_t*)(wb + W_O), MP, D, D}; pg8::StaticOrder S; S.init(TAIL0, D, G, (int)blockIdx.x);
            pg8::EpiResid E{(const pg8::bf16_t*)HB, (pg8::bf16_t*)(a.ws + WS_R + R_X1), DN_ALPHA};
            pg8::gemm_phase<pg8::EpiResid, pg8::StaticOrder, true, true, false, true>(lds, g, S, E);
            tail_outproj(a, gw, ngw, lane);
        }
        SEAM(pb + 6);
        if (EN(8) && IN(pb + 7)) for (int rep = 0; rep < NREP(8); ++rep) { OPQ(); ln1_router_phase(a, l, lds, tp, G, l + 2 * rep); __syncthreads(); }
        SEAM(pb + 7);
        if (EN(10) && IN(pb + 9)) for (int rep = 0; rep < NREP(10); ++rep) { OPQ();
            volatile LAS int* OFFS = (volatile LAS int*)(lds + MISC_OFF) + 16;
            expert_offsets(a, l, OFFS, tp);
            pg8::Gemm g{(const pg8::bf16_t*)HB, (const pg8::bf16_t*)(wb + W_GU), XROWS, 16 * 512, D, (const int*)(a.ws + WS_R + R_RT2)};
            pg8::OrderExpert S{G, (int)blockIdx.x, 2, (int)OFFS[16], (const LAS int*)(lds + MISC_OFF) + 16};
            pg8::EpiSwiglu E{(pg8::bf16_t*)(a.ws + WS_R + R_HID)};
            pg8::gemm_phase<pg8::EpiSwiglu, pg8::OrderExpert, true, true, true>(lds, g, S, E);
        }
        SEAM(pb + 9);
        if (EN(11) && IN(pb + 10)) for (int rep = 0; rep < NREP(11); ++rep) { OPQ();
            volatile LAS int* OFFS = (volatile LAS int*)(lds + MISC_OFF) + 16;
            expert_offsets(a, l, OFFS, tp);
            pg8::Gemm g{(const pg8::bf16_t*)(a.ws + WS_R + R_HID), (const pg8::bf16_t*)(wb + W_D), XROWS, 16 * D, 256};
            pg8::OrderExpert S{G, (int)blockIdx.x, 4, (int)OFFS[16], (const LAS int*)(lds + MISC_OFF) + 16};
            pg8::EpiDown E{(const int*)(a.ws + WS_R + R_RT2), (const float*)(a.ws + WS_R + R_RW2), (pg8::bf16_t*)(a.ws + WS_O2), (size_t)MP * D};
            pg8::gemm_phase<pg8::EpiDown, pg8::OrderExpert, true, true, false, true>(lds, g, S, E);
        }
        SEAM(pb + 10);
        if (EN(12) && IN(pb + 11)) { OPQ();
            ln2_phase(a, l, tp, G); if (NREP(12) == 2 && l == DEPTH - 1) ln2_phase(a, l, tp, G);
            if (l + 1 < DEPTH) convert_weights(a, l + 1, lds, gw, ngw, wave, lane);
            __syncthreads();
        }
        SEAM(pb + 11);
    }
#undef IN
#undef SEAM
}

__global__ void dump_kernel(const unsigned char* ws, float* out, int which) {
    const size_t i = (size_t)blockIdx.x * blockDim.x + threadIdx.x; if (i >= (size_t)BATCH * SEQ * D) return;
    const int c = (int)(i % D); const size_t r = i / D; const int b = (int)(r / SEQ), t = (int)(r % SEQ) + NMETA; const size_t m = (size_t)b * T + t;
    float v = 0.f;
    if (which == 1) v = bf2f(((const bf16*)(ws + WS_R + R_P))[m * PW + c]);
    else if (which == 2) v = (float)(ws + WS_R + R_G)[m * 4096 + c];
    else if (which == 8) v = m < 32768 ? (float)(ws + WS_R + R_G)[m * 4096 + c] : 0.f;
    else if (which == 9) v = m >= 32768 ? (float)(ws + WS_R + R_G)[m * 4096 + c] : 0.f;
    else if (which == 3) v = bf2f(((const bf16*)(ws + WS_MG))[m * D + c]);
    else if (which == 4) v = bf2f(((const bf16*)(ws + WS_R + R_X1))[m * D + c]);
    else if (which == 5) v = bf2f(((const bf16*)(ws + WS_HB))[m * D + c]);
    else if (which == 6) v = bf2f(((const bf16*)(ws + WS_Y))[(size_t)(c >> 8) * MP * 256 + m * 256 + (c & 255)]);
    else if (which == 7) v = bf2f(((const bf16*)(ws + WS_R + R_P))[m * PW + 2496 + c]);
#ifdef DUMP_RANGE
    v = (v > DUMP_HI || v < DUMP_LO || !(v == v)) ? (float)(DUMP_CODE) : 0.f;
#endif
    out[i] = v;
}
extern "C" void kernel_launch(void* const* d_in, const int* in_sizes, int n_in, void* d_out, int out_size, void* d_ws, size_t ws_size, hipStream_t stream) {
    static int grid = 0;
    if (grid == 0) {
        if (n_in != 41 || in_sizes[0] != BATCH * SEQ * D || out_size != BATCH * SEQ * D || ws_size < WS_END) {
            fprintf(stderr, "kernel_launch: unexpected shapes: n_in %d in0 %d out %d ws %zu (need %zu); nothing launched\n", n_in, n_in > 0 ? in_sizes[0] : -1, out_size, ws_size, (size_t)WS_END); grid = -1; return; }
        int dev = 0, cus = 0, per_cu = 0;
        if (hipGetDevice(&dev) != hipSuccess || hipDeviceGetAttribute(&cus, hipDeviceAttributeMultiprocessorCount, dev) != hipSuccess) { fprintf(stderr, "kernel_launch: device query failed\n"); grid = -1; return; }
        if (hipFuncSetAttribute((const void*)hybrid_fwd, hipFuncAttributeMaxDynamicSharedMemorySize, LDS_BYTES) != hipSuccess) { fprintf(stderr, "kernel_launch: hipFuncSetAttribute failed\n"); grid = -1; return; }
        if (hipOccupancyMaxActiveBlocksPerMultiprocessor(&per_cu, (const void*)hybrid_fwd, NT, LDS_BYTES) != hipSuccess || per_cu < 1)
            fprintf(stderr, "kernel_launch: note: occupancy query reports %d workgroups per CU\n", per_cu);
        (void)hipGetLastError();
        grid = cus;
        if (grid < 208) { fprintf(stderr, "kernel_launch: needs >= 208 CUs, got %d\n", grid); grid = -1; return; }
    }
    if (grid < 0) return;
#ifdef WSFILL_LO
    (void)hipMemsetAsync((char*)d_ws + (size_t)(WSFILL_LO) * MiB, 0x55, (size_t)((WSFILL_HI) - (WSFILL_LO)) * MiB, stream);
#endif
    if (hipMemsetAsync((char*)d_ws + WS_CTL, 0, CTL_ZERO_BYTES, stream) != hipSuccess) { fprintf(stderr, "kernel_launch: memset failed\n"); return; }
    Args a{};
    for (int i = 0; i < 41; ++i) a.in[i] = (const float*)d_in[i];
    a.out = (float*)d_out; a.ws = (unsigned char*)d_ws;
#if MK_MULTI
#ifdef DUMP_WHICH
#ifndef DUMP_SKIP_LO
#define DUMP_SKIP_LO 1000
#define DUMP_SKIP_HI 1000
#endif
    for (int p = 0; p < DUMP_NPH; ++p) { if (p >= DUMP_SKIP_LO && p < DUMP_SKIP_HI) continue; a.ph_lo = p; a.ph_hi = p + 1; hipLaunchKernelGGL(hybrid_fwd, dim3(grid), dim3(NT), LDS_BYTES, stream, a); }
    hipLaunchKernelGGL(dump_kernel, dim3((BATCH * SEQ * D + 255) / 256), dim3(256), 0, stream, (const unsigned char*)d_ws, (float*)d_out, DUMP_WHICH);
#else
    for (int p = 0; p < NPHASE; ++p) { a.ph_lo = p; a.ph_hi = p + 1; hipLaunchKernelGGL(hybrid_fwd, dim3(grid), dim3(NT), LDS_BYTES, stream, a); }
#endif
#else
    a.ph_lo = 0; a.ph_hi = NPHASE;
    hipLaunchKernelGGL(hybrid_fwd, dim3(grid), dim3(NT), LDS_BYTES, stream, a);
#endif
    const hipError_t le = hipPeekAtLastError();
    if (le != hipSuccess) fprintf(stderr, "kernel_launch: launch failed: %s\n", hipGetErrorName(le));
}
```
